# Optimizing an MI355X kernel written in HIP

```python
import math
import jax, jax.numpy as jnp
from jax import lax
import numpy as np

D_MODEL = 1024
BATCH = 8
SEQ = 4096
DEPTH = 2

N_A_LAYERS = DEPTH // 2
N_B_LAYERS = DEPTH - N_A_LAYERS
GLA_HEADS = 4
GLA_DK = D_MODEL // 2
GLA_DV = D_MODEL
GLA_HK = GLA_DK // GLA_HEADS
GLA_HV = GLA_DV // GLA_HEADS
GLA_GATE_RANK = 16
GLA_GATE_NORM = 16.0
GLA_CHUNK = 64
DIFF_HEADS = 8
DIFF_HD = D_MODEL // (2 * DIFF_HEADS)
DIFF_VD = 2 * DIFF_HD
DIFF_QK = DIFF_HEADS * 2 * DIFF_HD
DIFF_V = DIFF_HEADS * DIFF_VD
Q_BLOCK = 128
ROPE_THETA = 10000.0
D_FF = 2816
CONV_WIDTH = 3
EPS = 1e-6

kernel_name = 'yoco_gla_diffattn_convffn'


def rmsnorm(x, w):
    xf = x.astype(jnp.float32)
    y = xf * lax.rsqrt(jnp.mean(xf * xf, axis=-1, keepdims=True) + EPS)
    return (y * w.astype(jnp.float32)).astype(x.dtype)


def rope_tables(seq):
    pos = jnp.arange(seq, dtype=jnp.float32)
    inv = ROPE_THETA ** (-jnp.arange(0, DIFF_HD, 2, dtype=jnp.float32) / DIFF_HD)
    f = pos[:, None] * inv[None, :]
    emb = jnp.concatenate([f, f], axis=-1)
    return jnp.cos(emb), jnp.sin(emb)


def apply_rope(x, cos, sin):
    c = cos[None, :, None, None, :]
    s = sin[None, :, None, None, :]
    x1, x2 = jnp.split(x, 2, axis=-1)
    rot = jnp.concatenate([-x2, x1], axis=-1)
    return (x.astype(jnp.float32) * c + rot.astype(jnp.float32) * s).astype(x.dtype)


def gla_mix(h, w_qkvg, w_gk1, w_gk2, b_gk, onorm_w, w_o):
    B, S, _ = h.shape
    C = GLA_CHUNK
    N = S // C
    proj = h @ w_qkvg
    q, k, v, g = jnp.split(proj, [GLA_DK, 2 * GLA_DK, 2 * GLA_DK + GLA_DV], axis=-1)
    gk = jax.nn.log_sigmoid(((h @ w_gk1) @ w_gk2 + b_gk).astype(jnp.float32)) / GLA_GATE_NORM

    def heads_k(t):
        return t.astype(jnp.float32).reshape(B, N, C, GLA_HEADS, GLA_HK).transpose(0, 3, 1, 2, 4)

    q = heads_k(q) * (GLA_HK ** -0.5)
    k = heads_k(k)
    gk = heads_k(gk)
    v = v.astype(jnp.float32).reshape(B, N, C, GLA_HEADS, GLA_HV).transpose(0, 3, 1, 2, 4)

    b = jnp.cumsum(gk, axis=3)
    b_last = b[:, :, :, -1:, :]
    q_in = q * jnp.exp(b)
    k_in = k * jnp.exp(-b)
    k_end = k * jnp.exp(b_last - b)

    causal = jnp.tril(jnp.ones((C, C), dtype=bool))
    scores = jnp.einsum('bhncd,bhnjd->bhncj', q_in, k_in)
    scores = jnp.where(causal, scores, 0.0)
    o_intra = jnp.einsum('bhncj,bhnje->bhnce', scores, v)

    contrib = jnp.einsum('bhncd,bhnce->bhnde', k_end, v)
    decay = jnp.exp(b_last[:, :, :, 0, :])

    def step(state, inp):
        d, c = inp
        return d[..., None] * state + c, state

    init = jnp.zeros((B, GLA_HEADS, GLA_HK, GLA_HV), jnp.float32)
    _, s_prev = lax.scan(step, init, (jnp.moveaxis(decay, 2, 0), jnp.moveaxis(contrib, 2, 0)))
    s_prev = jnp.moveaxis(s_prev, 0, 2)
    o_inter = jnp.einsum('bhncd,bhnde->bhnce', q_in, s_prev)

    o = (o_intra + o_inter).transpose(0, 2, 3, 1, 4).reshape(B, S, GLA_HEADS, GLA_HV)
    o = rmsnorm(o.astype(h.dtype), onorm_w).reshape(B, S, GLA_DV)
    o = o * jax.nn.silu(g)
    return o @ w_o


def shared_kv(h, kv_norm_w, w_kv, cos, sin):
    B, S, _ = h.shape
    kv = rmsnorm(h, kv_norm_w) @ w_kv
    k, v = jnp.split(kv, [DIFF_QK], axis=-1)
    k = apply_rope(k.reshape(B, S, DIFF_HEADS, 2, DIFF_HD), cos, sin)
    v = v.reshape(B, S, DIFF_HEADS, DIFF_VD)
    return k, v


def diff_attn(h, k_sh, v_sh, w_q, lam_p, subln_w, w_o, lam_init, cos, sin):
    B, S, _ = h.shape
    q = apply_rope((h @ w_q).reshape(B, S, DIFF_HEADS, 2, DIFF_HD), cos, sin)
    lp = lam_p.astype(jnp.float32)
    lam = jnp.exp(jnp.sum(lp[0] * lp[1])) - jnp.exp(jnp.sum(lp[2] * lp[3])) + lam_init
    nqb = S // Q_BLOCK
    qb = jnp.moveaxis(q.reshape(B, nqb, Q_BLOCK, DIFF_HEADS, 2, DIFF_HD), 1, 0)
    kpos = jnp.arange(S)
    scale = DIFF_HD ** -0.5

    def block(args):
        qblk, i = args
        s = jnp.einsum('bqhcd,bkhcd->bhcqk', qblk, k_sh).astype(jnp.float32) * scale
        qpos = i * Q_BLOCK + jnp.arange(Q_BLOCK)
        mask = kpos[None, :] <= qpos[:, None]
        s = jnp.where(mask[None, None, None], s, -jnp.inf)
        p = jax.nn.softmax(s, axis=-1)
        a = p[:, :, 0] - lam * p[:, :, 1]
        return jnp.einsum('bhqk,bkhe->bqhe', a.astype(v_sh.dtype), v_sh)

    o = lax.map(block, (qb, jnp.arange(nqb)))
    o = jnp.moveaxis(o, 0, 1).reshape(B, S, DIFF_HEADS, DIFF_VD)
    o = rmsnorm(o, subln_w) * (1.0 - lam_init)
    return o.reshape(B, S, DIFF_V) @ w_o


def conv_ffn(h, w_in, conv_w, conv_b, w_out):
    S = h.shape[1]
    u = h @ w_in
    up = jnp.pad(u, ((0, 0), (CONV_WIDTH - 1, 0), (0, 0)))
    c = sum(up[:, j:j + S, :] * conv_w[j] for j in range(CONV_WIDTH)) + conv_b
    a, g = jnp.split(c, 2, axis=-1)
    return (jax.nn.silu(g) * a) @ w_out


def setup_inputs(seed: int = 0) -> dict:
    key = jax.random.key(seed)
    ks = jax.random.split(key, 24)

    def nrm(k, shape, scale):
        return jax.random.normal(k, shape, jnp.float32) * scale

    def gain(k, shape):
        return 1.0 + 0.02 * jax.random.normal(k, shape, jnp.float32)

    D = D_MODEL
    return {
        'x': nrm(ks[0], (BATCH, SEQ, D), 1.0),
        'attn_norm_w': gain(ks[1], (DEPTH, D)),
        'ffn_norm_w': gain(ks[2], (DEPTH, D)),
        'gla_w_qkvg': nrm(ks[3], (N_A_LAYERS, D, 2 * GLA_DK + 2 * GLA_DV), D ** -0.5),
        'gla_w_gk1': nrm(ks[4], (N_A_LAYERS, D, GLA_GATE_RANK), D ** -0.5),
        'gla_w_gk2': nrm(ks[5], (N_A_LAYERS, GLA_GATE_RANK, GLA_DK), GLA_GATE_RANK ** -0.5),
        'gla_b_gk': nrm(ks[6], (N_A_LAYERS, GLA_DK), 0.1),
        'gla_onorm_w': gain(ks[7], (N_A_LAYERS, GLA_HV)),
        'gla_w_o': nrm(ks[8], (N_A_LAYERS, GLA_DV, D), GLA_DV ** -0.5),
        'kv_norm_w': gain(ks[9], (D,)),
        'w_kv': nrm(ks[10], (D, DIFF_QK + DIFF_V), D ** -0.5),
        'diff_w_q': nrm(ks[11], (N_B_LAYERS, D, DIFF_QK), D ** -0.5),
        'diff_lambda': nrm(ks[12], (N_B_LAYERS, 4, DIFF_HD), 0.1),
        'diff_subln_w': gain(ks[13], (N_B_LAYERS, DIFF_VD)),
        'diff_w_o': nrm(ks[14], (N_B_LAYERS, DIFF_V, D), DIFF_V ** -0.5),
        'ffn_w_in': nrm(ks[15], (DEPTH, D, 2 * D_FF), D ** -0.5),
        'ffn_conv_w': nrm(ks[16], (DEPTH, CONV_WIDTH, 2 * D_FF), CONV_WIDTH ** -0.5),
        'ffn_conv_b': nrm(ks[17], (DEPTH, 2 * D_FF), 0.02),
        'ffn_w_out': nrm(ks[18], (DEPTH, D_FF, D), D_FF ** -0.5),
        'final_norm_w': gain(ks[19], (D,)),
    }


def reference(x, attn_norm_w, ffn_norm_w, gla_w_qkvg, gla_w_gk1, gla_w_gk2, gla_b_gk, gla_onorm_w, gla_w_o,
              kv_norm_w, w_kv, diff_w_q, diff_lambda, diff_subln_w, diff_w_o,
              ffn_w_in, ffn_conv_w, ffn_conv_b, ffn_w_out, final_norm_w):
    S = x.shape[1]
    cos, sin = rope_tables(S)
    h = x
    k_sh = None
    v_sh = None
    for l in range(DEPTH):
        if l == N_A_LAYERS:
            k_sh, v_sh = shared_kv(h, kv_norm_w, w_kv, cos, sin)
        a_in = rmsnorm(h, attn_norm_w[l])
        if l < N_A_LAYERS:
            h = h + gla_mix(a_in, gla_w_qkvg[l], gla_w_gk1[l], gla_w_gk2[l], gla_b_gk[l], gla_onorm_w[l], gla_w_o[l])
        else:
            j = l - N_A_LAYERS
            lam_init = 0.8 - 0.6 * math.exp(-0.3 * l)
            h = h + diff_attn(a_in, k_sh, v_sh, diff_w_q[j], diff_lambda[j], diff_subln_w[j], diff_w_o[j], lam_init, cos, sin)
        h = h + conv_ffn(rmsnorm(h, ffn_norm_w[l]), ffn_w_in[l], ffn_conv_w[l], ffn_conv_b[l], ffn_w_out[l])
    return rmsnorm(h, final_norm_w)
```

```cpp
#ifndef MK_PER_PHASE
#define MK_PER_PHASE 0
#endif
#include <hip/hip_runtime.h>
#include <cstdio>
#include <cstdint>
namespace pg8 {
#define PG8_LAS __attribute__((address_space(3)))
typedef unsigned short bf16_t;
typedef short bf16x8 __attribute__((ext_vector_type(8)));
typedef float f32x4 __attribute__((ext_vector_type(4)));
typedef unsigned u32x4 __attribute__((ext_vector_type(4)));
constexpr int BM = 256, BK = 64, HALF = 128, HTB = HALF * BK * 2  , STAGE_BYTES = 8 * HTB, NXCD = 8, WGM = 8;

__host__ __device__ __forceinline__ int lds_byte(int r, int c) { const int st = (r >> 4) * 2 + (c >> 5), rr = r & 15, cc = c & 31, ob = rr * 64 + cc * 2; return st * 1024 + (ob ^ (((ob >> 9) & 1) << 5)); }
__host__ __device__ __forceinline__ void stage_rc(int b, int& R, int& C) { const int st = b / 1024, sb = b % 1024, swz = sb ^ (((sb >> 9) & 1) << 5); R = (st >> 1) * 16 + swz / 64; C = (st & 1) * 32 + (swz % 64) / 2; }
__host__ __device__ __forceinline__ int perm32(int rho) { const int n = rho >> 4, i = rho & 15; return 8 * (i >> 2) + 4 * n + (i & 3); }

struct Unit { int pm, pn; };
struct Gemm { const bf16_t* A; const bf16_t* Bt; int M, N, K; };

struct StaticOrder {
    int nM, nN, nwg, G, c;
    __host__ __device__ void init(int M, int N, int G_, int c_) { nM = M / BM; nN = N / BM; nwg = nM * nN; G = G_; c = c_; }
    __host__ __device__ bool next(int i, Unit& u) const {
        const long L = (long)i * G + c; if (L >= nwg) return false;
        int wgid = (int)L; { const int q = nwg / NXCD, r = nwg % NXCD, xcd = wgid % NXCD, off = wgid / NXCD; wgid = (xcd < r ? xcd * (q + 1) : r * (q + 1) + (xcd - r) * q) + off; }
        const int nig = WGM * nN, gid = wgid / nig, fm = gid * WGM, gsz = (nM - fm) < WGM ? (nM - fm) : WGM;
        u.pm = fm + ((wgid % nig) % gsz); u.pn = (wgid % nig) / gsz; return true;
    }
    __device__ __forceinline__ void a_ready(const Unit&) const {}
    __device__ __forceinline__ void done(const Unit&) const {}
};

__device__ __forceinline__ unsigned cvt_pk_bf16(float lo, float hi) { unsigned r; asm volatile("v_cvt_pk_bf16_f32 %0, %1, %2" : "=v"(r) : "v"(lo), "v"(hi)); return r; }
typedef float f32x2 __attribute__((ext_vector_type(2)));
__device__ __forceinline__ float rstd_ps(const float* ps, int row) {
    const f32x4* p = (const f32x4*)(ps + (size_t)row * 16); const f32x4 a = p[0], b = p[1], c = p[2], d = p[3];
    const float s = ((a[0] + a[1]) + (a[2] + a[3])) + ((b[0] + b[1]) + (b[2] + b[3])) + ((c[0] + c[1]) + (c[2] + c[3])) + ((d[0] + d[1]) + (d[2] + d[3]));
    return __builtin_amdgcn_rsqf(s * (1.0f / 1024.0f) + 1e-6f);
}
struct EpiScaleBf16 {
    static constexpr bool PERM = true, AFTER_DRAIN = false, APERM = false;
    bf16_t* O; int ldc; const float* rstd; const float* ps; int halo;
    __device__ __forceinline__ void operator()(const f32x4 (&acc)[2][2][4][2], const Unit& u, int wr, int wc, int fr, int fq) const {
        const int row0 = u.pm * BM + wr * 64 + fr, col0 = u.pn * BM + wc * 32 + 8 * fq;
        float sc[2][4];
#pragma unroll
        for (int ai = 0; ai < 2; ++ai)
#pragma unroll
            for (int m = 0; m < 4; ++m) { const int row = row0 + ai * HALF + m * 16;
                if (rstd) sc[ai][m] = rstd[row];
                else if (halo) { const int st = row >> 1; sc[ai][m] = (st & 63) ? rstd_ps(ps, 64 * st - 2 + (row & 1)) : 0.f; } else sc[ai][m] = rstd_ps(ps, row); }
#pragma unroll
        for (int ai = 0; ai < 2; ++ai)
#pragma unroll
            for (int m = 0; m < 4; ++m) { const int row = row0 + ai * HALF + m * 16; const float s = sc[ai][m];
                bf16_t* rowp = O + (size_t)row * ldc + col0;
#pragma unroll
                for (int bj = 0; bj < 2; ++bj) { const f32x4 v0 = acc[ai][bj][m][0] * s, v1 = acc[ai][bj][m][1] * s;
                    u32x4 w; w.x = cvt_pk_bf16(v0[0], v0[1]); w.y = cvt_pk_bf16(v0[2], v0[3]); w.z = cvt_pk_bf16(v1[0], v1[1]); w.w = cvt_pk_bf16(v1[2], v1[3]);
                    *(u32x4*)(rowp + bj * HALF) = w; } }
    }
};
struct EpiResBf16 {
    static constexpr bool PERM = true, AFTER_DRAIN = false, APERM = false;
    const float* base32; const bf16_t* base16; bf16_t* out; int ldc; float* ps; bf16_t* ah;
    __device__ __forceinline__ void operator()(const f32x4 (&acc)[2][2][4][2], const Unit& u, int wr, int wc, int fr, int fq) const {
        const int row0 = u.pm * BM + wr * 64 + fr, col0 = u.pn * BM + wc * 32 + 8 * fq;
#pragma unroll
        for (int ai = 0; ai < 2; ++ai) {
            f32x4 b0[4][2], b1[4][2];
            if (base32) {
#pragma unroll
                for (int m = 0; m < 4; ++m)
#pragma unroll
                    for (int bj = 0; bj < 2; ++bj) { const size_t off = (size_t)(row0 + ai * HALF + m * 16) * ldc + col0 + bj * HALF; b0[m][bj] = *(const f32x4*)(base32 + off); b1[m][bj] = *(const f32x4*)(base32 + off + 4); }
            } else {
                u32x4 r[4][2];
#pragma unroll
                for (int m = 0; m < 4; ++m)
#pragma unroll
                    for (int bj = 0; bj < 2; ++bj) r[m][bj] = *(const u32x4*)(base16 + (size_t)(row0 + ai * HALF + m * 16) * ldc + col0 + bj * HALF);
#pragma unroll
                for (int m = 0; m < 4; ++m)
#pragma unroll
                    for (int bj = 0; bj < 2; ++bj) { const u32x4 q = r[m][bj];
                        b0[m][bj][0] = __builtin_bit_cast(float, q.x << 16); b0[m][bj][1] = __builtin_bit_cast(float, q.x & 0xffff0000u); b0[m][bj][2] = __builtin_bit_cast(float, q.y << 16); b0[m][bj][3] = __builtin_bit_cast(float, q.y & 0xffff0000u);
                        b1[m][bj][0] = __builtin_bit_cast(float, q.z << 16); b1[m][bj][1] = __builtin_bit_cast(float, q.z & 0xffff0000u); b1[m][bj][2] = __builtin_bit_cast(float, q.w << 16); b1[m][bj][3] = __builtin_bit_cast(float, q.w & 0xffff0000u); }
            }
#pragma unroll
            for (int m = 0; m < 4; ++m) { const int row = row0 + ai * HALF + m * 16; const size_t off = (size_t)row * ldc + col0; float ss = 0.f;
                const bool hrow = (m == 3) && (fr >= 14); const int st = ((row >> 6) + 1) & 511; const bool hw = ah && hrow && (st & 63);
                bf16_t* ahp = ah + (size_t)(2 * st + (fr - 14)) * ldc + col0;
#pragma unroll
                for (int bj = 0; bj < 2; ++bj) {
                    const f32x4 v0 = b0[m][bj] + acc[ai][bj][m][0], v1 = b1[m][bj] + acc[ai][bj][m][1];
                    ss += ((v0[0] * v0[0] + v0[1] * v0[1]) + (v0[2] * v0[2] + v0[3] * v0[3])) + ((v1[0] * v1[0] + v1[1] * v1[1]) + (v1[2] * v1[2] + v1[3] * v1[3]));
                    u32x4 w; w.x = cvt_pk_bf16(v0[0], v0[1]); w.y = cvt_pk_bf16(v0[2], v0[3]); w.z = cvt_pk_bf16(v1[0], v1[1]); w.w = cvt_pk_bf16(v1[2], v1[3]);
                    *(u32x4*)(out + off + bj * HALF) = w;
                    if (hw) *(u32x4*)(ahp + bj * HALF) = w; }
                ss += __shfl_xor(ss, 16); ss += __shfl_xor(ss, 32);
                if (fq == 0) ps[(size_t)row * 16 + u.pn * 4 + wc] = ss; }
        }
    }
};
struct EpiRope {
    static constexpr bool PERM = false, AFTER_DRAIN = false, APERM = false;
    bf16_t* KR; bf16_t* VR; bf16_t* QR; const float* ps; const float* cosT; const float* sinT;
    __device__ __forceinline__ void operator()(const f32x4 (&acc)[2][2][4][2], const Unit& u, int wr, int wc, int fr, int fq) const {
        typedef unsigned u32x2v __attribute__((ext_vector_type(2)));
        const int row0 = u.pm * BM + wr * 64 + fr; const int pn = u.pn;
#pragma unroll
        for (int ai = 0; ai < 2; ++ai) {
            float sc[4];
#pragma unroll
            for (int m = 0; m < 4; ++m) sc[m] = rstd_ps(ps, row0 + ai * HALF + m * 16);
            if (pn >= 4 && pn < 8) {
#pragma unroll
                for (int m = 0; m < 4; ++m) { const int row = row0 + ai * HALF + m * 16; const float s = sc[m]; const int b = row >> 12, sq = row & 4095;
#pragma unroll
                    for (int bj = 0; bj < 2; ++bj) { const int head = 2 * (pn - 4) + bj; bf16_t* p = VR + ((size_t)(b * 8 + head) * 4096 + sq) * 128 + 32 * wc + 4 * fq;
#pragma unroll
                        for (int n = 0; n < 2; ++n) { const f32x4 v = acc[ai][bj][m][n] * s; u32x2v w; w.x = cvt_pk_bf16(v[0], v[1]); w.y = cvt_pk_bf16(v[2], v[3]); *(u32x2v*)(p + 16 * n) = w; } } }
            } else {
                bf16_t* dst = pn < 4 ? KR : QR; const int tl = pn < 4 ? pn : pn - 8; const int d0 = 16 * (wc & 1) + 4 * fq;
                f32x4 cs[4], sn[4];
#pragma unroll
                for (int m = 0; m < 4; ++m) { const int sq = (row0 + ai * HALF + m * 16) & 4095; cs[m] = *(const f32x4*)(cosT + sq * 32 + d0); sn[m] = *(const f32x4*)(sinT + sq * 32 + d0); }
#pragma unroll
                for (int m = 0; m < 4; ++m) { const int row = row0 + ai * HALF + m * 16; const float s = sc[m]; const int b = row >> 12, sq = row & 4095;
#pragma unroll
                    for (int bj = 0; bj < 2; ++bj) { const int gc = tl * 4 + 2 * bj + (wc >> 1), head = gc >> 1, c2 = gc & 1;
                        const f32x4 x1 = acc[ai][bj][m][0] * s, x2 = acc[ai][bj][m][1] * s; const f32x4 o1 = x1 * cs[m] - x2 * sn[m], o2 = x2 * cs[m] + x1 * sn[m];
                        bf16_t* p = dst + ((size_t)((b * 8 + head) * 2 + c2) * 4096 + sq) * 64 + d0;
                        u32x2v w1, w2; w1.x = cvt_pk_bf16(o1[0], o1[1]); w1.y = cvt_pk_bf16(o1[2], o1[3]); w2.x = cvt_pk_bf16(o2[0], o2[1]); w2.y = cvt_pk_bf16(o2[2], o2[3]);
                        *(u32x2v*)p = w1; *(u32x2v*)(p + 32) = w2; } }
            }
        }
    }
};

#define DPPF(oldv, src, ctrl) __builtin_bit_cast(float, __builtin_amdgcn_update_dpp(__builtin_bit_cast(int, (float)(oldv)), __builtin_bit_cast(int, (float)(src)), (ctrl), 0xf, 0xf, false))
struct EpiConvGate {
    static constexpr bool PERM = true, AFTER_DRAIN = false;
    bf16_t* ACT; const bf16_t* UH; const float* rstd; const float* cw; const float* cb;
    __device__ __forceinline__ void operator()(const f32x4 (&acc)[2][2][4][2], const Unit& u, int wr, int wc, int fr, int fq) const {
        typedef unsigned u32x2v __attribute__((ext_vector_type(2)));
        const int row0 = u.pm * BM + wr * 64 + fr;
        float rs[2][4];
#pragma unroll
        for (int ai = 0; ai < 2; ++ai)
#pragma unroll
            for (int m = 0; m < 4; ++m) rs[ai][m] = rstd[row0 + ai * HALF + m * 16];
        u32x2v hq[2][2][4];
#pragma unroll
        for (int n = 0; n < 2; ++n)
#pragma unroll
            for (int ai = 0; ai < 2; ++ai) { const bf16_t* hp = UH + (size_t)(2 * (4 * u.pm + 2 * ai + wr)) * 5632 + u.pn * BM + wc * 32 + 8 * fq + 4 * n;
                hq[n][ai][0] = *(const u32x2v*)hp; hq[n][ai][1] = *(const u32x2v*)(hp + 5632); hq[n][ai][2] = *(const u32x2v*)(hp + HALF); hq[n][ai][3] = *(const u32x2v*)(hp + 5632 + HALF); }
#pragma unroll
        for (int n = 0; n < 2; ++n) {
            const int cha = u.pn * 128 + wc * 32 + 8 * fq + 4 * n, chg = 2816 + cha;
            f32x4 wa[3], wg[3];
#pragma unroll
            for (int j = 0; j < 3; ++j) { wa[j] = *(const f32x4*)(cw + j * 5632 + cha); wg[j] = *(const f32x4*)(cw + j * 5632 + chg); }
            const f32x4 ba = *(const f32x4*)(cb + cha), bg = *(const f32x4*)(cb + chg);
#pragma unroll
            for (int ai = 0; ai < 2; ++ai) {
                const u32x2v ha2 = hq[n][ai][0], ha1 = hq[n][ai][1], hg2 = hq[n][ai][2], hg1 = hq[n][ai][3];
                f32x4 pa, pg;
                { f32x4 a1, a2, g1, g2;
                  a1[0] = __builtin_bit_cast(float, ha1.x << 16); a1[1] = __builtin_bit_cast(float, ha1.x & 0xffff0000u); a1[2] = __builtin_bit_cast(float, ha1.y << 16); a1[3] = __builtin_bit_cast(float, ha1.y & 0xffff0000u);
                  a2[0] = __builtin_bit_cast(float, ha2.x << 16); a2[1] = __builtin_bit_cast(float, ha2.x & 0xffff0000u); a2[2] = __builtin_bit_cast(float, ha2.y << 16); a2[3] = __builtin_bit_cast(float, ha2.y & 0xffff0000u);
                  g1[0] = __builtin_bit_cast(float, hg1.x << 16); g1[1] = __builtin_bit_cast(float, hg1.x & 0xffff0000u); g1[2] = __builtin_bit_cast(float, hg1.y << 16); g1[3] = __builtin_bit_cast(float, hg1.y & 0xffff0000u);
                  g2[0] = __builtin_bit_cast(float, hg2.x << 16); g2[1] = __builtin_bit_cast(float, hg2.x & 0xffff0000u); g2[2] = __builtin_bit_cast(float, hg2.y << 16); g2[3] = __builtin_bit_cast(float, hg2.y & 0xffff0000u);
                  const bool is14 = (fr == 14);
#pragma unroll
                  for (int i = 0; i < 4; ++i) { pa[i] = is14 ? a2[i] : a1[i]; pg[i] = is14 ? g2[i] : g1[i]; } }
#pragma unroll
                for (int m = 0; m < 4; ++m) {
                    const int row = row0 + ai * HALF + m * 16; const float s = rs[ai][m];
                    const f32x4 ua = acc[ai][0][m][n] * s, ug = acc[ai][1][m][n] * s;
                    float r[4];
#pragma unroll
                    for (int i = 0; i < 4; ++i) {
                        const float oa1 = DPPF(0.f, pa[i], 0x121), oa2 = DPPF(0.f, pa[i], 0x122), og1 = DPPF(0.f, pg[i], 0x121), og2 = DPPF(0.f, pg[i], 0x122);
                        const float a1 = DPPF(oa1, ua[i], 0x111), a2 = DPPF(oa2, ua[i], 0x112), g1 = DPPF(og1, ug[i], 0x111), g2 = DPPF(og2, ug[i], 0x112);
                        const float ca = wa[0][i] * a2 + wa[1][i] * a1 + wa[2][i] * ua[i] + ba[i];
                        const float cg = wg[0][i] * g2 + wg[1][i] * g1 + wg[2][i] * ug[i] + bg[i];
                        r[i] = ca * (cg * __builtin_amdgcn_rcpf(1.0f + __builtin_amdgcn_exp2f(-1.4426950408889634f * cg)));
                    }
                    pa = ua; pg = ug;
                    u32x2v w; w.x = cvt_pk_bf16(r[0], r[1]); w.y = cvt_pk_bf16(r[2], r[3]);
                    *(u32x2v*)(ACT + (size_t)row * 2816 + cha) = w;
                }
            }
        }
    }
};
template <class Epi, class Sched, bool ALIGN_EPI = false, bool SP2 = false>
__device__ __forceinline__ void gemm_phase(PG8_LAS unsigned char* lds, const Gemm g, const Sched& S, const Epi& E) {
    int tid_l = threadIdx.x; asm volatile("" : "+v"(tid_l));
    const int tid = tid_l, wid = __builtin_amdgcn_readfirstlane(tid >> 6), lane = tid & 63, wr = wid >> 2, wc = wid & 3, fr = lane & 15, fq = lane >> 4;
    const int K = g.K, nt = K / BK;
    unsigned voffA[2], voffB[2];
#pragma unroll
    for (int i = 0; i < 2; ++i) { int R, C; stage_rc(tid * 16 + i * 8192, R, C); const int Rb = Epi::PERM ? ((R & ~31) + perm32(R & 31)) : R;
        voffA[i] = (unsigned)(R * K + C) * 2u; voffB[i] = (unsigned)(Rb * K + C) * 2u; }
    const size_t kstep = (size_t)(BK * 2);
    const size_t hstep = (size_t)HALF * K * 2;
    const size_t tstep = 2 * hstep;
    const unsigned ldsw = (unsigned)wid * 1024u;
    const int aoff = lds_byte(wr * 64 + fr, fq * 8), boff = lds_byte(wc * 32 + fr, fq * 8);
#define PG8_SA(b, h) (((b) * 2 + (h)) * HTB)
#define PG8_SB(b, h) ((4 + (b) * 2 + (h)) * HTB)
#define PG8_STAGE(bufoff, gbase, voff) do { _Pragma("unroll") for (int _i = 0; _i < 2; ++_i) \
        __builtin_amdgcn_global_load_lds((const unsigned*)((const char*)(gbase) + (voff)[_i]), (PG8_LAS unsigned*)(lds + (bufoff) + ldsw + _i * 8192), 16, 0, 0); } while (0)
#define PG8_LDA(dst, b, h) do { _Pragma("unroll") for (int m = 0; m < 4; ++m) _Pragma("unroll") for (int k = 0; k < 2; ++k) dst[m][k] = *(const PG8_LAS bf16x8*)(lds + PG8_SA(b, h) + aoff + m * 2048 + k * 1024); } while (0)
#define PG8_LDB(dst, b, h) do { _Pragma("unroll") for (int n = 0; n < 2; ++n) _Pragma("unroll") for (int k = 0; k < 2; ++k) dst[n][k] = *(const PG8_LAS bf16x8*)(lds + PG8_SB(b, h) + boff + n * 2048 + k * 1024); } while (0)
#define PG8_MMA(ai, bj, At, Bt) do { __builtin_amdgcn_s_setprio(1); _Pragma("unroll") for (int m = 0; m < 4; ++m) _Pragma("unroll") for (int n = 0; n < 2; ++n) _Pragma("unroll") for (int k = 0; k < 2; ++k) \
        acc[ai][bj][m][n] = __builtin_amdgcn_mfma_f32_16x16x32_bf16(Bt[n][k], At[m][k], acc[ai][bj][m][n], 0, 0, 0); __builtin_amdgcn_s_setprio(0); } while (0)
#define PG8_WAIT_V(n) asm volatile("s_waitcnt vmcnt(" #n ")" ::: "memory")
#define PG8_WAIT_L(n) asm volatile("s_waitcnt lgkmcnt(" #n ")" ::: "memory")
#define PG8_BAR __builtin_amdgcn_s_barrier()
#define PG8_SCHED __builtin_amdgcn_sched_barrier(0)
    Unit cur, nxt; int ui = 0;
    if (!S.next(0, cur)) return;
    f32x4 acc[2][2][4][2];
#pragma unroll
    for (int a = 0; a < 2; ++a)
#pragma unroll
        for (int b = 0; b < 2; ++b)
#pragma unroll
            for (int m = 0; m < 4; ++m)
#pragma unroll
                for (int n = 0; n < 2; ++n) acc[a][b][m][n] = (f32x4){0.f, 0.f, 0.f, 0.f};
    bf16x8 At[4][2], B0[2][2], B1[2][2];
    const char* cA = (const char*)g.A + (size_t)cur.pm * tstep; const char* cB = (const char*)g.Bt + (size_t)cur.pn * tstep;
    S.a_ready(cur);
    if constexpr (SP2) {
        PG8_STAGE(PG8_SB(0, 0), cB, voffB); PG8_STAGE(PG8_SB(0, 1), cB + hstep, voffB); PG8_STAGE(PG8_SA(0, 0), cA, voffA); PG8_STAGE(PG8_SA(0, 1), cA + hstep, voffA);
        if (wr == 1) PG8_BAR;
        PG8_WAIT_V(2); PG8_BAR;
        PG8_STAGE(PG8_SB(1, 0), cB + kstep, voffB); PG8_STAGE(PG8_SA(1, 0), cA + kstep, voffA); PG8_STAGE(PG8_SB(1, 1), cB + hstep + kstep, voffB);
        PG8_WAIT_V(6); PG8_BAR;
    } else {
        PG8_STAGE(PG8_SB(0, 0), cB, voffB); PG8_STAGE(PG8_SA(0, 0), cA, voffA); PG8_STAGE(PG8_SB(0, 1), cB + hstep, voffB); PG8_STAGE(PG8_SA(0, 1), cA + hstep, voffA);
        if (wr == 1) PG8_BAR;
        PG8_WAIT_V(4); PG8_BAR;
        PG8_STAGE(PG8_SB(1, 0), cB + kstep, voffB); PG8_STAGE(PG8_SA(1, 0), cA + kstep, voffA); PG8_STAGE(PG8_SB(1, 1), cB + hstep + kstep, voffB);
        PG8_WAIT_V(6); PG8_BAR;
    }
    for (;;) {
        const bool has_next = S.next(ui + 1, nxt);
        const char* nA = has_next ? (const char*)g.A + (size_t)nxt.pm * tstep : cA; const char* nB = has_next ? (const char*)g.Bt + (size_t)nxt.pn * tstep : cB;
        for (int t = 0; t < nt; t += 2) {
            const bool last = (t == nt - 2);
            const char* a1 = cA + (size_t)(t + 1) * kstep;
            const char* a2 = last ? nA : cA + (size_t)(t + 2) * kstep; const char* b2 = last ? nB : cB + (size_t)(t + 2) * kstep;
            const char* a3 = a2 + kstep; const char* b3 = b2 + kstep;
            if (last && has_next) S.a_ready(nxt);
            if constexpr (SP2) {
            PG8_LDB(B0, 0, 0); PG8_LDB(B1, 0, 1); PG8_SCHED; PG8_LDA(At, 0, 0); PG8_STAGE(PG8_SA(1, 1), a1 + hstep, voffA);
            PG8_WAIT_V(8); PG8_WAIT_L(0); PG8_BAR; PG8_MMA(0, 0, At, B0); PG8_MMA(0, 1, At, B1); PG8_BAR; PG8_SCHED;
            PG8_LDA(At, 0, 1); PG8_STAGE(PG8_SB(0, 0), b2, voffB); PG8_STAGE(PG8_SB(0, 1), b2 + hstep, voffB); PG8_STAGE(PG8_SA(0, 0), a2, voffA);
            PG8_WAIT_V(8); PG8_WAIT_L(0); PG8_BAR; PG8_MMA(1, 0, At, B0); PG8_MMA(1, 1, At, B1); PG8_BAR; PG8_SCHED;
            PG8_LDB(B0, 1, 0); PG8_LDB(B1, 1, 1); PG8_SCHED; PG8_LDA(At, 1, 0); PG8_STAGE(PG8_SA(0, 1), a2 + hstep, voffA);
            PG8_WAIT_V(8); PG8_WAIT_L(0); PG8_BAR; PG8_MMA(0, 0, At, B0); PG8_MMA(0, 1, At, B1); PG8_BAR; PG8_SCHED;
            PG8_LDA(At, 1, 1); PG8_STAGE(PG8_SB(1, 0), b3, voffB); PG8_STAGE(PG8_SB(1, 1), b3 + hstep, voffB); PG8_STAGE(PG8_SA(1, 0), a3, voffA);
            PG8_WAIT_V(8); PG8_WAIT_L(0); PG8_BAR; PG8_MMA(1, 0, At, B0); PG8_MMA(1, 1, At, B1); PG8_BAR; PG8_SCHED;
            } else {
            PG8_LDB(B0, 0, 0); PG8_SCHED; PG8_LDA(At, 0, 0); PG8_STAGE(PG8_SA(1, 1), a1 + hstep, voffA);
            PG8_WAIT_L(8); PG8_BAR; PG8_WAIT_L(0); PG8_MMA(0, 0, At, B0); PG8_BAR; PG8_SCHED;
            PG8_LDB(B1, 0, 1); PG8_STAGE(PG8_SB(0, 0), b2, voffB);
            PG8_BAR; PG8_WAIT_L(0); PG8_MMA(0, 1, At, B1); PG8_BAR;
            PG8_LDA(At, 0, 1); PG8_STAGE(PG8_SA(0, 0), a2, voffA);
            PG8_BAR; PG8_WAIT_L(0); PG8_MMA(1, 0, At, B0); PG8_BAR; PG8_SCHED;
            PG8_STAGE(PG8_SB(0, 1), b2 + hstep, voffB);
            PG8_WAIT_V(6); PG8_BAR; PG8_MMA(1, 1, At, B1); PG8_BAR;
            PG8_LDB(B0, 1, 0); PG8_SCHED; PG8_LDA(At, 1, 0); PG8_STAGE(PG8_SA(0, 1), a2 + hstep, voffA);
            PG8_WAIT_L(8); PG8_BAR; PG8_WAIT_L(0); PG8_MMA(0, 0, At, B0); PG8_BAR; PG8_SCHED;
            PG8_LDB(B1, 1, 1); PG8_STAGE(PG8_SB(1, 0), b3, voffB);
            PG8_BAR; PG8_WAIT_L(0); PG8_MMA(0, 1, At, B1); PG8_BAR;
            PG8_LDA(At, 1, 1); PG8_STAGE(PG8_SA(1, 0), a3, voffA);
            PG8_BAR; PG8_WAIT_L(0); PG8_MMA(1, 0, At, B0); PG8_BAR; PG8_SCHED;
            PG8_STAGE(PG8_SB(1, 1), b3 + hstep, voffB);
            PG8_WAIT_V(6); PG8_BAR; PG8_MMA(1, 1, At, B1); PG8_BAR;
            }
        }
        if constexpr (ALIGN_EPI) { if (wr == 0) PG8_BAR; }
        if constexpr (!Epi::AFTER_DRAIN) { E(acc, cur, wr, wc, fr, fq); S.done(cur); }
        if (!has_next) break;
#pragma unroll
        for (int a = 0; a < 2; ++a)
#pragma unroll
            for (int b = 0; b < 2; ++b)
#pragma unroll
                for (int m = 0; m < 4; ++m)
#pragma unroll
                    for (int n = 0; n < 2; ++n) acc[a][b][m][n] = (f32x4){0.f, 0.f, 0.f, 0.f};
        cur = nxt; cA = nA; cB = nB; ++ui;
        if constexpr (ALIGN_EPI) { if (wr == 1) PG8_BAR; }
    }
    PG8_WAIT_V(0);
    if constexpr (!ALIGN_EPI) { if (wr == 0) PG8_BAR; }
    PG8_BAR;
    if constexpr (Epi::AFTER_DRAIN) { E.fused(acc, cur, wr, wc, fr, fq, lds, wid, lane); S.done(cur); }
#undef PG8_SA
#undef PG8_SB
#undef PG8_STAGE
#undef PG8_LDA
#undef PG8_LDB
#undef PG8_MMA
#undef PG8_WAIT_V
#undef PG8_WAIT_L
#undef PG8_BAR
#undef PG8_SCHED
}
}
constexpr int NWAVES = 8;
constexpr int BATCH = 8, SEQ = 4096, DM = 1024, T = BATCH * SEQ, DFF = 2816, NBN = T / 64;
constexpr float EPS = 1e-6f, LOG2E_ = 1.4426950408889634f;
constexpr float LAM_INIT = 0.35550906759096934f;
constexpr size_t MiB = 1u << 20;
constexpr size_t WS_CTL = 0, CTL_ZERO_BYTES = 1 * MiB;
constexpr size_t WS_W1T = 2 * MiB, WS_WG1T = 8 * MiB, WS_WO1T = 9 * MiB, WS_WIN0T = 11 * MiB, WS_WOUT0T = 22 * MiB, WS_WKVQT = 28 * MiB, WS_WO2T = 34 * MiB, WS_WIN1T = 36 * MiB, WS_WOUT1T = 47 * MiB;
constexpr size_t WS_COS = 53 * MiB, WS_SIN = 53 * MiB + 512 * 1024, WS_RSTD = 54 * MiB, WS_DEC = 55 * MiB;
constexpr size_t WS_XB = 64 * MiB;
constexpr size_t WS_BIG = 128 * MiB;
constexpr size_t WS_QKVG = WS_BIG;
constexpr size_t WS_QI = 320 * MiB, WS_KET = 352 * MiB, WS_PM = 384 * MiB, WS_VT = 400 * MiB;
constexpr size_t WS_OGATE = 320 * MiB;
constexpr size_t WS_U = WS_BIG;
constexpr size_t WS_ACT = 320 * MiB;
constexpr size_t WS_KR = 128 * MiB, WS_VR = 192 * MiB, WS_QR = 256 * MiB, WS_AO = 320 * MiB;
constexpr size_t WS_UH = 496 * MiB, WS_AH = 507 * MiB, WS_RSTDH = 54 * MiB + 256 * 1024;
constexpr size_t WS_PS = 56 * MiB;
constexpr size_t WS_END = 512 * MiB;
constexpr int CW_BAR = 4096;
constexpr int RING_BYTES = 131072, LDSCTL_OFF = 147456, MISC_OFF = LDSCTL_OFF + 320, LDS_BYTES = 155648;

#define GAS __attribute__((address_space(1)))
#define LAS __attribute__((address_space(3)))
typedef unsigned short bf16;
typedef unsigned v4u __attribute__((ext_vector_type(4)));
typedef unsigned v2u __attribute__((ext_vector_type(2)));
typedef float f32x4 __attribute__((ext_vector_type(4)));
typedef float f32x16 __attribute__((ext_vector_type(16)));
typedef short bf16x8 __attribute__((ext_vector_type(8)));
typedef short s16x4 __attribute__((ext_vector_type(4)));
typedef GAS unsigned gu32;
#define RLX_AGENT __ATOMIC_RELAXED, __HIP_MEMORY_SCOPE_AGENT
#define LDS_WAIT() asm volatile("s_waitcnt lgkmcnt(0)" ::: "memory")
__device__ __forceinline__ unsigned f2bf(float f) { unsigned u = __builtin_bit_cast(unsigned, f); return (u + 0x7fffu + ((u >> 16) & 1u)) >> 16; }
typedef float f32x2_t __attribute__((ext_vector_type(2))); typedef __bf16 bf16x2_t __attribute__((ext_vector_type(2)));
__device__ __forceinline__ unsigned cvtpk(float lo, float hi) { f32x2_t v = {lo, hi}; bf16x2_t b = __builtin_convertvector(v, bf16x2_t); return __builtin_bit_cast(unsigned, b); }
__device__ __forceinline__ unsigned pk2(float lo, float hi) { return cvtpk(lo, hi); }
__device__ __forceinline__ float bf2f(unsigned short x) { return __builtin_bit_cast(float, (unsigned)x << 16); }
__device__ __forceinline__ float bflo(unsigned w) { return __builtin_bit_cast(float, w << 16); }
__device__ __forceinline__ float bfhi(unsigned w) { return __builtin_bit_cast(float, w & 0xffff0000u); }
#define MFMA_BF16(a, b, c) __builtin_amdgcn_mfma_f32_32x32x16_bf16(a, b, c, 0, 0, 0)

#define XB_TMO      128
#define XB_XCNT(j)  (256  + 64 * (j))
#define XB_XSUB(j)  (1280 + 64 * (j))
#define XB_XGEN(j)  (2304 + 64 * (j))
#define XB_TOP      3328
#define XB_TOPGEN   3392
#define XCD_BAR_WORDS 3456
#define XB_SPIN_CAP (1u << 18)

__device__ __forceinline__ unsigned xb_ld(unsigned* p)              { return __hip_atomic_load(p, __ATOMIC_RELAXED, __HIP_MEMORY_SCOPE_AGENT); }
__device__ __forceinline__ unsigned xb_add(unsigned* p, unsigned v) { return __hip_atomic_fetch_add(p, v, __ATOMIC_RELAXED, __HIP_MEMORY_SCOPE_AGENT); }
__device__ __forceinline__ unsigned xb_xcc_id() { return (unsigned)__builtin_amdgcn_s_getreg((3 << 11) | 20) & 0xFu; }
#define XB_SPIN(cond, bar) do { unsigned _sp = 0; while (cond) { __builtin_amdgcn_s_sleep(1); \
    if ((++_sp & 255u) == 0u) { if (xb_ld(&(bar)[XB_TMO])) break; if (_sp > XB_SPIN_CAP) { atomicAdd(&(bar)[XB_TMO], 1u); break; } } } } while (0)

struct XcdBarrier {
    unsigned* bar; unsigned x;
    volatile LAS unsigned* st;
};

__device__ __forceinline__ XcdBarrier xcd_barrier_post(unsigned* bar, volatile LAS unsigned* st) {
    XcdBarrier b; b.bar = bar; b.x = xb_xcc_id(); b.st = st;
    if (threadIdx.x == 0) (void)xb_add(&bar[XB_XCNT(b.x)], 1u);
    return b;
}
__device__ __forceinline__ void xcd_barrier_complete(unsigned* bar, unsigned x, unsigned& nloc, unsigned& nx) {
    const unsigned G = gridDim.x * gridDim.y * gridDim.z;
    unsigned sum, cnt, mine, sp = 0u;
    for (;;) {
        sum = 0u; cnt = 0u; mine = 0u;
#pragma unroll
        for (unsigned j = 0; j < 16; ++j) { const unsigned c = xb_ld(&bar[XB_XCNT(j)]); sum += c; cnt += (c > 0u) ? 1u : 0u; mine = (j == x) ? c : mine; }
        if (sum == G) break;
        __builtin_amdgcn_s_sleep(1);
        if ((++sp & 255u) == 0u) { if (xb_ld(&bar[XB_TMO])) break; if (sp > XB_SPIN_CAP) { atomicAdd(&bar[XB_TMO], 1u); break; } }
    }
    nloc = mine > 0u ? mine : 1u; nx = cnt > 0u ? cnt : 1u;
}

__device__ __forceinline__ void xcd_barrier(const XcdBarrier& b) {
    asm volatile("s_waitcnt vmcnt(0)" ::: "memory");
    __syncthreads();
    if (threadIdx.x == 0) {
        unsigned* bar = b.bar; asm volatile("" : "+s"(bar));
        __builtin_amdgcn_s_waitcnt(0);
        unsigned nloc = b.st[0], nx = b.st[1];
        if (nloc == 0u) { xcd_barrier_complete(bar, b.x, nloc, nx); b.st[0] = nloc; b.st[1] = nx; }
        const unsigned old = xb_add(&bar[XB_XSUB(b.x)], 1u);
        const unsigned gen = old / nloc;
        if (old + 1u == (gen + 1u) * nloc) {
            __builtin_amdgcn_fence(__ATOMIC_RELEASE, "agent");
            asm volatile("s_waitcnt vmcnt(0)" ::: "memory");
            const unsigned og = xb_add(&bar[XB_TOP], 1u);
            const unsigned tg = og / nx;
            if (og + 1u == (tg + 1u) * nx) xb_add(&bar[XB_TOPGEN], 1u);
            else XB_SPIN(xb_ld(&bar[XB_TOPGEN]) == tg, bar);
            __builtin_amdgcn_fence(__ATOMIC_ACQUIRE, "agent");
            xb_add(&bar[XB_XGEN(b.x)], 1u);
            asm volatile("s_waitcnt vmcnt(0)" ::: "memory");
        } else {
            XB_SPIN(xb_ld(&bar[XB_XGEN(b.x)]) == gen, bar);
            __builtin_amdgcn_fence(__ATOMIC_ACQUIRE, "agent");
            asm volatile("s_waitcnt vmcnt(0)" ::: "memory");
        }
    }
    __syncthreads();
}


__device__ __forceinline__ float wave_sum(float v) {
#pragma unroll
    for (int o = 1; o < 64; o <<= 1) v += __shfl_xor(v, o);
    return v;
}

struct Args { const float* in[20]; float* out; unsigned char* ws; int ph_lo, ph_hi; };
enum { I_X = 0, I_ATTN_NORM, I_FFN_NORM, I_WQKVG, I_WGK1, I_WGK2, I_BGK, I_ONORM, I_GLA_WO, I_KVNORM, I_WKV, I_WQ, I_LAMBDA, I_SUBLN, I_DIFF_WO, I_WIN, I_CONVW, I_CONVB, I_WOUT, I_FINAL };

template <int MAP> __device__ __forceinline__ int map_row(int s) {
    if (MAP == 0) return s;
    if (MAP == 1) { const int half = s >= DFF ? 1 : 0, j = s - half * DFF; return (j >> 7) * 256 + half * 128 + (j & 127); }
    const int tile = s >> 8, cidx = (s >> 6) & 3, d = s & 63, bj = cidx >> 1, wcp = cidx & 1, n = d >> 5, dd = d & 31;
    return tile * 256 + 128 * bj + 32 * (2 * wcp + (dd >> 4)) + 16 * n + 4 * ((dd & 15) >> 2) + (dd & 3);
}
template <int MAP> __device__ __forceinline__ void transpose_item(const float* W, int ldw, int K, int N, const float* gain, float scale, bf16* WT, int row_off, LAS float* scr, int item, int lane) {
    const int nblk = N / 32, kb = item / nblk, nb = item % nblk, k0 = 64 * kb, n0 = 32 * nb;
#pragma unroll
    for (int i = 0; i < 8; ++i) { const int kk = 8 * i + (lane >> 3), n4 = (lane & 7) * 4; const float g = gain ? gain[k0 + kk] * scale : scale;
        const f32x4 w = *(const f32x4*)(W + (size_t)(k0 + kk) * ldw + n0 + n4);
        scr[kk * 33 + n4] = w[0] * g; scr[kk * 33 + n4 + 1] = w[1] * g; scr[kk * 33 + n4 + 2] = w[2] * g; scr[kk * 33 + n4 + 3] = w[3] * g; }
    LDS_WAIT(); asm volatile("" ::: "memory");
    const int c = lane & 7;
#pragma unroll
    for (int j = 0; j < 4; ++j) { const int n = (lane >> 3) + 8 * j; const LAS float* s = scr + (8 * c) * 33 + n;
        v4u o; o.x = pk2(s[0 * 33], s[1 * 33]); o.y = pk2(s[2 * 33], s[3 * 33]); o.z = pk2(s[4 * 33], s[5 * 33]); o.w = pk2(s[6 * 33], s[7 * 33]);
        *(v4u*)(WT + (size_t)(row_off + map_row<MAP>(n0 + n)) * K + k0 + 8 * c) = o; }
    LDS_WAIT(); asm volatile("" ::: "memory");
}
__device__ __forceinline__ void sincos_d(double x, double& s, double& c) {
    const double k = __builtin_rint(x * 0.15915494309189535);
    double r = __builtin_fma(-k, 6.283185307179586, x); r = __builtin_fma(-k, 2.4492935982947064e-16, r);
    const double y = r * 0.25, y2 = y * y;
    double sy = 1.0 - y2 * (1.0 / 272.0);
    sy = 1.0 - y2 * (1.0 / 210.0) * sy; sy = 1.0 - y2 * (1.0 / 156.0) * sy; sy = 1.0 - y2 * (1.0 / 110.0) * sy; sy = 1.0 - y2 * (1.0 / 72.0) * sy;
    sy = 1.0 - y2 * (1.0 / 42.0) * sy; sy = 1.0 - y2 * (1.0 / 20.0) * sy; sy = 1.0 - y2 * (1.0 / 6.0) * sy; sy = y * sy;
    double cy = 1.0 - y2 * (1.0 / 240.0);
    cy = 1.0 - y2 * (1.0 / 182.0) * cy; cy = 1.0 - y2 * (1.0 / 132.0) * cy; cy = 1.0 - y2 * (1.0 / 90.0) * cy; cy = 1.0 - y2 * (1.0 / 56.0) * cy;
    cy = 1.0 - y2 * (1.0 / 30.0) * cy; cy = 1.0 - y2 * (1.0 / 12.0) * cy; cy = 1.0 - y2 * 0.5 * cy;
    const double s2 = 2.0 * sy * cy, c2 = 1.0 - 2.0 * sy * sy;
    s = 2.0 * s2 * c2; c = 1.0 - 2.0 * s2 * s2;
}
__device__ __forceinline__ void row_to_bf16_ps(const float* xrow, bf16* orow, float* ps_row, int lane) {
    const f32x4* xr = (const f32x4*)xrow + lane;
    f32x4 v[4]; float s = 0.f;
#pragma unroll
    for (int j = 0; j < 4; ++j) { v[j] = xr[64 * j]; s += (v[j].x * v[j].x + v[j].y * v[j].y) + (v[j].z * v[j].z + v[j].w * v[j].w); }
    s = wave_sum(s);
    if (lane < 16) ps_row[lane] = lane == 0 ? s : 0.f;
    unsigned long long* o8 = (unsigned long long*)orow + lane;
#pragma unroll
    for (int j = 0; j < 4; ++j) o8[64 * j] = (unsigned long long)pk2(v[j].x, v[j].y) | ((unsigned long long)pk2(v[j].z, v[j].w) << 32);
}
__device__ __forceinline__ void p0_prologue(const Args& A, LAS unsigned char* lds, int vcu, int G, int wave, int lane, int tid) {
    unsigned char* ws = A.ws;
    LAS float* scr = (LAS float*)(lds + wave * 16384);
    const int gw = vcu * NWAVES + wave, NGW = G * NWAVES;
    constexpr int I0 = (DM / 64) * (3072 / 32), I1 = (DM / 64) * (DM / 32), I2 = (DM / 64) * (2 * DFF / 32), I3 = (DFF / 64) * (DM / 32);
    constexpr int NITEMS = I0 + I1 + I2 + I3 + 3 * I1 + I1 + I2 + I3;
    const float QS = 0.18033688011112042f;
    for (int it = gw; it < NITEMS; it += NGW) {
        int r = it;
        if (r < I0) { transpose_item<0>(A.in[I_WQKVG], 3072, DM, 3072, A.in[I_ATTN_NORM], 1.f, (bf16*)(ws + WS_W1T), 0, scr, r, lane); continue; } r -= I0;
        if (r < I1) { transpose_item<0>(A.in[I_GLA_WO], DM, DM, DM, nullptr, 1.f, (bf16*)(ws + WS_WO1T), 0, scr, r, lane); continue; } r -= I1;
        if (r < I2) { transpose_item<1>(A.in[I_WIN], 2 * DFF, DM, 2 * DFF, A.in[I_FFN_NORM], 1.f, (bf16*)(ws + WS_WIN0T), 0, scr, r, lane); continue; } r -= I2;
        if (r < I3) { transpose_item<0>(A.in[I_WOUT], DM, DFF, DM, nullptr, 1.f, (bf16*)(ws + WS_WOUT0T), 0, scr, r, lane); continue; } r -= I3;
        if (r < I1) { transpose_item<2>(A.in[I_WKV], 2048, DM, 1024, A.in[I_KVNORM], 1.f, (bf16*)(ws + WS_WKVQT), 0, scr, r, lane); continue; } r -= I1;
        if (r < I1) { transpose_item<0>(A.in[I_WKV] + 1024, 2048, DM, 1024, A.in[I_KVNORM], 1.f, (bf16*)(ws + WS_WKVQT), 1024, scr, r, lane); continue; } r -= I1;
        if (r < I1) { transpose_item<2>(A.in[I_WQ], DM, DM, 1024, A.in[I_ATTN_NORM] + DM, QS, (bf16*)(ws + WS_WKVQT), 2048, scr, r, lane); continue; } r -= I1;
        if (r < I1) { transpose_item<0>(A.in[I_DIFF_WO], DM, DM, DM, nullptr, 1.f, (bf16*)(ws + WS_WO2T), 0, scr, r, lane); continue; } r -= I1;
        if (r < I2) { transpose_item<1>(A.in[I_WIN] + (size_t)DM * 2 * DFF, 2 * DFF, DM, 2 * DFF, A.in[I_FFN_NORM] + DM, 1.f, (bf16*)(ws + WS_WIN1T), 0, scr, r, lane); continue; } r -= I2;
        transpose_item<0>(A.in[I_WOUT] + (size_t)DFF * DM, DM, DFF, DM, nullptr, 1.f, (bf16*)(ws + WS_WOUT1T), 0, scr, r, lane);
    }
    const int gt = vcu * (NWAVES * 64) + tid, NGT = G * NWAVES * 64;
    for (int i = gt; i < 32 * DM; i += NGT) { const int j = i >> 10, k = i & 1023; ((bf16*)(ws + WS_WG1T))[i] = j < 16 ? (bf16)f2bf(A.in[I_WGK1][k * 16 + j] * A.in[I_ATTN_NORM][k]) : (bf16)0; }
    for (int i = gt; i < SEQ * 32; i += NGT) { const int pos = i >> 5, fi = i & 31; double inv = 1.0; for (int q = 0; q < fi; ++q) inv *= 0.7498942093324558;
        double s, c; sincos_d((double)pos * inv, s, c); ((float*)(ws + WS_COS))[i] = (float)c; ((float*)(ws + WS_SIN))[i] = (float)s; }
    for (int i = gt; i < 1024 * DM / 8; i += NGT) ((v4u*)(ws + WS_AH))[i] = (v4u){0u, 0u, 0u, 0u};
    for (int m = gw; m < T; m += 2 * NGW) {
        const int m2 = m + NGW; const bool h2 = m2 < T;
        const f32x4* xa = (const f32x4*)(A.in[I_X] + (size_t)m * DM) + lane; const f32x4* xb2 = (const f32x4*)(A.in[I_X] + (size_t)(h2 ? m2 : m) * DM) + lane;
        f32x4 va[4], vb[4]; float sa = 0.f, sb = 0.f;
#pragma unroll
        for (int j = 0; j < 4; ++j) { va[j] = xa[64 * j]; vb[j] = xb2[64 * j]; }
#pragma unroll
        for (int j = 0; j < 4; ++j) { sa += (va[j].x * va[j].x + va[j].y * va[j].y) + (va[j].z * va[j].z + va[j].w * va[j].w); sb += (vb[j].x * vb[j].x + vb[j].y * vb[j].y) + (vb[j].z * vb[j].z + vb[j].w * vb[j].w); }
        sa = wave_sum(sa); sb = wave_sum(sb);
        if (lane == 0) { ((float*)(ws + WS_RSTD))[m] = __builtin_amdgcn_rsqf(sa * (1.0f / DM) + EPS); if (h2) ((float*)(ws + WS_RSTD))[m2] = __builtin_amdgcn_rsqf(sb * (1.0f / DM) + EPS); }
        unsigned long long* oa = (unsigned long long*)((bf16*)(ws + WS_XB) + (size_t)m * DM) + lane; unsigned long long* ob = (unsigned long long*)((bf16*)(ws + WS_XB) + (size_t)m2 * DM) + lane;
#pragma unroll
        for (int j = 0; j < 4; ++j) { oa[64 * j] = (unsigned long long)pk2(va[j].x, va[j].y) | ((unsigned long long)pk2(va[j].z, va[j].w) << 32);
            if (h2) ob[64 * j] = (unsigned long long)pk2(vb[j].x, vb[j].y) | ((unsigned long long)pk2(vb[j].z, vb[j].w) << 32); }
    }
}

__device__ __forceinline__ void final_norm_phase(const bf16* HB, const float* PS, float* out, const float* w, int vcu, int G, int wave, int lane) {
    const int gw = vcu * NWAVES + wave, NGW = G * NWAVES;
    const f32x4* wp = (const f32x4*)w + 2 * lane; const f32x4 w00 = wp[0], w01 = wp[1], w10 = wp[128], w11 = wp[129];
    for (int m0 = gw; m0 < T; m0 += 4 * NGW) {
        v4u r0[4], r1[4]; float rs[4];
#pragma unroll
        for (int q = 0; q < 4; ++q) { const int m = m0 + q * NGW; const int mm = m < T ? m : m0; const v4u* hp = (const v4u*)(HB + (size_t)mm * DM) + lane; r0[q] = hp[0]; r1[q] = hp[64]; rs[q] = pg8::rstd_ps(PS, mm); }
#pragma unroll
        for (int q = 0; q < 4; ++q) { const int m = m0 + q * NGW; if (m < T) { f32x4* op = (f32x4*)(out + (size_t)m * DM) + 2 * lane; const float rstd = rs[q];
            f32x4 a, b; a[0] = bflo(r0[q].x); a[1] = bfhi(r0[q].x); a[2] = bflo(r0[q].y); a[3] = bfhi(r0[q].y); b[0] = bflo(r0[q].z); b[1] = bfhi(r0[q].z); b[2] = bflo(r0[q].w); b[3] = bfhi(r0[q].w);
            op[0] = a * rstd * w00; op[1] = b * rstd * w01;
            a[0] = bflo(r1[q].x); a[1] = bfhi(r1[q].x); a[2] = bflo(r1[q].y); a[3] = bfhi(r1[q].y); b[0] = bflo(r1[q].z); b[1] = bfhi(r1[q].z); b[2] = bflo(r1[q].w); b[3] = bfhi(r1[q].w);
            op[128] = a * rstd * w10; op[129] = b * rstd * w11; } }
    }
}
__device__ __forceinline__ void gla_gate_phase(const bf16* O, const bf16* QKVG, const float* onw, bf16* OG, int vcu, int G, int wave, int lane) {
    const int gw = vcu * NWAVES + wave, NGW = G * NWAVES;
    const f32x4* wp = (const f32x4*)(onw + 16 * (lane & 15)); const f32x4 wq[4] = {wp[0], wp[1], wp[2], wp[3]};
    for (int m0 = gw; m0 < T; m0 += 4 * NGW) {
        v4u o0[4], o1[4], g0[4], g1[4];
#pragma unroll
        for (int q = 0; q < 4; ++q) { const int m = m0 + q * NGW; const int mm = m < T ? m : m0; const v4u* op = (const v4u*)(O + (size_t)mm * DM + 16 * lane); const v4u* gp = (const v4u*)(QKVG + (size_t)mm * 3072 + 2048 + 16 * lane);
            o0[q] = op[0]; o1[q] = op[1]; g0[q] = gp[0]; g1[q] = gp[1]; }
#pragma unroll
        for (int q = 0; q < 4; ++q) { const int m = m0 + q * NGW; if (m < T) {
            float ov[16], gv[16];
#pragma unroll
            for (int i = 0; i < 4; ++i) { ov[2 * i] = bflo(o0[q][i]); ov[2 * i + 1] = bfhi(o0[q][i]); ov[8 + 2 * i] = bflo(o1[q][i]); ov[8 + 2 * i + 1] = bfhi(o1[q][i]);
                                          gv[2 * i] = bflo(g0[q][i]); gv[2 * i + 1] = bfhi(g0[q][i]); gv[8 + 2 * i] = bflo(g1[q][i]); gv[8 + 2 * i + 1] = bfhi(g1[q][i]); }
            float s = 0.f;
#pragma unroll
            for (int i = 0; i < 16; ++i) s += ov[i] * ov[i];
            s += __shfl_xor(s, 1); s += __shfl_xor(s, 2); s += __shfl_xor(s, 4); s += __shfl_xor(s, 8);
            const float rstd = __builtin_amdgcn_rsqf(s * (1.0f / 256.0f) + EPS);
            float r[16];
#pragma unroll
            for (int k = 0; k < 4; ++k)
#pragma unroll
                for (int i = 0; i < 4; ++i) { const float g = gv[4 * k + i]; r[4 * k + i] = ov[4 * k + i] * rstd * wq[k][i] * (g * __builtin_amdgcn_rcpf(1.0f + __builtin_amdgcn_exp2f(-LOG2E_ * g))); }
            v4u w0, w1;
#pragma unroll
            for (int i = 0; i < 4; ++i) { w0[i] = pk2(r[2 * i], r[2 * i + 1]); w1[i] = pk2(r[8 + 2 * i], r[8 + 2 * i + 1]); }
            v4u* dp = (v4u*)(OG + (size_t)m * DM + 16 * lane); dp[0] = w0; dp[1] = w1; } }
    }
}
constexpr float LOG2E = 1.4426950408889634f, LN2 = 0.6931471805599453f;
__device__ __forceinline__ void gla_pre_unit(const Args& A, int bn, LAS unsigned char* lds, int tid_in, int wave) {
    int tid = tid_in; asm volatile("" : "+v"(tid)); const int lane = tid & 63;
    unsigned char* ws = A.ws;
    const bf16* XB = (const bf16*)(ws + WS_XB); const bf16* WG1T = (const bf16*)(ws + WS_WG1T); const float* PS = (const float*)(ws + WS_PS);
    const bf16* QKVG = (const bf16*)(ws + WS_QKVG);
    bf16* QIG = (bf16*)(ws + WS_QI); bf16* KIG = (bf16*)(ws + WS_KET); bf16* PM = (bf16*)(ws + WS_PM); float* DEC = (float*)(ws + WS_DEC);
    const int row0 = bn * 64, cl = lane & 31, h = lane >> 5;
    LAS float* r_lds = (LAS float*)lds;
    LAS float* part = (LAS float*)(lds + 4608);
    LAS unsigned char* QIl = lds + 4608;
    LAS unsigned char* KIl = lds + 4608 + 69632;
    v4u qraw[8], kraw[8];
#pragma unroll
    for (int q = 0; q < 8; ++q) { const int idx = tid + 512 * q, t = idx >> 6, ch8 = idx & 63; const bf16* p = QKVG + (size_t)(row0 + t) * 3072 + ch8 * 8; qraw[q] = *(const v4u*)p; kraw[q] = *(const v4u*)(p + 512); }
    {
        bf16x8 bfr[8], afr[2][8];
        const bf16* bp = WG1T + (size_t)cl * DM + 128 * wave + 8 * h;
#pragma unroll
        for (int s = 0; s < 8; ++s) bfr[s] = *(const bf16x8*)(bp + 16 * s);
#pragma unroll
        for (int rb = 0; rb < 2; ++rb) { const bf16* ap = XB + (size_t)(row0 + 32 * rb + cl) * DM + 128 * wave + 8 * h;
#pragma unroll
            for (int s = 0; s < 8; ++s) afr[rb][s] = *(const bf16x8*)(ap + 16 * s); }
        __builtin_amdgcn_sched_barrier(0);
#pragma unroll
        for (int rb = 0; rb < 2; ++rb) {
            f32x16 acc = {};
#pragma unroll
            for (int s = 0; s < 8; ++s) acc = MFMA_BF16(afr[rb][s], bfr[s], acc);
            if (cl < 16) {
#pragma unroll
                for (int i = 0; i < 16; ++i) { const int row = 32 * rb + (i & 3) + 8 * (i >> 2) + 4 * h; part[(wave * 64 + row) * 16 + cl] = acc[i]; }
            }
        }
    }
    __syncthreads();
    float rsum[2];
#pragma unroll
    for (int q = 0; q < 2; ++q) { const int idx = tid + 512 * q, row = idx >> 4, j = idx & 15; float s = 0.f;
#pragma unroll
        for (int w = 0; w < 8; ++w) s += part[(w * 64 + row) * 16 + j];
        rsum[q] = s * ((const float*)(ws + WS_RSTD))[row0 + row]; }
    __syncthreads();
#pragma unroll
    for (int q = 0; q < 2; ++q) { const int idx = tid + 512 * q, row = idx >> 4, j = idx & 15; r_lds[row * 17 + j] = rsum[q]; }
#pragma unroll
    for (int q = 0; q < 8; ++q) { const int idx = tid + 512 * q, t = idx >> 6, ch8 = idx & 63, hd2 = ch8 >> 4, cc2 = (ch8 & 15) * 8; const int off = ((hd2 * 64 + t) * 136 + cc2) * 2;
        *(LAS v4u*)(QIl + off) = qraw[q]; *(LAS v4u*)(KIl + off) = kraw[q]; }
    __syncthreads();
    const int hd = wave >> 1, chh = wave & 1;
#pragma unroll 1
    for (int cb = 0; cb < 2; ++cb) {
        const int cc = 64 * chh + 32 * cb + cl, c = hd * 128 + cc;
        const float bias = A.in[I_BGK][c];
        float pre = 0.f;
#pragma unroll 1
        for (int rb = 0; rb < 2; ++rb) {
            f32x16 x = {};
#pragma unroll
            for (int s = 0; s < 8; ++s) { const float a = r_lds[(32 * rb + cl) * 17 + 2 * s + h]; const float b = A.in[I_WGK2][(2 * s + h) * 512 + c]; x = __builtin_amdgcn_mfma_f32_32x32x2f32(a, b, x, 0, 0, 0); }
#pragma unroll
            for (int i = 0; i < 16; ++i) { const float v = x[i] + bias; const float e = __builtin_amdgcn_exp2f(-fabsf(v) * LOG2E);
                x[i] = (fminf(v, 0.f) - __builtin_amdgcn_logf(1.0f + e) * LN2) * (0.0625f * LOG2E); }
#pragma unroll
            for (int g = 0; g < 4; ++g) {
                const float own = (x[4 * g] + x[4 * g + 1]) + (x[4 * g + 2] + x[4 * g + 3]); const float oth = __shfl_xor(own, 32);
                const float start = pre + (h ? oth : 0.f);
                x[4 * g] += start; x[4 * g + 1] += x[4 * g]; x[4 * g + 2] += x[4 * g + 1]; x[4 * g + 3] += x[4 * g + 2];
                pre += own + oth;
            }
#pragma unroll
            for (int i = 0; i < 16; ++i) { const int t = 32 * rb + (i & 3) + 8 * (i >> 2) + 4 * h; const int off = ((hd * 64 + t) * 136 + cc) * 2;
                const float qv = bf2f(*(const LAS bf16*)(QIl + off)), kv = bf2f(*(const LAS bf16*)(KIl + off)); const float bb = x[i];
                const float qi = qv * 0.08838834764831845f * __builtin_amdgcn_exp2f(bb), ki = kv * __builtin_amdgcn_exp2f(-bb);
                *(LAS bf16*)(QIl + off) = (bf16)(cvtpk(qi, 0.f) & 0xffffu); *(LAS bf16*)(KIl + off) = (bf16)(cvtpk(ki, 0.f) & 0xffffu); }
        }
        if (h == 0) DEC[bn * 512 + c] = __builtin_amdgcn_exp2f(pre);
    }
    __syncthreads();
#pragma unroll
    for (int q = 0; q < 8; ++q) { const int idx = tid + 512 * q, t = idx >> 6, ch8 = idx & 63, hd2 = ch8 >> 4, cc2 = (ch8 & 15) * 8;
        const v4u kv = *(const LAS v4u*)(KIl + ((hd2 * 64 + t) * 136 + cc2) * 2); *(v4u*)(KIG + (size_t)(row0 + t) * 512 + hd2 * 128 + cc2) = kv;
        const int c0 = (cc2 & ~15) + 4 * ((cc2 >> 3) & 1);
        const v2u qa = *(const LAS v2u*)(QIl + ((hd2 * 64 + t) * 136 + c0) * 2), qb = *(const LAS v2u*)(QIl + ((hd2 * 64 + t) * 136 + c0 + 8) * 2);
        v4u qv; qv.x = qa.x; qv.y = qa.y; qv.z = qb.x; qv.w = qb.y; *(v4u*)(QIG + (size_t)(row0 + t) * 512 + hd2 * 128 + cc2) = qv; }
    { const int rb = wave & 1; const int t = 32 * rb + cl;
#pragma unroll
        for (int cbp = 0; cbp < 2; ++cbp) {
            f32x16 acc = {};
#pragma unroll
            for (int s = 0; s < 8; ++s) { const bf16x8 a = *(const LAS bf16x8*)(KIl + ((hd * 64 + 32 * cbp + cl) * 136 + 16 * s + 8 * h) * 2), b = *(const LAS bf16x8*)(QIl + ((hd * 64 + 32 * rb + cl) * 136 + 16 * s + 8 * h) * 2); acc = MFMA_BF16(a, b, acc); }
#pragma unroll
            for (int g = 0; g < 4; ++g) { const int tp0 = 32 * cbp + 8 * g + 4 * h; float v[4];
#pragma unroll
                for (int ii = 0; ii < 4; ++ii) v[ii] = (tp0 + ii <= t) ? acc[4 * g + ii] : 0.f;
                v2u w; w.x = pk2(v[0], v[1]); w.y = pk2(v[2], v[3]); *(v2u*)(PM + ((size_t)(bn * 4 + hd) * 64 + t) * 64 + tp0) = w; }
        }
    }
    __syncthreads();
}

constexpr int SL_P = 0, SL_QI = 9216, SL_KI = 26624, SL_V = 47104, SL_DEC = 51200, SL_BYTES = 51712;
struct SeqRegs { v4u p, q0, q1, k0, k1, x; };
__device__ __forceinline__ void seq_fetch(SeqRegs& R, const unsigned char* ws, int bn, int hd, int es, int tid) {
    const bf16* QIG = (const bf16*)(ws + WS_QI); const bf16* KIG = (const bf16*)(ws + WS_KET); const bf16* PM = (const bf16*)(ws + WS_PM); const bf16* QKVG = (const bf16*)(ws + WS_QKVG); const float* DEC = (const float*)(ws + WS_DEC);
    const int row0 = bn * 64;
    R.p = *(const v4u*)(PM + ((size_t)(bn * 4 + hd) * 64 + (tid >> 3)) * 64 + (tid & 7) * 8);
    { const int t = tid >> 4, c16 = tid & 15; const size_t o0 = (size_t)(row0 + t) * 512 + hd * 128 + c16 * 8, o1 = o0 + (size_t)32 * 512;
      R.q0 = *(const v4u*)(QIG + o0); R.q1 = *(const v4u*)(QIG + o1); R.k0 = *(const v4u*)(KIG + o0); R.k1 = *(const v4u*)(KIG + o1); }
    if (tid < 256) R.x = *(const v4u*)(QKVG + (size_t)(row0 + (tid >> 2)) * 3072 + 1024 + hd * 256 + 32 * es + (tid & 3) * 8);
    else if (tid < 288) R.x = *(const v4u*)(DEC + bn * 512 + hd * 128 + (tid - 256) * 4);
}
__device__ __forceinline__ void seq_put(const SeqRegs& R, LAS unsigned char* slot, int tid) {
    *(LAS v4u*)(slot + SL_P + (tid >> 3) * 144 + (tid & 7) * 16) = R.p;
    { const int t = tid >> 4, c16 = tid & 15;
      *(LAS v4u*)(slot + SL_QI + t * 272 + c16 * 16) = R.q0; *(LAS v4u*)(slot + SL_QI + (t + 32) * 272 + c16 * 16) = R.q1;
      *(LAS v4u*)(slot + SL_KI + t * 320 + c16 * 16) = R.k0; *(LAS v4u*)(slot + SL_KI + (t + 32) * 320 + c16 * 16) = R.k1; }
    if (tid < 256) *(LAS v4u*)(slot + SL_V + (tid >> 2) * 64 + (tid & 3) * 16) = R.x;
    else if (tid < 288) *(LAS v4u*)(slot + SL_DEC + (tid - 256) * 16) = R.x;
}
#define LTR(p) __builtin_bit_cast(s16x4, __builtin_amdgcn_ds_read_tr16_b64_v4i16((LAS s16x4*)(p)))
__device__ __forceinline__ void seq_out(LAS unsigned char* slot, const LAS unsigned char* sfr, bf16* O, int row0, int ocol, int rb, int lane) {
    const int cl = lane & 31, h = lane >> 5;
    const int trb = (8 * h + ((lane & 15) >> 2)), trc = (16 * ((lane >> 4) & 1) + 4 * (lane & 3)) * 2;
    bf16x8 vt[4], pf[4], sa[4], qw[4];
#pragma unroll
    for (int s = 0; s < 4; ++s) { const s16x4 lo = LTR(slot + SL_V + (16 * s + trb) * 64 + trc), hi = LTR(slot + SL_V + (16 * s + 4 + trb) * 64 + trc); vt[s] = (bf16x8){lo[0], lo[1], lo[2], lo[3], hi[0], hi[1], hi[2], hi[3]}; }
#pragma unroll
    for (int s = 0; s < 4; ++s) pf[s] = *(const LAS bf16x8*)(slot + SL_P + (32 * rb + cl) * 144 + (16 * s + 8 * h) * 2);
#pragma unroll
    for (int i = 0; i < 4; ++i) { sa[i] = *(const LAS bf16x8*)(sfr + i * 1024 + lane * 16); qw[i] = *(const LAS bf16x8*)(slot + SL_QI + (32 * rb + cl) * 272 + (16 * i + 8 * h) * 2); }
    __builtin_amdgcn_sched_barrier(0);
    f32x16 acc = {};
#pragma unroll
    for (int s = 0; s < 4; ++s) acc = MFMA_BF16(vt[s], pf[s], acc);
    __builtin_amdgcn_sched_barrier(0);
#pragma unroll
    for (int i = 0; i < 4; ++i) { vt[i] = *(const LAS bf16x8*)(sfr + (4 + i) * 1024 + lane * 16); pf[i] = *(const LAS bf16x8*)(slot + SL_QI + (32 * rb + cl) * 272 + (16 * (4 + i) + 8 * h) * 2); }
    __builtin_amdgcn_sched_barrier(0);
#pragma unroll
    for (int i = 0; i < 4; ++i) acc = MFMA_BF16(sa[i], qw[i], acc);
#pragma unroll
    for (int i = 0; i < 4; ++i) acc = MFMA_BF16(vt[i], pf[i], acc);
#pragma unroll
    for (int g = 0; g < 4; ++g) { v2u w; w.x = cvtpk(acc[4 * g], acc[4 * g + 1]); w.y = cvtpk(acc[4 * g + 2], acc[4 * g + 3]);
        *(v2u*)(O + (size_t)(row0 + 32 * rb + cl) * DM + ocol + 8 * g + 4 * h) = w; }
}
__device__ __forceinline__ void seq_state(f32x16 (&S)[2], LAS unsigned char* slot, LAS unsigned char* sfw, int blk0, int lane) {
    const int h = lane >> 5;
    const int trb = (8 * h + ((lane & 15) >> 2)), trc = (16 * ((lane >> 4) & 1) + 4 * (lane & 3)) * 2;
    bf16x8 vt[4];
#pragma unroll
    for (int s = 0; s < 4; ++s) { const s16x4 lo = LTR(slot + SL_V + (16 * s + trb) * 64 + trc), hi = LTR(slot + SL_V + (16 * s + 4 + trb) * 64 + trc); vt[s] = (bf16x8){lo[0], lo[1], lo[2], lo[3], hi[0], hi[1], hi[2], hi[3]}; }
#pragma unroll
    for (int bi = 0; bi < 2; ++bi) { const int blk = blk0 + bi;
        bf16x8 ke[4];
#pragma unroll
        for (int s = 0; s < 4; ++s) { const s16x4 lo = LTR(slot + SL_KI + (16 * s + trb) * 320 + 64 * blk + trc), hi = LTR(slot + SL_KI + (16 * s + 4 + trb) * 320 + 64 * blk + trc);
            ke[s] = (bf16x8){lo[0], lo[1], lo[2], lo[3], hi[0], hi[1], hi[2], hi[3]}; }
#pragma unroll
        for (int s = 0; s < 4; ++s) S[bi] = MFMA_BF16(ke[s], vt[s], S[bi]);
#pragma unroll
        for (int g = 0; g < 4; ++g) { const f32x4 d4 = *(const LAS f32x4*)(slot + SL_DEC + (32 * blk + 8 * g + 4 * h) * 4);
#pragma unroll
            for (int ii = 0; ii < 4; ++ii) S[bi][4 * g + ii] *= d4[ii]; }
#pragma unroll
        for (int sp = 0; sp < 2; ++sp) { v4u sw; sw.x = cvtpk(S[bi][8 * sp], S[bi][8 * sp + 1]); sw.y = cvtpk(S[bi][8 * sp + 2], S[bi][8 * sp + 3]); sw.z = cvtpk(S[bi][8 * sp + 4], S[bi][8 * sp + 5]); sw.w = cvtpk(S[bi][8 * sp + 6], S[bi][8 * sp + 7]);
            *(LAS v4u*)(sfw + (2 * blk + sp) * 1024 + lane * 16) = sw; }
    }
}
constexpr int SEQ_SF = 2 * SL_BYTES;
__device__ __forceinline__ void seq_touch(unsigned& d0, unsigned& d1, const unsigned char* ws, int bn, int hd, int es, int t  ) {
    const bf16* QIG = (const bf16*)(ws + WS_QI); const bf16* KIG = (const bf16*)(ws + WS_KET); const bf16* PM = (const bf16*)(ws + WS_PM); const bf16* QKVG = (const bf16*)(ws + WS_QKVG); const float* DEC = (const float*)(ws + WS_DEC);
    const int row0 = bn * 64;
    const bf16* p0;
    if (t < 64) p0 = PM + (size_t)(bn * 4 + hd) * 4096 + t * 64;
    else if (t < 192) p0 = QIG + (size_t)(row0 + ((t - 64) >> 1)) * 512 + hd * 128 + ((t - 64) & 1) * 64;
    else p0 = QKVG + (size_t)(row0 + (t - 192)) * 3072 + 1024 + hd * 256 + 32 * es;
    d0 = *(const unsigned*)p0;
    if (t < 128) d1 = *(const unsigned*)(KIG + (size_t)(row0 + (t >> 1)) * 512 + hd * 128 + (t & 1) * 64);
    else if (t < 132) d1 = *(const unsigned*)(DEC + bn * 512 + hd * 128 + (t - 128) * 32);
}
struct SeqRegs4 { v4u p[2], q[4], k[4], x, d; };
__device__ __forceinline__ void seq_fetch4(SeqRegs4& R, const unsigned char* ws, int bn, int hd, int es, int lt) {
    const bf16* QIG = (const bf16*)(ws + WS_QI); const bf16* KIG = (const bf16*)(ws + WS_KET); const bf16* PM = (const bf16*)(ws + WS_PM); const bf16* QKVG = (const bf16*)(ws + WS_QKVG); const float* DEC = (const float*)(ws + WS_DEC);
    const int row0 = bn * 64;
#pragma unroll
    for (int j = 0; j < 2; ++j) { const int idx = lt + 256 * j; R.p[j] = *(const v4u*)(PM + ((size_t)(bn * 4 + hd) * 64 + (idx >> 3)) * 64 + (idx & 7) * 8); }
#pragma unroll
    for (int j = 0; j < 4; ++j) { const int idx = lt + 256 * j, t = idx >> 4, c16 = idx & 15; const size_t o = (size_t)(row0 + t) * 512 + hd * 128 + c16 * 8; R.q[j] = *(const v4u*)(QIG + o); R.k[j] = *(const v4u*)(KIG + o); }
    R.x = *(const v4u*)(QKVG + (size_t)(row0 + (lt >> 2)) * 3072 + 1024 + hd * 256 + 32 * es + (lt & 3) * 8);
    if (lt < 32) R.d = *(const v4u*)(DEC + bn * 512 + hd * 128 + lt * 4);
}
__device__ __forceinline__ void seq_put4(const SeqRegs4& R, LAS unsigned char* slot, int lt) {
#pragma unroll
    for (int j = 0; j < 2; ++j) { const int idx = lt + 256 * j; *(LAS v4u*)(slot + SL_P + (idx >> 3) * 144 + (idx & 7) * 16) = R.p[j]; }
#pragma unroll
    for (int j = 0; j < 4; ++j) { const int idx = lt + 256 * j, t = idx >> 4, c16 = idx & 15; *(LAS v4u*)(slot + SL_QI + t * 272 + c16 * 16) = R.q[j]; *(LAS v4u*)(slot + SL_KI + t * 320 + c16 * 16) = R.k[j]; }
    *(LAS v4u*)(slot + SL_V + (lt >> 2) * 64 + (lt & 3) * 16) = R.x;
    if (lt < 32) *(LAS v4u*)(slot + SL_DEC + lt * 16) = R.d;
}
__device__ __forceinline__ void gla_seq_unit(const Args& A, int u, LAS unsigned char* lds, int tid_in, int wave) {
    int tid = tid_in; asm volatile("" : "+v"(tid)); const int lane = tid & 63;
    unsigned char* ws = A.ws; bf16* O = (bf16*)(ws + WS_XB);
    const int b = u >> 5, hd = (u >> 3) & 3, es = u & 7;
    for (int i = tid; i < 8192 / 16; i += 512) *(LAS v4u*)(lds + SEQ_SF + i * 16) = (v4u){0u, 0u, 0u, 0u};
    if (wave >= 4) {
        const int lt = tid - 256;
        SeqRegs4 L0, L1, L2, L3;
        seq_fetch4(L0, ws, b * 64, hd, es, lt); seq_fetch4(L1, ws, b * 64 + 1, hd, es, lt); seq_fetch4(L2, ws, b * 64 + 2, hd, es, lt); seq_fetch4(L3, ws, b * 64 + 3, hd, es, lt);
        seq_put4(L0, lds, lt); seq_fetch4(L0, ws, b * 64 + 4, hd, es, lt);
        __syncthreads();
#define SEQ_LOAD(n, R) do { if ((n) + 1 < 64) { seq_put4(R, lds + (((n) + 1) & 1) * SL_BYTES, lt); if ((n) + 5 < 64) seq_fetch4(R, ws, b * 64 + (n) + 5, hd, es, lt); } __syncthreads(); } while (0)
#pragma unroll 1
        for (int n = 0; n < 64; n += 4) { SEQ_LOAD(n, L1); SEQ_LOAD(n + 1, L2); SEQ_LOAD(n + 2, L3); SEQ_LOAD(n + 3, L0); }
#undef SEQ_LOAD
    } else {
        f32x16 S[2]; S[0] = f32x16{}; S[1] = f32x16{};
        __syncthreads();
#pragma unroll 1
        for (int n = 0; n < 64; ++n) {
            if (wave < 2) seq_out(lds + (n & 1) * SL_BYTES, lds + SEQ_SF + (n & 1) * 8192, O, (b * 64 + n) * 64, hd * 256 + 32 * es, wave, lane);
            else seq_state(S, lds + (n & 1) * SL_BYTES, lds + SEQ_SF + ((n + 1) & 1) * 8192, 2 * (wave - 2), lane);
            __syncthreads();
        }
    }
}

constexpr int AT_KB = 18432, AT_VB = 20480, AT_K0 = 0, AT_V0 = 2 * AT_KB, AT_XO = 2 * AT_KB + 2 * AT_VB;
__device__ __forceinline__ float max3f(float a, float b, float c) { return fmaxf(fmaxf(a, b), c); }
#define VTR(p) __builtin_bit_cast(s16x4, __builtin_amdgcn_ds_read_tr16_b64_v4i16((LAS s16x4*)(p)))
#define MFMA_PV(a, b, c) MFMA_BF16(a, b, c)
#define EXP2F(x) __builtin_amdgcn_exp2f(x)
#define VFRAG(lo, hi) ((bf16x8){lo[0], lo[1], lo[2], lo[3], hi[0], hi[1], hi[2], hi[3]})
#define AT_EXP8(P, B, W) do { const float e0 = EXP2F(P[B]), e1 = EXP2F(P[B + 1]), e2 = EXP2F(P[B + 2]), e3 = EXP2F(P[B + 3]), e4 = EXP2F(P[B + 4]), e5 = EXP2F(P[B + 5]), e6 = EXP2F(P[B + 6]), e7 = EXP2F(P[B + 7]); \
        W.x = cvtpk(e0, e1); W.y = cvtpk(e2, e3); W.z = cvtpk(e4, e5); W.w = cvtpk(e6, e7); ra += (e0 + e1) + (e4 + e5); rb += (e2 + e3) + (e6 + e7); } while (0)
__device__ __forceinline__ void glds16_asm(const void* gsrc, unsigned lds_dst) { unsigned keep;
    asm volatile("s_mov_b32 %0, m0\n\ts_mov_b32 m0, %2\n\ts_nop 0\n\tglobal_load_lds_dwordx4 %1, off\n\ts_mov_b32 m0, %0" : "=&s"(keep) : "v"(gsrc), "s"(lds_dst) : "memory"); }
__device__ __forceinline__ void glds16_so(const void* sbase, unsigned voff, unsigned lds_dst) { unsigned keep;
    asm volatile("s_mov_b32 %0, m0\n\ts_mov_b32 m0, %3\n\ts_nop 0\n\tglobal_load_lds_dwordx4 %1, %2\n\ts_mov_b32 m0, %0" : "=&s"(keep) : "v"(voff), "s"(sbase), "s"(lds_dst) : "memory"); }
constexpr int A5_K0 = 0, A5_V0 = 3 * AT_KB;
__device__ __forceinline__ void attn5_tile(LAS unsigned char* vp, LAS unsigned char* kpn  , bool has_next, bf16x8 (&kf)[8], const bf16x8 (&qf)[4], f32x16 (&o)[4], float& m, float& l, f32x16& nmv  ,
                                           int key0, int qrow, int h, bool need_mask, bool first) {
    s16x4 la[4], ha[4], lb[4], hb[4];
#pragma unroll
    for (int eb = 0; eb < 4; ++eb) { la[eb] = VTR(vp + eb * 64); ha[eb] = VTR(vp + 8 * 320 + eb * 64); }
#pragma unroll
    for (int eb = 0; eb < 4; ++eb) { lb[eb] = VTR(vp + 16 * 320 + eb * 64); hb[eb] = VTR(vp + 16 * 320 + 8 * 320 + eb * 64); }
    __builtin_amdgcn_sched_barrier(0);
    f32x16 p0 = MFMA_BF16(kf[0], qf[0], nmv), p1 = MFMA_BF16(kf[1], qf[0], nmv);
#pragma unroll
    for (int s = 1; s < 4; ++s) { p0 = MFMA_BF16(kf[2 * s], qf[s], p0); p1 = MFMA_BF16(kf[2 * s + 1], qf[s], p1); }
    if (need_mask) {
#pragma unroll
        for (int i = 0; i < 16; ++i) { const int key = key0 + (i & 3) + 8 * (i >> 2) + 4 * h; if (key > qrow) p0[i] = -INFINITY; if (key + 32 > qrow) p1[i] = -INFINITY; }
    }
    float ma = max3f(p0[0], p0[1], p1[0]), mb = max3f(p0[2], p0[3], p1[1]), mc = max3f(p0[4], p0[5], p1[2]), md = max3f(p0[6], p0[7], p1[3]);
    ma = max3f(ma, p0[8], p0[9]); mb = max3f(mb, p0[10], p0[11]); mc = max3f(mc, p0[12], p0[13]); md = max3f(md, p0[14], p0[15]);
    ma = max3f(ma, p1[4], p1[5]); mb = max3f(mb, p1[6], p1[7]); mc = max3f(mc, p1[8], p1[9]); md = max3f(md, p1[10], p1[11]);
    ma = max3f(ma, p1[12], p1[13]); mb = max3f(mb, p1[14], p1[15]);
    float mx = fmaxf(fmaxf(ma, mb), fmaxf(mc, md));
    { auto rr = __builtin_amdgcn_permlane32_swap(__builtin_bit_cast(unsigned, mx), __builtin_bit_cast(unsigned, mx), false, false); mx = fmaxf(__builtin_bit_cast(float, rr[0]), __builtin_bit_cast(float, rr[1])); }
    if (first || __any(mx > 8.0f)) {
        const float dl = first ? mx : fmaxf(mx, 0.f); m += dl;
#pragma unroll
        for (int i = 0; i < 16; ++i) { p0[i] -= dl; p1[i] -= dl; nmv[i] = -m; }
        if (!first) { const float al = __builtin_amdgcn_exp2f(-dl); l *= al;
#pragma unroll
            for (int eb = 0; eb < 4; ++eb) o[eb] *= al; }
    }
    float ra = 0.f, rb = 0.f; v4u w0, w1;
    AT_EXP8(p0, 0, w0);
    __builtin_amdgcn_sched_barrier(0);
    { const bf16x8 pf = __builtin_bit_cast(bf16x8, w0);
#pragma unroll
      for (int eb = 0; eb < 4; ++eb) o[eb] = MFMA_PV(VFRAG(la[eb], ha[eb]), pf, o[eb]); }
    AT_EXP8(p0, 8, w1);
    __builtin_amdgcn_sched_barrier(0);
#pragma unroll
    for (int eb = 0; eb < 4; ++eb) { la[eb] = VTR(vp + 32 * 320 + eb * 64); ha[eb] = VTR(vp + 32 * 320 + 8 * 320 + eb * 64); }
    __builtin_amdgcn_sched_barrier(0);
    { const bf16x8 pf = __builtin_bit_cast(bf16x8, w1);
#pragma unroll
      for (int eb = 0; eb < 4; ++eb) o[eb] = MFMA_PV(VFRAG(lb[eb], hb[eb]), pf, o[eb]); }
    AT_EXP8(p1, 0, w0);
    __builtin_amdgcn_sched_barrier(0);
#pragma unroll
    for (int eb = 0; eb < 4; ++eb) { lb[eb] = VTR(vp + 48 * 320 + eb * 64); hb[eb] = VTR(vp + 48 * 320 + 8 * 320 + eb * 64); }
    if (has_next) {
#pragma unroll
        for (int s = 0; s < 4; ++s) { kf[2 * s] = *(const LAS bf16x8*)(kpn + s * 32); kf[2 * s + 1] = *(const LAS bf16x8*)(kpn + 32 * 144 + s * 32); }
    }
    __builtin_amdgcn_sched_barrier(0);
    { const bf16x8 pf = __builtin_bit_cast(bf16x8, w0);
#pragma unroll
      for (int eb = 0; eb < 4; ++eb) o[eb] = MFMA_PV(VFRAG(la[eb], ha[eb]), pf, o[eb]); }
    AT_EXP8(p1, 8, w1);
    __builtin_amdgcn_sched_barrier(0);
    { const bf16x8 pf = __builtin_bit_cast(bf16x8, w1);
#pragma unroll
      for (int eb = 0; eb < 4; ++eb) o[eb] = MFMA_PV(VFRAG(lb[eb], hb[eb]), pf, o[eb]); }
    l += ra + rb;
}
__device__ __forceinline__ void attn8_step(LAS unsigned char* vp, LAS unsigned char* kpn2  , bool has_next, bool has_next2, bf16x8 (&kf)[8], const bf16x8 (&qf)[4], f32x16 (&o)[4], float& m, float& l,
                                           f32x16& p0, f32x16& p1, f32x16& n0, f32x16& n1, int key0, int qrow, int h, bool need_mask, bool first) {
    s16x4 la[4], ha[4], lb[4], hb[4];
#pragma unroll
    for (int eb = 0; eb < 4; ++eb) { la[eb] = VTR(vp + eb * 64); ha[eb] = VTR(vp + 8 * 320 + eb * 64); }
#pragma unroll
    for (int eb = 0; eb < 4; ++eb) { lb[eb] = VTR(vp + 16 * 320 + eb * 64); hb[eb] = VTR(vp + 16 * 320 + 8 * 320 + eb * 64); }
    __builtin_amdgcn_sched_barrier(0);
    { const float nm = -m;
#pragma unroll
        for (int i = 0; i < 16; ++i) { n0[i] = nm; n1[i] = nm; }
#pragma unroll
        for (int s = 0; s < 4; ++s) { n0 = MFMA_BF16(kf[2 * s], qf[s], n0); n1 = MFMA_BF16(kf[2 * s + 1], qf[s], n1); } }
    __builtin_amdgcn_sched_barrier(0);
    if (need_mask) {
#pragma unroll
        for (int i = 0; i < 16; ++i) { const int key = key0 + (i & 3) + 8 * (i >> 2) + 4 * h; if (key > qrow) p0[i] = -INFINITY; if (key + 32 > qrow) p1[i] = -INFINITY; }
    }
    float ma = max3f(p0[0], p0[1], p1[0]), mb = max3f(p0[2], p0[3], p1[1]), mc = max3f(p0[4], p0[5], p1[2]), md = max3f(p0[6], p0[7], p1[3]);
    ma = max3f(ma, p0[8], p0[9]); mb = max3f(mb, p0[10], p0[11]); mc = max3f(mc, p0[12], p0[13]); md = max3f(md, p0[14], p0[15]);
    ma = max3f(ma, p1[4], p1[5]); mb = max3f(mb, p1[6], p1[7]); mc = max3f(mc, p1[8], p1[9]); md = max3f(md, p1[10], p1[11]);
    ma = max3f(ma, p1[12], p1[13]); mb = max3f(mb, p1[14], p1[15]);
    float mx = fmaxf(fmaxf(ma, mb), fmaxf(mc, md));
    { auto rr = __builtin_amdgcn_permlane32_swap(__builtin_bit_cast(unsigned, mx), __builtin_bit_cast(unsigned, mx), false, false); mx = fmaxf(__builtin_bit_cast(float, rr[0]), __builtin_bit_cast(float, rr[1])); }
    if (first || __any(mx > 8.0f)) {
        const float dl = first ? mx : fmaxf(mx, 0.f); m += dl;
#pragma unroll
        for (int i = 0; i < 16; ++i) { p0[i] -= dl; p1[i] -= dl; }
#pragma unroll
        for (int i = 0; i < 16; ++i) { n0[i] -= dl; n1[i] -= dl; }
        if (!first) { const float al = __builtin_amdgcn_exp2f(-dl); l *= al;
#pragma unroll
            for (int eb = 0; eb < 4; ++eb) o[eb] *= al; }
    }
    float ra = 0.f, rb = 0.f; v4u w0, w1;
    AT_EXP8(p0, 0, w0);
    __builtin_amdgcn_sched_barrier(0);
    { const bf16x8 pf = __builtin_bit_cast(bf16x8, w0);
#pragma unroll
      for (int eb = 0; eb < 4; ++eb) o[eb] = MFMA_PV(VFRAG(la[eb], ha[eb]), pf, o[eb]); }
    AT_EXP8(p0, 8, w1);
    __builtin_amdgcn_sched_barrier(0);
#pragma unroll
    for (int eb = 0; eb < 4; ++eb) { la[eb] = VTR(vp + 32 * 320 + eb * 64); ha[eb] = VTR(vp + 32 * 320 + 8 * 320 + eb * 64); }
    __builtin_amdgcn_sched_barrier(0);
    { const bf16x8 pf = __builtin_bit_cast(bf16x8, w1);
#pragma unroll
      for (int eb = 0; eb < 4; ++eb) o[eb] = MFMA_PV(VFRAG(lb[eb], hb[eb]), pf, o[eb]); }
    AT_EXP8(p1, 0, w0);
    __builtin_amdgcn_sched_barrier(0);
#pragma unroll
    for (int eb = 0; eb < 4; ++eb) { lb[eb] = VTR(vp + 48 * 320 + eb * 64); hb[eb] = VTR(vp + 48 * 320 + 8 * 320 + eb * 64); }
    {
#pragma unroll
        for (int s = 0; s < 4; ++s) { kf[2 * s] = *(const LAS bf16x8*)(kpn2 + s * 32); kf[2 * s + 1] = *(const LAS bf16x8*)(kpn2 + 32 * 144 + s * 32); }
    }
    __builtin_amdgcn_sched_barrier(0);
    { const bf16x8 pf = __builtin_bit_cast(bf16x8, w0);
#pragma unroll
      for (int eb = 0; eb < 4; ++eb) o[eb] = MFMA_PV(VFRAG(la[eb], ha[eb]), pf, o[eb]); }
    AT_EXP8(p1, 8, w1);
    __builtin_amdgcn_sched_barrier(0);
    { const bf16x8 pf = __builtin_bit_cast(bf16x8, w1);
#pragma unroll
      for (int eb = 0; eb < 4; ++eb) o[eb] = MFMA_PV(VFRAG(lb[eb], hb[eb]), pf, o[eb]); }
    l += ra + rb;
}
__device__ __forceinline__ unsigned a8_koff(int cc, int i, int lane) { const int t = i + lane, r = (t * 57) >> 9, cq = t - 9 * r; return (unsigned)((cc * 4096 * 64 + (7 * i + r) * 64 + (cq > 7 ? 7 : cq) * 8) * 2); }
__device__ __forceinline__ unsigned a8_voff(int i, int lane) { const int t = 4 * i + lane, r = (t * 205) >> 12, cq = t - 20 * r; return (unsigned)(((3 * i + r) * 128 + (cq > 15 ? 15 : cq) * 8) * 2); }
__device__ __forceinline__ void a8_dma_k(const bf16* kt, unsigned ldsK, int wave, int lane) {
#pragma unroll
    for (int ii = 0; ii < 3; ++ii) { const int g = wave + 8 * ii; if (g < 18) { const int cc = g >= 9 ? 1 : 0, i = g - 9 * cc;
        glds16_so(kt, a8_koff(cc, i, lane), (unsigned)__builtin_amdgcn_readfirstlane((int)(ldsK + cc * 9216 + i * 1024))); } }
}
__device__ __forceinline__ void a8_dma_v(const bf16* vt, unsigned ldsV, int wave, int lane) {
#pragma unroll
    for (int ii = 2; ii < 5; ++ii) { const int g = wave + 8 * ii; if (g >= 18) { const int i = g < 38 ? g - 18 : g - 38;
        glds16_so(vt, a8_voff(i, lane), (unsigned)__builtin_amdgcn_readfirstlane((int)(ldsV + i * 1024))); } }
}
__device__ __forceinline__ void attn_unit(const Args& A, int b, int hh, int qb, float lam, LAS unsigned char* lds, int tid_in, int wave, int lane_in) {
    int tid = tid_in; asm volatile("" : "+v"(tid));
    const int lane = tid & 63; (void)lane_in;
    unsigned char* ws = A.ws;
    const bf16* KR = (const bf16*)(ws + WS_KR); const bf16* VR = (const bf16*)(ws + WS_VR); const bf16* QR = (const bf16*)(ws + WS_QR); bf16* AO = (bf16*)(ws + WS_AO);
    const int cl = lane & 31, h = lane >> 5, c = wave >> 2, qg = wave & 3;
    const int q0 = qb * 128, NT = 2 * (qb + 1), qrow = q0 + 32 * qg + cl, qmax = q0 + 32 * qg + 31, qmin = q0 + 32 * qg;
    bf16x8 qf[4];
    { const bf16* qp = QR + ((size_t)((b * 8 + hh) * 2 + c) * 4096 + qrow) * 64 + 8 * h;
#pragma unroll
        for (int s = 0; s < 4; ++s) qf[s] = *(const bf16x8*)(qp + 16 * s); }
    f32x16 o[4]; o[0] = f32x16{}; o[1] = f32x16{}; o[2] = f32x16{}; o[3] = f32x16{};
    float m = 0.f, l = 0.f;
    constexpr int A7_K0 = 0, A7_V0 = 4 * AT_KB;
    const bf16* const kbase = KR + (size_t)((b * 8 + hh) * 2) * 4096 * 64; const bf16* const vbase = VR + (size_t)(b * 8 + hh) * 4096 * 128;
    const unsigned lds0 = (unsigned)(uintptr_t)lds;
#define A7_DMA_K(t, slot) a8_dma_k(kbase + (size_t)(t) * 64 * 64, lds0 + A7_K0 + (slot) * AT_KB, wave, lane)
#define A7_DMA_V(t, slot) a8_dma_v(vbase + (size_t)(t) * 64 * 128, lds0 + A7_V0 + (slot) * AT_VB, wave, lane)
    LAS unsigned char* const vtr = lds + A7_V0 + (4 * h + ((lane & 15) >> 2)) * 320 + (16 * ((lane >> 4) & 1) + 4 * (lane & 3)) * 2;
    LAS unsigned char* const kfr = lds + A7_K0 + c * 9216 + cl * 144 + 16 * h;
    A7_DMA_K(0, 0); A7_DMA_V(0, 0); A7_DMA_K(1, 1); A7_DMA_V(1, 1);
    if (NT > 2) A7_DMA_K(2, 2);
    asm volatile("s_waitcnt vmcnt(0)" ::: "memory"); __syncthreads();
    asm volatile("" : "+v"(qf[0]), "+v"(qf[1]), "+v"(qf[2]), "+v"(qf[3]));
    bf16x8 kf[8];
#pragma unroll
    for (int s = 0; s < 4; ++s) { kf[2 * s] = *(const LAS bf16x8*)(kfr + s * 32); kf[2 * s + 1] = *(const LAS bf16x8*)(kfr + 32 * 144 + s * 32); }
    f32x16 nmv = {};
    int kv = 0, kv1 = 1, kv2 = 2, kk1 = 1, kk3 = 3;
#pragma unroll 1
    for (int j = 0; j < NT; ++j) {
        if (j + 3 < NT) A7_DMA_K(j + 3, kk3);
        if (j + 2 < NT) A7_DMA_V(j + 2, kv2);
        const bool act_ = (64 * j <= qmax);
        if (act_) attn5_tile(vtr + kv * AT_VB, kfr + kk1 * AT_KB, j + 1 < NT, kf, qf, o, m, l, nmv, 64 * j, qrow, h, 64 * j + 63 > qmin, j == 0);
        if (j + 3 < NT) asm volatile("s_waitcnt vmcnt(5) lgkmcnt(0)\n\ts_barrier" ::: "memory"); else asm volatile("s_waitcnt vmcnt(0) lgkmcnt(0)\n\ts_barrier" ::: "memory");
        kv = kv1; kv1 = kv2; kv2 = (kv2 == 2) ? 0 : kv2 + 1; kk1 = (kk1 + 1) & 3; kk3 = (kk3 + 1) & 3;
    }
    __syncthreads();
    int tid2 = tid; asm volatile("" : "+v"(tid2));
    const int bp32 = ((tid2 & 63) ^ 32) << 2;
    l += __builtin_bit_cast(float, __builtin_amdgcn_ds_bpermute(bp32, __builtin_bit_cast(int, l)));
    const float inv = __builtin_amdgcn_rcpf(l);
    {
    const int lane2 = tid2 & 63, cl = lane2 & 31, h = lane2 >> 5, wave2 = __builtin_amdgcn_readfirstlane(tid2 >> 6), c = wave2 >> 2, qg = wave2 & 3, qrow = q0 + 32 * qg + cl;
    LAS float* XO = (LAS float*)(lds) + qg * 4096;
    if (c == 1) {
        const float f = inv * lam;
#pragma unroll
        for (int eb = 0; eb < 4; ++eb)
#pragma unroll
            for (int i = 0; i < 16; ++i) { const int e = 32 * eb + (i & 3) + 8 * (i >> 2) + 4 * h; XO[e * 32 + cl] = o[eb][i] * f; }
    }
    __syncthreads();
    if (c == 0) {
        float ss = 0.f;
#pragma unroll
        for (int eb = 0; eb < 4; ++eb)
#pragma unroll
            for (int i = 0; i < 16; ++i) { const int e = 32 * eb + (i & 3) + 8 * (i >> 2) + 4 * h; const float v = o[eb][i] * inv - XO[e * 32 + cl]; o[eb][i] = v; ss += v * v; }
        ss += __builtin_bit_cast(float, __builtin_amdgcn_ds_bpermute(bp32, __builtin_bit_cast(int, ss)));
        const float rstd = (1.0f - LAM_INIT) * __builtin_amdgcn_rsqf(ss * (1.0f / 128.0f) + EPS);
        bf16* op = AO + (size_t)(b * 4096 + qrow) * DM + hh * 128;
        f32x4 w4[4][4];
#pragma unroll
        for (int eb = 0; eb < 4; ++eb)
#pragma unroll
            for (int g = 0; g < 4; ++g) w4[eb][g] = *(const f32x4*)(A.in[I_SUBLN] + 32 * eb + 8 * g + 4 * h);
#pragma unroll
        for (int eb = 0; eb < 4; ++eb)
#pragma unroll
            for (int g = 0; g < 4; ++g) { const int e0 = 32 * eb + 8 * g + 4 * h;
                v2u w; w.x = cvtpk(o[eb][4 * g] * rstd * w4[eb][g][0], o[eb][4 * g + 1] * rstd * w4[eb][g][1]); w.y = cvtpk(o[eb][4 * g + 2] * rstd * w4[eb][g][2], o[eb][4 * g + 3] * rstd * w4[eb][g][3]);
                *(v2u*)(op + e0) = w; }
    }
    }
    __syncthreads();
#undef A7_DMA_K
#undef A7_DMA_V
}

constexpr int NPH = 16;
__global__ void __launch_bounds__(NWAVES * 64, 2) yoco_fwd(Args args) {
    extern __shared__ __attribute__((aligned(16))) unsigned char lds_raw[];
    LAS unsigned char* lds = (LAS unsigned char*)lds_raw;
#define FRESH() int tid = threadIdx.x; asm volatile("" : "+v"(tid)); const int lane = tid & 63, wave = __builtin_amdgcn_readfirstlane(tid >> 6); (void)lane; (void)wave
    const int G = gridDim.x; const int bx = blockIdx.x; const int vcu = (G % 8 == 0) ? (bx % 8) * (G / 8) + bx / 8 : bx;
    unsigned char* ws = args.ws;
    for (int u = threadIdx.x; u < (LDS_BYTES - LDSCTL_OFF) / 4; u += NWAVES * 64) ((LAS unsigned*)(lds + LDSCTL_OFF))[u] = 0u;
    __syncthreads();
#if !MK_PER_PHASE
    XcdBarrier bar = xcd_barrier_post((unsigned*)(ws + WS_CTL) + CW_BAR, (volatile LAS unsigned*)(lds + MISC_OFF) + 8);
#define GRID_BAR() xcd_barrier(bar)
#else
#define GRID_BAR() do {} while (0)
#endif
    const int lo = args.ph_lo, hi = args.ph_hi;
#define IN(k) (lo <= (k) && (k) < hi)
#define SEAM(k) do { if (IN((k) + 1)) GRID_BAR(); } while (0)
    float* H = args.out;
    const float* PS = (const float*)(ws + WS_PS);
    if (IN(0)) { FRESH(); { p0_prologue(args, lds, vcu, G, wave, lane, tid); } SEAM(0); }
    if (IN(1)) { FRESH(); {
        pg8::Gemm g{(const bf16*)(ws + WS_XB), (const bf16*)(ws + WS_W1T), T, 3072, DM}; pg8::StaticOrder S; S.init(T, 3072, G, bx);
        pg8::EpiScaleBf16 E{(bf16*)(ws + WS_QKVG), 3072, (const float*)(ws + WS_RSTD), nullptr, 0};
        pg8::gemm_phase<pg8::EpiScaleBf16, pg8::StaticOrder, true, true>(lds, g, S, E); } SEAM(1);
    }
    if (IN(2)) { FRESH(); { for (int bn = vcu; bn < NBN; bn += G) gla_pre_unit(args, bn, lds, tid, wave); } SEAM(2); }
    if (IN(3)) { FRESH(); { for (int u = vcu; u < 256; u += G) gla_seq_unit(args, u, lds, tid, wave); } SEAM(3); }
    if (IN(4)) { FRESH(); { gla_gate_phase((const bf16*)(ws + WS_XB), (const bf16*)(ws + WS_QKVG), args.in[I_ONORM], (bf16*)(ws + WS_OGATE), vcu, G, wave, lane); } SEAM(4); }
    if (IN(5)) { FRESH(); {
        pg8::Gemm g{(const bf16*)(ws + WS_OGATE), (const bf16*)(ws + WS_WO1T), T, DM, DM}; pg8::StaticOrder S; S.init(T, DM, G, bx);
        pg8::EpiResBf16 E{args.in[I_X], nullptr, (bf16*)(ws + WS_XB), DM, (float*)(ws + WS_PS), (bf16*)(ws + WS_AH)};
        pg8::gemm_phase<pg8::EpiResBf16, pg8::StaticOrder, true, true>(lds, g, S, E); } SEAM(5);
    }
#pragma unroll
    for (int layer = 0; layer < 2; ++layer) {
        const int pb = layer == 0 ? 6 : 12;
        const bf16* WIN = (const bf16*)(ws + (layer == 0 ? WS_WIN0T : WS_WIN1T)); const bf16* WOUT = (const bf16*)(ws + (layer == 0 ? WS_WOUT0T : WS_WOUT1T));
        const float* cw = args.in[I_CONVW] + (size_t)layer * 3 * 2 * DFF; const float* cb = args.in[I_CONVB] + (size_t)layer * 2 * DFF;
        if (IN(pb)) { FRESH(); {
            pg8::Gemm g{(const bf16*)(ws + WS_AH), WIN, 1024, 2 * DFF, DM}; pg8::StaticOrder S; S.init(1024, 2 * DFF, G, bx);
            pg8::EpiScaleBf16 E{(bf16*)(ws + WS_UH), 2 * DFF, nullptr, PS, 1};
            pg8::gemm_phase<pg8::EpiScaleBf16, pg8::StaticOrder, true, true>(lds, g, S, E);
            { const int nidle = G > 88 ? G - 88 : G, me = G > 88 ? bx - 88 : bx;
              if (me >= 0) for (int r = me * (NWAVES * 64) + tid; r < T; r += nidle * NWAVES * 64) ((float*)(ws + WS_RSTD))[r] = pg8::rstd_ps(PS, r); } } SEAM(pb);
        }
        if (IN(pb + 1)) { FRESH(); {
            pg8::Gemm g{(const bf16*)(ws + WS_XB), WIN, T, 2 * DFF, DM}; pg8::StaticOrder S; S.init(T, 2 * DFF, G, bx);
            pg8::EpiConvGate E{(bf16*)(ws + WS_ACT), (const bf16*)(ws + WS_UH), (const float*)(ws + WS_RSTD), cw, cb};
            pg8::gemm_phase<pg8::EpiConvGate, pg8::StaticOrder, true, true>(lds, g, S, E); } SEAM(pb + 1);
        }
        if (IN(pb + 2)) { FRESH(); {
            pg8::Gemm g{(const bf16*)(ws + WS_ACT), WOUT, T, DM, DFF}; pg8::StaticOrder S; S.init(T, DM, G, bx);
            pg8::EpiResBf16 E{nullptr, (const bf16*)(ws + WS_XB), (bf16*)(ws + WS_XB), DM, (float*)(ws + WS_PS), layer == 0 ? (bf16*)(ws + WS_AH) : (bf16*)nullptr};
            pg8::gemm_phase<pg8::EpiResBf16, pg8::StaticOrder, true, true>(lds, g, S, E); } SEAM(pb + 2);
        }
        if (layer == 0) {
            if (IN(9)) { FRESH(); {
                pg8::Gemm g{(const bf16*)(ws + WS_XB), (const bf16*)(ws + WS_WKVQT), T, 3072, DM}; pg8::StaticOrder S; S.init(T, 3072, G, bx);
                pg8::EpiRope E{(bf16*)(ws + WS_KR), (bf16*)(ws + WS_VR), (bf16*)(ws + WS_QR), PS, (const float*)(ws + WS_COS), (const float*)(ws + WS_SIN)};
                pg8::gemm_phase<pg8::EpiRope, pg8::StaticOrder, true, true>(lds, g, S, E); } SEAM(9);
            }
            if (IN(10)) { FRESH(); {
                const float* lp = args.in[I_LAMBDA];
                const float sa = wave_sum(lp[lane] * lp[64 + lane]), sb = wave_sum(lp[128 + lane] * lp[192 + lane]);
                const float lam = __builtin_bit_cast(float, __builtin_amdgcn_readfirstlane(__builtin_bit_cast(int, expf(sa) - expf(sb) + LAM_INIT)));
                const int xg = vcu >> 5, cu = vcu & 31, kq = cu & 15;
                if (G == 256) {
#pragma unroll 1
                    for (int i = 0; i < 8; ++i) { const int pr = xg * 8 + 2 * (i >> 1) + (cu >> 4); const int qb = (i & 1) ? 31 - kq : kq; attn_unit(args, pr >> 3, pr & 7, qb, lam, lds, tid, wave, lane); }
                } else {
#pragma unroll 1
                    for (int it = vcu; it < 1024; it += G) {
#pragma unroll 1
                        for (int i = 0; i < 2; ++i) { const int pr = it >> 4, k2 = it & 15; attn_unit(args, pr >> 3, pr & 7, i ? 31 - k2 : k2, lam, lds, tid, wave, lane); } }
                } }
                SEAM(10);
            }
            if (IN(11)) { FRESH(); {
                pg8::Gemm g{(const bf16*)(ws + WS_AO), (const bf16*)(ws + WS_WO2T), T, DM, DM}; pg8::StaticOrder S; S.init(T, DM, G, bx);
                pg8::EpiResBf16 E{nullptr, (const bf16*)(ws + WS_XB), (bf16*)(ws + WS_XB), DM, (float*)(ws + WS_PS), (bf16*)(ws + WS_AH)};
                pg8::gemm_phase<pg8::EpiResBf16, pg8::StaticOrder, true, true>(lds, g, S, E); } SEAM(11);
            }
        }
    }
    if (IN(15)) { FRESH(); { final_norm_phase((const bf16*)(ws + WS_XB), PS, H, args.in[I_FINAL], vcu, G, wave, lane); } }
#undef IN
#undef SEAM
}

extern "C" void kernel_launch(void* const* d_in, const int* in_sizes, int n_in, void* d_out, int out_size, void* d_ws, size_t ws_size, hipStream_t stream) {
    static int grid = 0;
    if (grid == 0) {
        if (n_in != 20 || out_size != T * DM || ws_size < WS_END) { fprintf(stderr, "kernel_launch: unexpected shapes (n_in %d out %d ws %zu)\n", n_in, out_size, ws_size); grid = -1; return; }
        int dev = 0, cus = 0;
        if (hipGetDevice(&dev) != hipSuccess || hipDeviceGetAttribute(&cus, hipDeviceAttributeMultiprocessorCount, dev) != hipSuccess) { grid = -1; return; }
        if (hipFuncSetAttribute((const void*)yoco_fwd, hipFuncAttributeMaxDynamicSharedMemorySize, LDS_BYTES) != hipSuccess) { grid = -1; return; }
        int per_cu = 0; (void)hipOccupancyMaxActiveBlocksPerMultiprocessor(&per_cu, (const void*)yoco_fwd, NWAVES * 64, LDS_BYTES); (void)hipGetLastError();
        grid = cus;
    }
    if (grid < 0) return;
    if (hipMemsetAsync((char*)d_ws + WS_CTL, 0, CTL_ZERO_BYTES, stream) != hipSuccess) return;
    Args a{};
    for (int i = 0; i < 20; ++i) a.in[i] = (const float*)d_in[i];
    a.out = (float*)d_out; a.ws = (unsigned char*)d_ws;
#if MK_PER_PHASE
    for (int ph = 0; ph < NPH; ++ph) { a.ph_lo = ph; a.ph_hi = ph + 1; hipLaunchKernelGGL(yoco_fwd, dim3(grid), dim3(NWAVES * 64), LDS_BYTES, stream, a); }
#else
    a.ph_lo = 0; a.ph_hi = NPH; hipLaunchKernelGGL(yoco_fwd, dim3(grid), dim3(NWAVES * 64), LDS_BYTES, stream, a);
#endif
}
```

```cpp
#ifndef MK_PER_PHASE
#define MK_PER_PHASE 0
#endif
#include <hip/hip_runtime.h>
#include <cstdio>
#include <cstdint>
namespace pg8 {
#define PG8_LAS __attribute__((address_space(3)))
typedef unsigned short bf16_t;
typedef short bf16x8 __attribute__((ext_vector_type(8)));
typedef float f32x4 __attribute__((ext_vector_type(4)));
typedef unsigned u32x4 __attribute__((ext_vector_type(4)));
constexpr int BM = 256, BK = 64, HALF = 128, HTB = HALF * BK * 2  , STAGE_BYTES = 8 * HTB, NXCD = 8, WGM = 8;

__host__ __device__ __forceinline__ int lds_byte(int r, int c) { const int st = (r >> 4) * 2 + (c >> 5), rr = r & 15, cc = c & 31, ob = rr * 64 + cc * 2; return st * 1024 + (ob ^ (((ob >> 9) & 1) << 5)); }
__host__ __device__ __forceinline__ void stage_rc(int b, int& R, int& C) { const int st = b / 1024, sb = b % 1024, swz = sb ^ (((sb >> 9) & 1) << 5); R = (st >> 1) * 16 + swz / 64; C = (st & 1) * 32 + (swz % 64) / 2; }
__host__ __device__ __forceinline__ int perm32(int rho) { const int n = rho >> 4, i = rho & 15; return 8 * (i >> 2) + 4 * n + (i & 3); }

struct Unit { int pm, pn; };
struct Gemm { const bf16_t* A; const bf16_t* Bt; int M, N, K; };

struct StaticOrder {
    int nM, nN, nwg, G, c;
    __host__ __device__ void init(int M, int N, int G_, int c_) { nM = M / BM; nN = N / BM; nwg = nM * nN; G = G_; c = c_; }
    __host__ __device__ bool next(int i, Unit& u) const {
        const long L = (long)i * G + c; if (L >= nwg) return false;
        int wgid = (int)L; { const int q = nwg / NXCD, r = nwg % NXCD, xcd = wgid % NXCD, off = wgid / NXCD; wgid = (xcd < r ? xcd * (q + 1) : r * (q + 1) + (xcd - r) * q) + off; }
        const int nig = WGM * nN, gid = wgid / nig, fm = gid * WGM, gsz = (nM - fm) < WGM ? (nM - fm) : WGM;
        u.pm = fm + ((wgid % nig) % gsz); u.pn = (wgid % nig) / gsz; return true;
    }
    __device__ __forceinline__ void a_ready(const Unit&) const {}
    __device__ __forceinline__ void done(const Unit&) const {}
};

__device__ __forceinline__ unsigned cvt_pk_bf16(float lo, float hi) { unsigned r; asm volatile("v_cvt_pk_bf16_f32 %0, %1, %2" : "=v"(r) : "v"(lo), "v"(hi)); return r; }
typedef float f32x2 __attribute__((ext_vector_type(2)));
__device__ __forceinline__ float rstd_ps(const float* ps, int row) {
    const f32x4* p = (const f32x4*)(ps + (size_t)row * 16); const f32x4 a = p[0], b = p[1], c = p[2], d = p[3];
    const float s = ((a[0] + a[1]) + (a[2] + a[3])) + ((b[0] + b[1]) + (b[2] + b[3])) + ((c[0] + c[1]) + (c[2] + c[3])) + ((d[0] + d[1]) + (d[2] + d[3]));
    return __builtin_amdgcn_rsqf(s * (1.0f / 1024.0f) + 1e-6f);
}
struct EpiScaleBf16 {
    static constexpr bool PERM = true, AFTER_DRAIN = false, APERM = false;
    bf16_t* O; int ldc; const float* rstd; const float* ps; int halo;
    __device__ __forceinline__ void operator()(const f32x4 (&acc)[2][2][4][2], const Unit& u, int wr, int wc, int fr, int fq) const {
        const int row0 = u.pm * BM + wr * 64 + fr, col0 = u.pn * BM + wc * 32 + 8 * fq;
        float sc[2][4];
#pragma unroll
        for (int ai = 0; ai < 2; ++ai)
#pragma unroll
            for (int m = 0; m < 4; ++m) { const int row = row0 + ai * HALF + m * 16;
                if (rstd) sc[ai][m] = rstd[row];
                else if (halo) { const int st = row >> 1; sc[ai][m] = (st & 63) ? rstd_ps(ps, 64 * st - 2 + (row & 1)) : 0.f; } else sc[ai][m] = rstd_ps(ps, row); }
#pragma unroll
        for (int ai = 0; ai < 2; ++ai)
#pragma unroll
            for (int m = 0; m < 4; ++m) { const int row = row0 + ai * HALF + m * 16; const float s = sc[ai][m];
                bf16_t* rowp = O + (size_t)row * ldc + col0;
#pragma unroll
                for (int bj = 0; bj < 2; ++bj) { const f32x4 v0 = acc[ai][bj][m][0] * s, v1 = acc[ai][bj][m][1] * s;
                    u32x4 w; w.x = cvt_pk_bf16(v0[0], v0[1]); w.y = cvt_pk_bf16(v0[2], v0[3]); w.z = cvt_pk_bf16(v1[0], v1[1]); w.w = cvt_pk_bf16(v1[2], v1[3]);
                    *(u32x4*)(rowp + bj * HALF) = w; } }
    }
};
struct EpiResBf16 {
    static constexpr bool PERM = true, AFTER_DRAIN = false, APERM = false;
    const float* base32; const bf16_t* base16; bf16_t* out; int ldc; float* ps; bf16_t* ah;
    __device__ __forceinline__ void operator()(const f32x4 (&acc)[2][2][4][2], const Unit& u, int wr, int wc, int fr, int fq) const {
        const int row0 = u.pm * BM + wr * 64 + fr, col0 = u.pn * BM + wc * 32 + 8 * fq;
#pragma unroll
        for (int ai = 0; ai < 2; ++ai) {
            f32x4 b0[4][2], b1[4][2];
            if (base32) {
#pragma unroll
                for (int m = 0; m < 4; ++m)
#pragma unroll
                    for (int bj = 0; bj < 2; ++bj) { const size_t off = (size_t)(row0 + ai * HALF + m * 16) * ldc + col0 + bj * HALF; b0[m][bj] = *(const f32x4*)(base32 + off); b1[m][bj] = *(const f32x4*)(base32 + off + 4); }
            } else {
                u32x4 r[4][2];
#pragma unroll
                for (int m = 0; m < 4; ++m)
#pragma unroll
                    for (int bj = 0; bj < 2; ++bj) r[m][bj] = *(const u32x4*)(base16 + (size_t)(row0 + ai * HALF + m * 16) * ldc + col0 + bj * HALF);
#pragma unroll
                for (int m = 0; m < 4; ++m)
#pragma unroll
                    for (int bj = 0; bj < 2; ++bj) { const u32x4 q = r[m][bj];
                        b0[m][bj][0] = __builtin_bit_cast(float, q.x << 16); b0[m][bj][1] = __builtin_bit_cast(float, q.x & 0xffff0000u); b0[m][bj][2] = __builtin_bit_cast(float, q.y << 16); b0[m][bj][3] = __builtin_bit_cast(float, q.y & 0xffff0000u);
                        b1[m][bj][0] = __builtin_bit_cast(float, q.z << 16); b1[m][bj][1] = __builtin_bit_cast(float, q.z & 0xffff0000u); b1[m][bj][2] = __builtin_bit_cast(float, q.w << 16); b1[m][bj][3] = __builtin_bit_cast(float, q.w & 0xffff0000u); }
            }
#pragma unroll
            for (int m = 0; m < 4; ++m) { const int row = row0 + ai * HALF + m * 16; const size_t off = (size_t)row * ldc + col0; float ss = 0.f;
                const bool hrow = (m == 3) && (fr >= 14); const int st = ((row >> 6) + 1) & 511; const bool hw = ah && hrow && (st & 63);
                bf16_t* ahp = ah + (size_t)(2 * st + (fr - 14)) * ldc + col0;
#pragma unroll
                for (int bj = 0; bj < 2; ++bj) {
                    const f32x4 v0 = b0[m][bj] + acc[ai][bj][m][0], v1 = b1[m][bj] + acc[ai][bj][m][1];
                    ss += ((v0[0] * v0[0] + v0[1] * v0[1]) + (v0[2] * v0[2] + v0[3] * v0[3])) + ((v1[0] * v1[0] + v1[1] * v1[1]) + (v1[2] * v1[2] + v1[3] * v1[3]));
                    u32x4 w; w.x = cvt_pk_bf16(v0[0], v0[1]); w.y = cvt_pk_bf16(v0[2], v0[3]); w.z = cvt_pk_bf16(v1[0], v1[1]); w.w = cvt_pk_bf16(v1[2], v1[3]);
                    *(u32x4*)(out + off + bj * HALF) = w;
                    if (hw) *(u32x4*)(ahp + bj * HALF) = w; }
                ss += __shfl_xor(ss, 16); ss += __shfl_xor(ss, 32);
                if (fq == 0) ps[(size_t)row * 16 + u.pn * 4 + wc] = ss; }
        }
    }
};
struct EpiRope {
    static constexpr bool PERM = false, AFTER_DRAIN = false, APERM = false;
    bf16_t* KR; bf16_t* VR; bf16_t* QR; const float* ps; const float* cosT; const float* sinT;
    __device__ __forceinline__ void operator()(const f32x4 (&acc)[2][2][4][2], const Unit& u, int wr, int wc, int fr, int fq) const {
        typedef unsigned u32x2v __attribute__((ext_vector_type(2)));
        const int row0 = u.pm * BM + wr * 64 + fr; const int pn = u.pn;
#pragma unroll
        for (int ai = 0; ai < 2; ++ai) {
            float sc[4];
#pragma unroll
            for (int m = 0; m < 4; ++m) sc[m] = rstd_ps(ps, row0 + ai * HALF + m * 16);
            if (pn >= 4 && pn < 8) {
#pragma unroll
                for (int m = 0; m < 4; ++m) { const int row = row0 + ai * HALF + m * 16; const float s = sc[m]; const int b = row >> 12, sq = row & 4095;
#pragma unroll
                    for (int bj = 0; bj < 2; ++bj) { const int head = 2 * (pn - 4) + bj; bf16_t* p = VR + ((size_t)(b * 8 + head) * 4096 + sq) * 128 + 32 * wc + 4 * fq;
#pragma unroll
                        for (int n = 0; n < 2; ++n) { const f32x4 v = acc[ai][bj][m][n] * s; u32x2v w; w.x = cvt_pk_bf16(v[0], v[1]); w.y = cvt_pk_bf16(v[2], v[3]); *(u32x2v*)(p + 16 * n) = w; } } }
            } else {
                bf16_t* dst = pn < 4 ? KR : QR; const int tl = pn < 4 ? pn : pn - 8; const int d0 = 16 * (wc & 1) + 4 * fq;
                f32x4 cs[4], sn[4];
#pragma unroll
                for (int m = 0; m < 4; ++m) { const int sq = (row0 + ai * HALF + m * 16) & 4095; cs[m] = *(const f32x4*)(cosT + sq * 32 + d0); sn[m] = *(const f32x4*)(sinT + sq * 32 + d0); }
#pragma unroll
                for (int m = 0; m < 4; ++m) { const int row = row0 + ai * HALF + m * 16; const float s = sc[m]; const int b = row >> 12, sq = row & 4095;
#pragma unroll
                    for (int bj = 0; bj < 2; ++bj) { const int gc = tl * 4 + 2 * bj + (wc >> 1), head = gc >> 1, c2 = gc & 1;
                        const f32x4 x1 = acc[ai][bj][m][0] * s, x2 = acc[ai][bj][m][1] * s; const f32x4 o1 = x1 * cs[m] - x2 * sn[m], o2 = x2 * cs[m] + x1 * sn[m];
                        bf16_t* p = dst + ((size_t)((b * 8 + head) * 2 + c2) * 4096 + sq) * 64 + d0;
                        u32x2v w1, w2; w1.x = cvt_pk_bf16(o1[0], o1[1]); w1.y = cvt_pk_bf16(o1[2], o1[3]); w2.x = cvt_pk_bf16(o2[0], o2[1]); w2.y = cvt_pk_bf16(o2[2], o2[3]);
                        *(u32x2v*)p = w1; *(u32x2v*)(p + 32) = w2; } }
            }
        }
    }
};

#define DPPF(oldv, src, ctrl) __builtin_bit_cast(float, __builtin_amdgcn_update_dpp(__builtin_bit_cast(int, (float)(oldv)), __builtin_bit_cast(int, (float)(src)), (ctrl), 0xf, 0xf, false))
struct EpiConvGate {
    static constexpr bool PERM = true, AFTER_DRAIN = false;
    bf16_t* ACT; const bf16_t* UH; const float* rstd; const float* cw; const float* cb;
    __device__ __forceinline__ void operator()(const f32x4 (&acc)[2][2][4][2], const Unit& u, int wr, int wc, int fr, int fq) const {
        typedef unsigned u32x2v __attribute__((ext_vector_type(2)));
        const int row0 = u.pm * BM + wr * 64 + fr;
        float rs[2][4];
#pragma unroll
        for (int ai = 0; ai < 2; ++ai)
#pragma unroll
            for (int m = 0; m < 4; ++m) rs[ai][m] = rstd[row0 + ai * HALF + m * 16];
        u32x2v hq[2][2][4];
#pragma unroll
        for (int n = 0; n < 2; ++n)
#pragma unroll
            for (int ai = 0; ai < 2; ++ai) { const bf16_t* hp = UH + (size_t)(2 * (4 * u.pm + 2 * ai + wr)) * 5632 + u.pn * BM + wc * 32 + 8 * fq + 4 * n;
                hq[n][ai][0] = *(const u32x2v*)hp; hq[n][ai][1] = *(const u32x2v*)(hp + 5632); hq[n][ai][2] = *(const u32x2v*)(hp + HALF); hq[n][ai][3] = *(const u32x2v*)(hp + 5632 + HALF); }
#pragma unroll
        for (int n = 0; n < 2; ++n) {
            const int cha = u.pn * 128 + wc * 32 + 8 * fq + 4 * n, chg = 2816 + cha;
            f32x4 wa[3], wg[3];
#pragma unroll
            for (int j = 0; j < 3; ++j) { wa[j] = *(const f32x4*)(cw + j * 5632 + cha); wg[j] = *(const f32x4*)(cw + j * 5632 + chg); }
            const f32x4 ba = *(const f32x4*)(cb + cha), bg = *(const f32x4*)(cb + chg);
#pragma unroll
            for (int ai = 0; ai < 2; ++ai) {
                const u32x2v ha2 = hq[n][ai][0], ha1 = hq[n][ai][1], hg2 = hq[n][ai][2], hg1 = hq[n][ai][3];
                f32x4 pa, pg;
                { f32x4 a1, a2, g1, g2;
                  a1[0] = __builtin_bit_cast(float, ha1.x << 16); a1[1] = __builtin_bit_cast(float, ha1.x & 0xffff0000u); a1[2] = __builtin_bit_cast(float, ha1.y << 16); a1[3] = __builtin_bit_cast(float, ha1.y & 0xffff0000u);
                  a2[0] = __builtin_bit_cast(float, ha2.x << 16); a2[1] = __builtin_bit_cast(float, ha2.x & 0xffff0000u); a2[2] = __builtin_bit_cast(float, ha2.y << 16); a2[3] = __builtin_bit_cast(float, ha2.y & 0xffff0000u);
                  g1[0] = __builtin_bit_cast(float, hg1.x << 16); g1[1] = __builtin_bit_cast(float, hg1.x & 0xffff0000u); g1[2] = __builtin_bit_cast(float, hg1.y << 16); g1[3] = __builtin_bit_cast(float, hg1.y & 0xffff0000u);
                  g2[0] = __builtin_bit_cast(float, hg2.x << 16); g2[1] = __builtin_bit_cast(float, hg2.x & 0xffff0000u); g2[2] = __builtin_bit_cast(float, hg2.y << 16); g2[3] = __builtin_bit_cast(float, hg2.y & 0xffff0000u);
                  const bool is14 = (fr == 14);
#pragma unroll
                  for (int i = 0; i < 4; ++i) { pa[i] = is14 ? a2[i] : a1[i]; pg[i] = is14 ? g2[i] : g1[i]; } }
#pragma unroll
                for (int m = 0; m < 4; ++m) {
                    const int row = row0 + ai * HALF + m * 16; const float s = rs[ai][m];
                    const f32x4 ua = acc[ai][0][m][n] * s, ug = acc[ai][1][m][n] * s;
                    float r[4];
#pragma unroll
                    for (int i = 0; i < 4; ++i) {
                        const float oa1 = DPPF(0.f, pa[i], 0x121), oa2 = DPPF(0.f, pa[i], 0x122), og1 = DPPF(0.f, pg[i], 0x121), og2 = DPPF(0.f, pg[i], 0x122);
                        const float a1 = DPPF(oa1, ua[i], 0x111), a2 = DPPF(oa2, ua[i], 0x112), g1 = DPPF(og1, ug[i], 0x111), g2 = DPPF(og2, ug[i], 0x112);
                        const float ca = wa[0][i] * a2 + wa[1][i] * a1 + wa[2][i] * ua[i] + ba[i];
                        const float cg = wg[0][i] * g2 + wg[1][i] * g1 + wg[2][i] * ug[i] + bg[i];
                        r[i] = ca * (cg * __builtin_amdgcn_rcpf(1.0f + __builtin_amdgcn_exp2f(-1.4426950408889634f * cg)));
                    }
                    pa = ua; pg = ug;
                    u32x2v w; w.x = cvt_pk_bf16(r[0], r[1]); w.y = cvt_pk_bf16(r[2], r[3]);
                    *(u32x2v*)(ACT + (size_t)row * 2816 + cha) = w;
                }
            }
        }
    }
};
template <class Epi, class Sched, bool ALIGN_EPI = false, bool SP2 = false>
__device__ __forceinline__ void gemm_phase(PG8_LAS unsigned char* lds, const Gemm g, const Sched& S, const Epi& E) {
    int tid_l = threadIdx.x; asm volatile("" : "+v"(tid_l));
    const int tid = tid_l, wid = __builtin_amdgcn_readfirstlane(tid >> 6), lane = tid & 63, wr = wid >> 2, wc = wid & 3, fr = lane & 15, fq = lane >> 4;
    const int K = g.K, nt = K / BK;
    unsigned voffA[2], voffB[2];
#pragma unroll
    for (int i = 0; i < 2; ++i) { int R, C; stage_rc(tid * 16 + i * 8192, R, C); const int Rb = Epi::PERM ? ((R & ~31) + perm32(R & 31)) : R;
        voffA[i] = (unsigned)(R * K + C) * 2u; voffB[i] = (unsigned)(Rb * K + C) * 2u; }
    const size_t kstep = (size_t)(BK * 2);
    const size_t hstep = (size_t)HALF * K * 2;
    const size_t tstep = 2 * hstep;
    const unsigned ldsw = (unsigned)wid * 1024u;
    const int aoff = lds_byte(wr * 64 + fr, fq * 8), boff = lds_byte(wc * 32 + fr, fq * 8);
#define PG8_SA(b, h) (((b) * 2 + (h)) * HTB)
#define PG8_SB(b, h) ((4 + (b) * 2 + (h)) * HTB)
#define PG8_STAGE(bufoff, gbase, voff) do { _Pragma("unroll") for (int _i = 0; _i < 2; ++_i) \
        __builtin_amdgcn_global_load_lds((const unsigned*)((const char*)(gbase) + (voff)[_i]), (PG8_LAS unsigned*)(lds + (bufoff) + ldsw + _i * 8192), 16, 0, 0); } while (0)
#define PG8_LDA(dst, b, h) do { _Pragma("unroll") for (int m = 0; m < 4; ++m) _Pragma("unroll") for (int k = 0; k < 2; ++k) dst[m][k] = *(const PG8_LAS bf16x8*)(lds + PG8_SA(b, h) + aoff + m * 2048 + k * 1024); } while (0)
#define PG8_LDB(dst, b, h) do { _Pragma("unroll") for (int n = 0; n < 2; ++n) _Pragma("unroll") for (int k = 0; k < 2; ++k) dst[n][k] = *(const PG8_LAS bf16x8*)(lds + PG8_SB(b, h) + boff + n * 2048 + k * 1024); } while (0)
#define PG8_MMA(ai, bj, At, Bt) do { __builtin_amdgcn_s_setprio(1); _Pragma("unroll") for (int m = 0; m < 4; ++m) _Pragma("unroll") for (int n = 0; n < 2; ++n) _Pragma("unroll") for (int k = 0; k < 2; ++k) \
        acc[ai][bj][m][n] = __builtin_amdgcn_mfma_f32_16x16x32_bf16(Bt[n][k], At[m][k], acc[ai][bj][m][n], 0, 0, 0); __builtin_amdgcn_s_setprio(0); } while (0)
#define PG8_WAIT_V(n) asm volatile("s_waitcnt vmcnt(" #n ")" ::: "memory")
#define PG8_WAIT_L(n) asm volatile("s_waitcnt lgkmcnt(" #n ")" ::: "memory")
#define PG8_BAR __builtin_amdgcn_s_barrier()
#define PG8_SCHED __builtin_amdgcn_sched_barrier(0)
    Unit cur, nxt; int ui = 0;
    if (!S.next(0, cur)) return;
    f32x4 acc[2][2][4][2];
#pragma unroll
    for (int a = 0; a < 2; ++a)
#pragma unroll
        for (int b = 0; b < 2; ++b)
#pragma unroll
            for (int m = 0; m < 4; ++m)
#pragma unroll
                for (int n = 0; n < 2; ++n) acc[a][b][m][n] = (f32x4){0.f, 0.f, 0.f, 0.f};
    bf16x8 At[4][2], B0[2][2], B1[2][2];
    const char* cA = (const char*)g.A + (size_t)cur.pm * tstep; const char* cB = (const char*)g.Bt + (size_t)cur.pn * tstep;
    S.a_ready(cur);
    if constexpr (SP2) {
        PG8_STAGE(PG8_SB(0, 0), cB, voffB); PG8_STAGE(PG8_SB(0, 1), cB + hstep, voffB); PG8_STAGE(PG8_SA(0, 0), cA, voffA); PG8_STAGE(PG8_SA(0, 1), cA + hstep, voffA);
        if (wr == 1) PG8_BAR;
        PG8_WAIT_V(2); PG8_BAR;
        PG8_STAGE(PG8_SB(1, 0), cB + kstep, voffB); PG8_STAGE(PG8_SA(1, 0), cA + kstep, voffA); PG8_STAGE(PG8_SB(1, 1), cB + hstep + kstep, voffB);
        PG8_WAIT_V(6); PG8_BAR;
    } else {
        PG8_STAGE(PG8_SB(0, 0), cB, voffB); PG8_STAGE(PG8_SA(0, 0), cA, voffA); PG8_STAGE(PG8_SB(0, 1), cB + hstep, voffB); PG8_STAGE(PG8_SA(0, 1), cA + hstep, voffA);
        if (wr == 1) PG8_BAR;
        PG8_WAIT_V(4); PG8_BAR;
        PG8_STAGE(PG8_SB(1, 0), cB + kstep, voffB); PG8_STAGE(PG8_SA(1, 0), cA + kstep, voffA); PG8_STAGE(PG8_SB(1, 1), cB + hstep + kstep, voffB);
        PG8_WAIT_V(6); PG8_BAR;
    }
    for (;;) {
        const bool has_next = S.next(ui + 1, nxt);
        const char* nA = has_next ? (const char*)g.A + (size_t)nxt.pm * tstep : cA; const char* nB = has_next ? (const char*)g.Bt + (size_t)nxt.pn * tstep : cB;
        for (int t = 0; t < nt; t += 2) {
            const bool last = (t == nt - 2);
            const char* a1 = cA + (size_t)(t + 1) * kstep;
            const char* a2 = last ? nA : cA + (size_t)(t + 2) * kstep; const char* b2 = last ? nB : cB + (size_t)(t + 2) * kstep;
            const char* a3 = a2 + kstep; const char* b3 = b2 + kstep;
            if (last && has_next) S.a_ready(nxt);
            if constexpr (SP2) {
            PG8_LDB(B0, 0, 0); PG8_LDB(B1, 0, 1); PG8_SCHED; PG8_LDA(At, 0, 0); PG8_STAGE(PG8_SA(1, 1), a1 + hstep, voffA);
            PG8_WAIT_V(8); PG8_WAIT_L(0); PG8_BAR; PG8_MMA(0, 0, At, B0); PG8_MMA(0, 1, At, B1); PG8_BAR; PG8_SCHED;
            PG8_LDA(At, 0, 1); PG8_STAGE(PG8_SB(0, 0), b2, voffB); PG8_STAGE(PG8_SB(0, 1), b2 + hstep, voffB); PG8_STAGE(PG8_SA(0, 0), a2, voffA);
            PG8_WAIT_V(8); PG8_WAIT_L(0); PG8_BAR; PG8_MMA(1, 0, At, B0); PG8_MMA(1, 1, At, B1); PG8_BAR; PG8_SCHED;
            PG8_LDB(B0, 1, 0); PG8_LDB(B1, 1, 1); PG8_SCHED; PG8_LDA(At, 1, 0); PG8_STAGE(PG8_SA(0, 1), a2 + hstep, voffA);
            PG8_WAIT_V(8); PG8_WAIT_L(0); PG8_BAR; PG8_MMA(0, 0, At, B0); PG8_MMA(0, 1, At, B1); PG8_BAR; PG8_SCHED;
            PG8_LDA(At, 1, 1); PG8_STAGE(PG8_SB(1, 0), b3, voffB); PG8_STAGE(PG8_SB(1, 1), b3 + hstep, voffB); PG8_STAGE(PG8_SA(1, 0), a3, voffA);
            PG8_WAIT_V(8); PG8_WAIT_L(0); PG8_BAR; PG8_MMA(1, 0, At, B0); PG8_MMA(1, 1, At, B1); PG8_BAR; PG8_SCHED;
            } else {
            PG8_LDB(B0, 0, 0); PG8_SCHED; PG8_LDA(At, 0, 0); PG8_STAGE(PG8_SA(1, 1), a1 + hstep, voffA);
            PG8_WAIT_L(8); PG8_BAR; PG8_WAIT_L(0); PG8_MMA(0, 0, At, B0); PG8_BAR; PG8_SCHED;
            PG8_LDB(B1, 0, 1); PG8_STAGE(PG8_SB(0, 0), b2, voffB);
            PG8_BAR; PG8_WAIT_L(0); PG8_MMA(0, 1, At, B1); PG8_BAR;
            PG8_LDA(At, 0, 1); PG8_STAGE(PG8_SA(0, 0), a2, voffA);
            PG8_BAR; PG8_WAIT_L(0); PG8_MMA(1, 0, At, B0); PG8_BAR; PG8_SCHED;
            PG8_STAGE(PG8_SB(0, 1), b2 + hstep, voffB);
            PG8_WAIT_V(6); PG8_BAR; PG8_MMA(1, 1, At, B1); PG8_BAR;
            PG8_LDB(B0, 1, 0); PG8_SCHED; PG8_LDA(At, 1, 0); PG8_STAGE(PG8_SA(0, 1), a2 + hstep, voffA);
            PG8_WAIT_L(8); PG8_BAR; PG8_WAIT_L(0); PG8_MMA(0, 0, At, B0); PG8_BAR; PG8_SCHED;
            PG8_LDB(B1, 1, 1); PG8_STAGE(PG8_SB(1, 0), b3, voffB);
            PG8_BAR; PG8_WAIT_L(0); PG8_MMA(0, 1, At, B1); PG8_BAR;
            PG8_LDA(At, 1, 1); PG8_STAGE(PG8_SA(1, 0), a3, voffA);
            PG8_BAR; PG8_WAIT_L(0); PG8_MMA(1, 0, At, B0); PG8_BAR; PG8_SCHED;
            PG8_STAGE(PG8_SB(1, 1), b3 + hstep, voffB);
            PG8_WAIT_V(6); PG8_BAR; PG8_MMA(1, 1, At, B1); PG8_BAR;
            }
        }
        if constexpr (ALIGN_EPI) { if (wr == 0) PG8_BAR; }
        if constexpr (!Epi::AFTER_DRAIN) { E(acc, cur, wr, wc, fr, fq); S.done(cur); }
        if (!has_next) break;
#pragma unroll
        for (int a = 0; a < 2; ++a)
#pragma unroll
            for (int b = 0; b < 2; ++b)
#pragma unroll
                for (int m = 0; m < 4; ++m)
#pragma unroll
                    for (int n = 0; n < 2; ++n) acc[a][b][m][n] = (f32x4){0.f, 0.f, 0.f, 0.f};
        cur = nxt; cA = nA; cB = nB; ++ui;
        if constexpr (ALIGN_EPI) { if (wr == 1) PG8_BAR; }
    }
    PG8_WAIT_V(0);
    if constexpr (!ALIGN_EPI) { if (wr == 0) PG8_BAR; }
    PG8_BAR;
    if constexpr (Epi::AFTER_DRAIN) { E.fused(acc, cur, wr, wc, fr, fq, lds, wid, lane); S.done(cur); }
#undef PG8_SA
#undef PG8_SB
#undef PG8_STAGE
#undef PG8_LDA
#undef PG8_LDB
#undef PG8_MMA
#undef PG8_WAIT_V
#undef PG8_WAIT_L
#undef PG8_BAR
#undef PG8_SCHED
}
}
constexpr int NWAVES = 8;
constexpr int BATCH = 8, SEQ = 4096, DM = 1024, T = BATCH * SEQ, DFF = 2816, NBN = T / 64;
constexpr float EPS = 1e-6f, LOG2E_ = 1.4426950408889634f;
constexpr float LAM_INIT = 0.35550906759096934f;
constexpr size_t MiB = 1u << 20;
constexpr size_t WS_CTL = 0, CTL_ZERO_BYTES = 1 * MiB;
constexpr size_t WS_W1T = 2 * MiB, WS_WG1T = 8 * MiB, WS_WO1T = 9 * MiB, WS_WIN0T = 11 * MiB, WS_WOUT0T = 22 * MiB, WS_WKVQT = 28 * MiB, WS_WO2T = 34 * MiB, WS_WIN1T = 36 * MiB, WS_WOUT1T = 47 * MiB;
constexpr size_t WS_COS = 53 * MiB, WS_SIN = 53 * MiB + 512 * 1024, WS_RSTD = 54 * MiB, WS_DEC = 55 * MiB;
constexpr size_t WS_XB = 64 * MiB;
constexpr size_t WS_BIG = 128 * MiB;
constexpr size_t WS_QKVG = WS_BIG;
constexpr size_t WS_QI = 320 * MiB, WS_KET = 352 * MiB, WS_PM = 384 * MiB, WS_VT = 400 * MiB;
constexpr size_t WS_OGATE = 320 * MiB;
constexpr size_t WS_U = WS_BIG;
constexpr size_t WS_ACT = 320 * MiB;
constexpr size_t WS_KR = 128 * MiB, WS_VR = 192 * MiB, WS_QR = 256 * MiB, WS_AO = 320 * MiB;
constexpr size_t WS_UH = 496 * MiB, WS_AH = 507 * MiB, WS_RSTDH = 54 * MiB + 256 * 1024;
constexpr size_t WS_PS = 56 * MiB;
constexpr size_t WS_END = 512 * MiB;
constexpr int CW_BAR = 4096;
constexpr int RING_BYTES = 131072, LDSCTL_OFF = 147456, MISC_OFF = LDSCTL_OFF + 320, LDS_BYTES = 155648;

#define GAS __attribute__((address_space(1)))
#define LAS __attribute__((address_space(3)))
typedef unsigned short bf16;
typedef unsigned v4u __attribute__((ext_vector_type(4)));
typedef unsigned v2u __attribute__((ext_vector_type(2)));
typedef float f32x4 __attribute__((ext_vector_type(4)));
typedef float f32x16 __attribute__((ext_vector_type(16)));
typedef short bf16x8 __attribute__((ext_vector_type(8)));
typedef short s16x4 __attribute__((ext_vector_type(4)));
typedef GAS unsigned gu32;
#define RLX_AGENT __ATOMIC_RELAXED, __HIP_MEMORY_SCOPE_AGENT
#define LDS_WAIT() asm volatile("s_waitcnt lgkmcnt(0)" ::: "memory")
__device__ __forceinline__ unsigned f2bf(float f) { unsigned u = __builtin_bit_cast(unsigned, f); return (u + 0x7fffu + ((u >> 16) & 1u)) >> 16; }
typedef float f32x2_t __attribute__((ext_vector_type(2))); typedef __bf16 bf16x2_t __attribute__((ext_vector_type(2)));
__device__ __forceinline__ unsigned cvtpk(float lo, float hi) { f32x2_t v = {lo, hi}; bf16x2_t b = __builtin_convertvector(v, bf16x2_t); return __builtin_bit_cast(unsigned, b); }
__device__ __forceinline__ unsigned pk2(float lo, float hi) { return cvtpk(lo, hi); }
__device__ __forceinline__ float bf2f(unsigned short x) { return __builtin_bit_cast(float, (unsigned)x << 16); }
__device__ __forceinline__ float bflo(unsigned w) { return __builtin_bit_cast(float, w << 16); }
__device__ __forceinline__ float bfhi(unsigned w) { return __builtin_bit_cast(float, w & 0xffff0000u); }
#define MFMA_BF16(a, b, c) __builtin_amdgcn_mfma_f32_32x32x16_bf16(a, b, c, 0, 0, 0)

#define XB_TMO      128
#define XB_XCNT(j)  (256  + 64 * (j))
#define XB_XSUB(j)  (1280 + 64 * (j))
#define XB_XGEN(j)  (2304 + 64 * (j))
#define XB_TOP      3328
#define XB_TOPGEN   3392
#define XCD_BAR_WORDS 3456
#define XB_SPIN_CAP (1u << 18)

__device__ __forceinline__ unsigned xb_ld(unsigned* p)              { return __hip_atomic_load(p, __ATOMIC_RELAXED, __HIP_MEMORY_SCOPE_AGENT); }
__device__ __forceinline__ unsigned xb_add(unsigned* p, unsigned v) { return __hip_atomic_fetch_add(p, v, __ATOMIC_RELAXED, __HIP_MEMORY_SCOPE_AGENT); }
__device__ __forceinline__ unsigned xb_xcc_id() { return (unsigned)__builtin_amdgcn_s_getreg((3 << 11) | 20) & 0xFu; }
#define XB_SPIN(cond, bar) do { unsigned _sp = 0; while (cond) { __builtin_amdgcn_s_sleep(1); \
    if ((++_sp & 255u) == 0u) { if (xb_ld(&(bar)[XB_TMO])) break; if (_sp > XB_SPIN_CAP) { atomicAdd(&(bar)[XB_TMO], 1u); break; } } } } while (0)

struct XcdBarrier {
    unsigned* bar; unsigned x;
    volatile LAS unsigned* st;
};

__device__ __forceinline__ XcdBarrier xcd_barrier_post(unsigned* bar, volatile LAS unsigned* st) {
    XcdBarrier b; b.bar = bar; b.x = xb_xcc_id(); b.st = st;
    if (threadIdx.x == 0) (void)xb_add(&bar[XB_XCNT(b.x)], 1u);
    return b;
}
__device__ __forceinline__ void xcd_barrier_complete(unsigned* bar, unsigned x, unsigned& nloc, unsigned& nx) {
    const unsigned G = gridDim.x * gridDim.y * gridDim.z;
    unsigned sum, cnt, mine, sp = 0u;
    for (;;) {
        sum = 0u; cnt = 0u; mine = 0u;
#pragma unroll
        for (unsigned j = 0; j < 16; ++j) { const unsigned c = xb_ld(&bar[XB_XCNT(j)]); sum += c; cnt += (c > 0u) ? 1u : 0u; mine = (j == x) ? c : mine; }
        if (sum == G) break;
        __builtin_amdgcn_s_sleep(1);
        if ((++sp & 255u) == 0u) { if (xb_ld(&bar[XB_TMO])) break; if (sp > XB_SPIN_CAP) { atomicAdd(&bar[XB_TMO], 1u); break; } }
    }
    nloc = mine > 0u ? mine : 1u; nx = cnt > 0u ? cnt : 1u;
}

__device__ __forceinline__ void xcd_barrier(const XcdBarrier& b) {
    asm volatile("s_waitcnt vmcnt(0)" ::: "memory");
    __syncthreads();
    if (threadIdx.x == 0) {
        unsigned* bar = b.bar; asm volatile("" : "+s"(bar));
        __builtin_amdgcn_s_waitcnt(0);
        unsigned nloc = b.st[0], nx = b.st[1];
        if (nloc == 0u) { xcd_barrier_complete(bar, b.x, nloc, nx); b.st[0] = nloc; b.st[1] = nx; }
        const unsigned old = xb_add(&bar[XB_XSUB(b.x)], 1u);
        const unsigned gen = old / nloc;
        if (old + 1u == (gen + 1u) * nloc) {
            __builtin_amdgcn_fence(__ATOMIC_RELEASE, "agent");
            asm volatile("s_waitcnt vmcnt(0)" ::: "memory");
            const unsigned og = xb_add(&bar[XB_TOP], 1u);
            const unsigned tg = og / nx;
            if (og + 1u == (tg + 1u) * nx) xb_add(&bar[XB_TOPGEN], 1u);
            else XB_SPIN(xb_ld(&bar[XB_TOPGEN]) == tg, bar);
            __builtin_amdgcn_fence(__ATOMIC_ACQUIRE, "agent");
            xb_add(&bar[XB_XGEN(b.x)], 1u);
            asm volatile("s_waitcnt vmcnt(0)" ::: "memory");
        } else {
            XB_SPIN(xb_ld(&bar[XB_XGEN(b.x)]) == gen, bar);
            __builtin_amdgcn_fence(__ATOMIC_ACQUIRE, "agent");
            asm volatile("s_waitcnt vmcnt(0)" ::: "memory");
        }
    }
    __syncthreads();
}


__device__ __forceinline__ float wave_sum(float v) {
#pragma unroll
    for (int o = 1; o < 64; o <<= 1) v += __shfl_xor(v, o);
    return v;
}

struct Args { const float* in[20]; float* out; unsigned char* ws; int ph_lo, ph_hi; };
enum { I_X = 0, I_ATTN_NORM, I_FFN_NORM, I_WQKVG, I_WGK1, I_WGK2, I_BGK, I_ONORM, I_GLA_WO, I_KVNORM, I_WKV, I_WQ, I_LAMBDA, I_SUBLN, I_DIFF_WO, I_WIN, I_CONVW, I_CONVB, I_WOUT, I_FINAL };

template <int MAP> __device__ __forceinline__ int map_row(int s) {
    if (MAP == 0) return s;
    if (MAP == 1) { const int half = s >= DFF ? 1 : 0, j = s - half * DFF; return (j >> 7) * 256 + half * 128 + (j & 127); }
    const int tile = s >> 8, cidx = (s >> 6) & 3, d = s & 63, bj = cidx >> 1, wcp = cidx & 1, n = d >> 5, dd = d & 31;
    return tile * 256 + 128 * bj + 32 * (2 * wcp + (dd >> 4)) + 16 * n + 4 * ((dd & 15) >> 2) + (dd & 3);
}
template <int MAP> __device__ __forceinline__ void transpose_item(const float* W, int ldw, int K, int N, const float* gain, float scale, bf16* WT, int row_off, LAS float* scr, int item, int lane) {
    const int nblk = N / 32, kb = item / nblk, nb = item % nblk, k0 = 64 * kb, n0 = 32 * nb;
#pragma unroll
    for (int i = 0; i < 8; ++i) { const int kk = 8 * i + (lane >> 3), n4 = (lane & 7) * 4; const float g = gain ? gain[k0 + kk] * scale : scale;
        const f32x4 w = *(const f32x4*)(W + (size_t)(k0 + kk) * ldw + n0 + n4);
        scr[kk * 33 + n4] = w[0] * g; scr[kk * 33 + n4 + 1] = w[1] * g; scr[kk * 33 + n4 + 2] = w[2] * g; scr[kk * 33 + n4 + 3] = w[3] * g; }
    LDS_WAIT(); asm volatile("" ::: "memory");
    const int c = lane & 7;
#pragma unroll
    for (int j = 0; j < 4; ++j) { const int n = (lane >> 3) + 8 * j; const LAS float* s = scr + (8 * c) * 33 + n;
        v4u o; o.x = pk2(s[0 * 33], s[1 * 33]); o.y = pk2(s[2 * 33], s[3 * 33]); o.z = pk2(s[4 * 33], s[5 * 33]); o.w = pk2(s[6 * 33], s[7 * 33]);
        *(v4u*)(WT + (size_t)(row_off + map_row<MAP>(n0 + n)) * K + k0 + 8 * c) = o; }
    LDS_WAIT(); asm volatile("" ::: "memory");
}
__device__ __forceinline__ void sincos_d(double x, double& s, double& c) {
    const double k = __builtin_rint(x * 0.15915494309189535);
    double r = __builtin_fma(-k, 6.283185307179586, x); r = __builtin_fma(-k, 2.4492935982947064e-16, r);
    const double y = r * 0.25, y2 = y * y;
    double sy = 1.0 - y2 * (1.0 / 272.0);
    sy = 1.0 - y2 * (1.0 / 210.0) * sy; sy = 1.0 - y2 * (1.0 / 156.0) * sy; sy = 1.0 - y2 * (1.0 / 110.0) * sy; sy = 1.0 - y2 * (1.0 / 72.0) * sy;
    sy = 1.0 - y2 * (1.0 / 42.0) * sy; sy = 1.0 - y2 * (1.0 / 20.0) * sy; sy = 1.0 - y2 * (1.0 / 6.0) * sy; sy = y * sy;
    double cy = 1.0 - y2 * (1.0 / 240.0);
    cy = 1.0 - y2 * (1.0 / 182.0) * cy; cy = 1.0 - y2 * (1.0 / 132.0) * cy; cy = 1.0 - y2 * (1.0 / 90.0) * cy; cy = 1.0 - y2 * (1.0 / 56.0) * cy;
    cy = 1.0 - y2 * (1.0 / 30.0) * cy; cy = 1.0 - y2 * (1.0 / 12.0) * cy; cy = 1.0 - y2 * 0.5 * cy;
    const double s2 = 2.0 * sy * cy, c2 = 1.0 - 2.0 * sy * sy;
    s = 2.0 * s2 * c2; c = 1.0 - 2.0 * s2 * s2;
}
__device__ __forceinline__ void row_to_bf16_ps(const float* xrow, bf16* orow, float* ps_row, int lane) {
    const f32x4* xr = (const f32x4*)xrow + lane;
    f32x4 v[4]; float s = 0.f;
#pragma unroll
    for (int j = 0; j < 4; ++j) { v[j] = xr[64 * j]; s += (v[j].x * v[j].x + v[j].y * v[j].y) + (v[j].z * v[j].z + v[j].w * v[j].w); }
    s = wave_sum(s);
    if (lane < 16) ps_row[lane] = lane == 0 ? s : 0.f;
    unsigned long long* o8 = (unsigned long long*)orow + lane;
#pragma unroll
    for (int j = 0; j < 4; ++j) o8[64 * j] = (unsigned long long)pk2(v[j].x, v[j].y) | ((unsigned long long)pk2(v[j].z, v[j].w) << 32);
}
__device__ __forceinline__ void p0_prologue(const Args& A, LAS unsigned char* lds, int vcu, int G, int wave, int lane, int tid) {
    unsigned char* ws = A.ws;
    LAS float* scr = (LAS float*)(lds + wave * 16384);
    const int gw = vcu * NWAVES + wave, NGW = G * NWAVES;
    constexpr int I0 = (DM / 64) * (3072 / 32), I1 = (DM / 64) * (DM / 32), I2 = (DM / 64) * (2 * DFF / 32), I3 = (DFF / 64) * (DM / 32);
    constexpr int NITEMS = I0 + I1 + I2 + I3 + 3 * I1 + I1 + I2 + I3;
    const float QS = 0.18033688011112042f;
    for (int it = gw; it < NITEMS; it += NGW) {
        int r = it;
        if (r < I0) { transpose_item<0>(A.in[I_WQKVG], 3072, DM, 3072, A.in[I_ATTN_NORM], 1.f, (bf16*)(ws + WS_W1T), 0, scr, r, lane); continue; } r -= I0;
        if (r < I1) { transpose_item<0>(A.in[I_GLA_WO], DM, DM, DM, nullptr, 1.f, (bf16*)(ws + WS_WO1T), 0, scr, r, lane); continue; } r -= I1;
        if (r < I2) { transpose_item<1>(A.in[I_WIN], 2 * DFF, DM, 2 * DFF, A.in[I_FFN_NORM], 1.f, (bf16*)(ws + WS_WIN0T), 0, scr, r, lane); continue; } r -= I2;
        if (r < I3) { transpose_item<0>(A.in[I_WOUT], DM, DFF, DM, nullptr, 1.f, (bf16*)(ws + WS_WOUT0T), 0, scr, r, lane); continue; } r -= I3;
        if (r < I1) { transpose_item<2>(A.in[I_WKV], 2048, DM, 1024, A.in[I_KVNORM], 1.f, (bf16*)(ws + WS_WKVQT), 0, scr, r, lane); continue; } r -= I1;
        if (r < I1) { transpose_item<0>(A.in[I_WKV] + 1024, 2048, DM, 1024, A.in[I_KVNORM], 1.f, (bf16*)(ws + WS_WKVQT), 1024, scr, r, lane); continue; } r -= I1;
        if (r < I1) { transpose_item<2>(A.in[I_WQ], DM, DM, 1024, A.in[I_ATTN_NORM] + DM, QS, (bf16*)(ws + WS_WKVQT), 2048, scr, r, lane); continue; } r -= I1;
        if (r < I1) { transpose_item<0>(A.in[I_DIFF_WO], DM, DM, DM, nullptr, 1.f, (bf16*)(ws + WS_WO2T), 0, scr, r, lane); continue; } r -= I1;
        if (r < I2) { transpose_item<1>(A.in[I_WIN] + (size_t)DM * 2 * DFF, 2 * DFF, DM, 2 * DFF, A.in[I_FFN_NORM] + DM, 1.f, (bf16*)(ws + WS_WIN1T), 0, scr, r, lane); continue; } r -= I2;
        transpose_item<0>(A.in[I_WOUT] + (size_t)DFF * DM, DM, DFF, DM, nullptr, 1.f, (bf16*)(ws + WS_WOUT1T), 0, scr, r, lane);
    }
    const int gt = vcu * (NWAVES * 64) + tid, NGT = G * NWAVES * 64;
    for (int i = gt; i < 32 * DM; i += NGT) { const int j = i >> 10, k = i & 1023; ((bf16*)(ws + WS_WG1T))[i] = j < 16 ? (bf16)f2bf(A.in[I_WGK1][k * 16 + j] * A.in[I_ATTN_NORM][k]) : (bf16)0; }
    for (int i = gt; i < SEQ * 32; i += NGT) { const int pos = i >> 5, fi = i & 31; double inv = 1.0; for (int q = 0; q < fi; ++q) inv *= 0.7498942093324558;
        double s, c; sincos_d((double)pos * inv, s, c); ((float*)(ws + WS_COS))[i] = (float)c; ((float*)(ws + WS_SIN))[i] = (float)s; }
    for (int i = gt; i < 1024 * DM / 8; i += NGT) ((v4u*)(ws + WS_AH))[i] = (v4u){0u, 0u, 0u, 0u};
    for (int m = gw; m < T; m += 2 * NGW) {
        const int m2 = m + NGW; const bool h2 = m2 < T;
        const f32x4* xa = (const f32x4*)(A.in[I_X] + (size_t)m * DM) + lane; const f32x4* xb2 = (const f32x4*)(A.in[I_X] + (size_t)(h2 ? m2 : m) * DM) + lane;
        f32x4 va[4], vb[4]; float sa = 0.f, sb = 0.f;
#pragma unroll
        for (int j = 0; j < 4; ++j) { va[j] = xa[64 * j]; vb[j] = xb2[64 * j]; }
#pragma unroll
        for (int j = 0; j < 4; ++j) { sa += (va[j].x * va[j].x + va[j].y * va[j].y) + (va[j].z * va[j].z + va[j].w * va[j].w); sb += (vb[j].x * vb[j].x + vb[j].y * vb[j].y) + (vb[j].z * vb[j].z + vb[j].w * vb[j].w); }
        sa = wave_sum(sa); sb = wave_sum(sb);
        if (lane == 0) { ((float*)(ws + WS_RSTD))[m] = __builtin_amdgcn_rsqf(sa * (1.0f / DM) + EPS); if (h2) ((float*)(ws + WS_RSTD))[m2] = __builtin_amdgcn_rsqf(sb * (1.0f / DM) + EPS); }
        unsigned long long* oa = (unsigned long long*)((bf16*)(ws + WS_XB) + (size_t)m * DM) + lane; unsigned long long* ob = (unsigned long long*)((bf16*)(ws + WS_XB) + (size_t)m2 * DM) + lane;
#pragma unroll
        for (int j = 0; j < 4; ++j) { oa[64 * j] = (unsigned long long)pk2(va[j].x, va[j].y) | ((unsigned long long)pk2(va[j].z, va[j].w) << 32);
            if (h2) ob[64 * j] = (unsigned long long)pk2(vb[j].x, vb[j].y) | ((unsigned long long)pk2(vb[j].z, vb[j].w) << 32); }
    }
}

__device__ __forceinline__ void final_norm_phase(const bf16* HB, const float* PS, float* out, const float* w, int vcu, int G, int wave, int lane) {
    const int gw = vcu * NWAVES + wave, NGW = G * NWAVES;
    const f32x4* wp = (const f32x4*)w + 2 * lane; const f32x4 w00 = wp[0], w01 = wp[1], w10 = wp[128], w11 = wp[129];
    for (int m0 = gw; m0 < T; m0 += 4 * NGW) {
        v4u r0[4], r1[4]; float rs[4];
#pragma unroll
        for (int q = 0; q < 4; ++q) { const int m = m0 + q * NGW; const int mm = m < T ? m : m0; const v4u* hp = (const v4u*)(HB + (size_t)mm * DM) + lane; r0[q] = hp[0]; r1[q] = hp[64]; rs[q] = pg8::rstd_ps(PS, mm); }
#pragma unroll
        for (int q = 0; q < 4; ++q) { const int m = m0 + q * NGW; if (m < T) { f32x4* op = (f32x4*)(out + (size_t)m * DM) + 2 * lane; const float rstd = rs[q];
            f32x4 a, b; a[0] = bflo(r0[q].x); a[1] = bfhi(r0[q].x); a[2] = bflo(r0[q].y); a[3] = bfhi(r0[q].y); b[0] = bflo(r0[q].z); b[1] = bfhi(r0[q].z); b[2] = bflo(r0[q].w); b[3] = bfhi(r0[q].w);
            op[0] = a * rstd * w00; op[1] = b * rstd * w01;
            a[0] = bflo(r1[q].x); a[1] = bfhi(r1[q].x); a[2] = bflo(r1[q].y); a[3] = bfhi(r1[q].y); b[0] = bflo(r1[q].z); b[1] = bfhi(r1[q].z); b[2] = bflo(r1[q].w); b[3] = bfhi(r1[q].w);
            op[128] = a * rstd * w10; op[129] = b * rstd * w11; } }
    }
}
__device__ __forceinline__ void gla_gate_phase(const bf16* O, const bf16* QKVG, const float* onw, bf16* OG, int vcu, int G, int wave, int lane) {
    const int gw = vcu * NWAVES + wave, NGW = G * NWAVES;
    const f32x4* wp = (const f32x4*)(onw + 16 * (lane & 15)); const f32x4 wq[4] = {wp[0], wp[1], wp[2], wp[3]};
    for (int m0 = gw; m0 < T; m0 += 4 * NGW) {
        v4u o0[4], o1[4], g0[4], g1[4];
#pragma unroll
        for (int q = 0; q < 4; ++q) { const int m = m0 + q * NGW; const int mm = m < T ? m : m0; const v4u* op = (const v4u*)(O + (size_t)mm * DM + 16 * lane); const v4u* gp = (const v4u*)(QKVG + (size_t)mm * 3072 + 2048 + 16 * lane);
            o0[q] = op[0]; o1[q] = op[1]; g0[q] = gp[0]; g1[q] = gp[1]; }
#pragma unroll
        for (int q = 0; q < 4; ++q) { const int m = m0 + q * NGW; if (m < T) {
            float ov[16], gv[16];
#pragma unroll
            for (int i = 0; i < 4; ++i) { ov[2 * i] = bflo(o0[q][i]); ov[2 * i + 1] = bfhi(o0[q][i]); ov[8 + 2 * i] = bflo(o1[q][i]); ov[8 + 2 * i + 1] = bfhi(o1[q][i]);
                                          gv[2 * i] = bflo(g0[q][i]); gv[2 * i + 1] = bfhi(g0[q][i]); gv[8 + 2 * i] = bflo(g1[q][i]); gv[8 + 2 * i + 1] = bfhi(g1[q][i]); }
            float s = 0.f;
#pragma unroll
            for (int i = 0; i < 16; ++i) s += ov[i] * ov[i];
            s += __shfl_xor(s, 1); s += __shfl_xor(s, 2); s += __shfl_xor(s, 4); s += __shfl_xor(s, 8);
            const float rstd = __builtin_amdgcn_rsqf(s * (1.0f / 256.0f) + EPS);
            float r[16];
#pragma unroll
            for (int k = 0; k < 4; ++k)
#pragma unroll
                for (int i = 0; i < 4; ++i) { const float g = gv[4 * k + i]; r[4 * k + i] = ov[4 * k + i] * rstd * wq[k][i] * (g * __builtin_amdgcn_rcpf(1.0f + __builtin_amdgcn_exp2f(-LOG2E_ * g))); }
            v4u w0, w1;
#pragma unroll
            for (int i = 0; i < 4; ++i) { w0[i] = pk2(r[2 * i], r[2 * i + 1]); w1[i] = pk2(r[8 + 2 * i], r[8 + 2 * i + 1]); }
            v4u* dp = (v4u*)(OG + (size_t)m * DM + 16 * lane); dp[0] = w0; dp[1] = w1; } }
    }
}
constexpr float LOG2E = 1.4426950408889634f, LN2 = 0.6931471805599453f;
__device__ __forceinline__ void gla_pre_unit(const Args& A, int bn, LAS unsigned char* lds, int tid_in, int wave) {
    int tid = tid_in; asm volatile("" : "+v"(tid)); const int lane = tid & 63;
    unsigned char* ws = A.ws;
    const bf16* XB = (const bf16*)(ws + WS_XB); const bf16* WG1T = (const bf16*)(ws + WS_WG1T); const float* PS = (const float*)(ws + WS_PS);
    const bf16* QKVG = (const bf16*)(ws + WS_QKVG);
    bf16* QIG = (bf16*)(ws + WS_QI); bf16* KIG = (bf16*)(ws + WS_KET); bf16* PM = (bf16*)(ws + WS_PM); float* DEC = (float*)(ws + WS_DEC);
    const int row0 = bn * 64, cl = lane & 31, h = lane >> 5;
    LAS float* r_lds = (LAS float*)lds;
    LAS float* part = (LAS float*)(lds + 4608);
    LAS unsigned char* QIl = lds + 4608;
    LAS unsigned char* KIl = lds + 4608 + 69632;
    v4u qraw[8], kraw[8];
#pragma unroll
    for (int q = 0; q < 8; ++q) { const int idx = tid + 512 * q, t = idx >> 6, ch8 = idx & 63; const bf16* p = QKVG + (size_t)(row0 + t) * 3072 + ch8 * 8; qraw[q] = *(const v4u*)p; kraw[q] = *(const v4u*)(p + 512); }
    {
        bf16x8 bfr[8], afr[2][8];
        const bf16* bp = WG1T + (size_t)cl * DM + 128 * wave + 8 * h;
#pragma unroll
        for (int s = 0; s < 8; ++s) bfr[s] = *(const bf16x8*)(bp + 16 * s);
#pragma unroll
        for (int rb = 0; rb < 2; ++rb) { const bf16* ap = XB + (size_t)(row0 + 32 * rb + cl) * DM + 128 * wave + 8 * h;
#pragma unroll
            for (int s = 0; s < 8; ++s) afr[rb][s] = *(const bf16x8*)(ap + 16 * s); }
        __builtin_amdgcn_sched_barrier(0);
#pragma unroll
        for (int rb = 0; rb < 2; ++rb) {
            f32x16 acc = {};
#pragma unroll
            for (int s = 0; s < 8; ++s) acc = MFMA_BF16(afr[rb][s], bfr[s], acc);
            if (cl < 16) {
#pragma unroll
                for (int i = 0; i < 16; ++i) { const int row = 32 * rb + (i & 3) + 8 * (i >> 2) + 4 * h; part[(wave * 64 + row) * 16 + cl] = acc[i]; }
            }
        }
    }
    __syncthreads();
    float rsum[2];
#pragma unroll
    for (int q = 0; q < 2; ++q) { const int idx = tid + 512 * q, row = idx >> 4, j = idx & 15; float s = 0.f;
#pragma unroll
        for (int w = 0; w < 8; ++w) s += part[(w * 64 + row) * 16 + j];
        rsum[q] = s * ((const float*)(ws + WS_RSTD))[row0 + row]; }
    __syncthreads();
#pragma unroll
    for (int q = 0; q < 2; ++q) { const int idx = tid + 512 * q, row = idx >> 4, j = idx & 15; r_lds[row * 17 + j] = rsum[q]; }
#pragma unroll
    for (int q = 0; q < 8; ++q) { const int idx = tid + 512 * q, t = idx >> 6, ch8 = idx & 63, hd2 = ch8 >> 4, cc2 = (ch8 & 15) * 8; const int off = ((hd2 * 64 + t) * 136 + cc2) * 2;
        *(LAS v4u*)(QIl + off) = qraw[q]; *(LAS v4u*)(KIl + off) = kraw[q]; }
    __syncthreads();
    const int hd = wave >> 1, chh = wave & 1;
#pragma unroll 1
    for (int cb = 0; cb < 2; ++cb) {
        const int cc = 64 * chh + 32 * cb + cl, c = hd * 128 + cc;
        const float bias = A.in[I_BGK][c];
        float pre = 0.f;
#pragma unroll 1
        for (int rb = 0; rb < 2; ++rb) {
            f32x16 x = {};
#pragma unroll
            for (int s = 0; s < 8; ++s) { const float a = r_lds[(32 * rb + cl) * 17 + 2 * s + h]; const float b = A.in[I_WGK2][(2 * s + h) * 512 + c]; x = __builtin_amdgcn_mfma_f32_32x32x2f32(a, b, x, 0, 0, 0); }
#pragma unroll
            for (int i = 0; i < 16; ++i) { const float v = x[i] + bias; const float e = __builtin_amdgcn_exp2f(-fabsf(v) * LOG2E);
                x[i] = (fminf(v, 0.f) - __builtin_amdgcn_logf(1.0f + e) * LN2) * (0.0625f * LOG2E); }
#pragma unroll
            for (int g = 0; g < 4; ++g) {
                const float own = (x[4 * g] + x[4 * g + 1]) + (x[4 * g + 2] + x[4 * g + 3]); const float oth = __shfl_xor(own, 32);
                const float start = pre + (h ? oth : 0.f);
                x[4 * g] += start; x[4 * g + 1] += x[4 * g]; x[4 * g + 2] += x[4 * g + 1]; x[4 * g + 3] += x[4 * g + 2];
                pre += own + oth;
            }
#pragma unroll
            for (int i = 0; i < 16; ++i) { const int t = 32 * rb + (i & 3) + 8 * (i >> 2) + 4 * h; const int off = ((hd * 64 + t) * 136 + cc) * 2;
                const float qv = bf2f(*(const LAS bf16*)(QIl + off)), kv = bf2f(*(const LAS bf16*)(KIl + off)); const float bb = x[i];
                const float qi = qv * 0.08838834764831845f * __builtin_amdgcn_exp2f(bb), ki = kv * __builtin_amdgcn_exp2f(-bb);
                *(LAS bf16*)(QIl + off) = (bf16)(cvtpk(qi, 0.f) & 0xffffu); *(LAS bf16*)(KIl + off) = (bf16)(cvtpk(ki, 0.f) & 0xffffu); }
        }
        if (h == 0) DEC[bn * 512 + c] = __builtin_amdgcn_exp2f(pre);
    }
    __syncthreads();
#pragma unroll
    for (int q = 0; q < 8; ++q) { const int idx = tid + 512 * q, t = idx >> 6, ch8 = idx & 63, hd2 = ch8 >> 4, cc2 = (ch8 & 15) * 8;
        const v4u kv = *(const LAS v4u*)(KIl + ((hd2 * 64 + t) * 136 + cc2) * 2); *(v4u*)(KIG + (size_t)(row0 + t) * 512 + hd2 * 128 + cc2) = kv;
        const int c0 = (cc2 & ~15) + 4 * ((cc2 >> 3) & 1);
        const v2u qa = *(const LAS v2u*)(QIl + ((hd2 * 64 + t) * 136 + c0) * 2), qb = *(const LAS v2u*)(QIl + ((hd2 * 64 + t) * 136 + c0 + 8) * 2);
        v4u qv; qv.x = qa.x; qv.y = qa.y; qv.z = qb.x; qv.w = qb.y; *(v4u*)(QIG + (size_t)(row0 + t) * 512 + hd2 * 128 + cc2) = qv; }
    { const int rb = wave & 1; const int t = 32 * rb + cl;
#pragma unroll
        for (int cbp = 0; cbp < 2; ++cbp) {
            f32x16 acc = {};
#pragma unroll
            for (int s = 0; s < 8; ++s) { const bf16x8 a = *(const LAS bf16x8*)(KIl + ((hd * 64 + 32 * cbp + cl) * 136 + 16 * s + 8 * h) * 2), b = *(const LAS bf16x8*)(QIl + ((hd * 64 + 32 * rb + cl) * 136 + 16 * s + 8 * h) * 2); acc = MFMA_BF16(a, b, acc); }
#pragma unroll
            for (int g = 0; g < 4; ++g) { const int tp0 = 32 * cbp + 8 * g + 4 * h; float v[4];
#pragma unroll
                for (int ii = 0; ii < 4; ++ii) v[ii] = (tp0 + ii <= t) ? acc[4 * g + ii] : 0.f;
                v2u w; w.x = pk2(v[0], v[1]); w.y = pk2(v[2], v[3]); *(v2u*)(PM + ((size_t)(bn * 4 + hd) * 64 + t) * 64 + tp0) = w; }
        }
    }
    __syncthreads();
}

constexpr int SL_P = 0, SL_QI = 9216, SL_KI = 26624, SL_V = 47104, SL_DEC = 51200, SL_BYTES = 51712;
struct SeqRegs { v4u p, q0, q1, k0, k1, x; };
__device__ __forceinline__ void seq_fetch(SeqRegs& R, const unsigned char* ws, int bn, int hd, int es, int tid) {
    const bf16* QIG = (const bf16*)(ws + WS_QI); const bf16* KIG = (const bf16*)(ws + WS_KET); const bf16* PM = (const bf16*)(ws + WS_PM); const bf16* QKVG = (const bf16*)(ws + WS_QKVG); const float* DEC = (const float*)(ws + WS_DEC);
    const int row0 = bn * 64;
    R.p = *(const v4u*)(PM + ((size_t)(bn * 4 + hd) * 64 + (tid >> 3)) * 64 + (tid & 7) * 8);
    { const int t = tid >> 4, c16 = tid & 15; const size_t o0 = (size_t)(row0 + t) * 512 + hd * 128 + c16 * 8, o1 = o0 + (size_t)32 * 512;
      R.q0 = *(const v4u*)(QIG + o0); R.q1 = *(const v4u*)(QIG + o1); R.k0 = *(const v4u*)(KIG + o0); R.k1 = *(const v4u*)(KIG + o1); }
    if (tid < 256) R.x = *(const v4u*)(QKVG + (size_t)(row0 + (tid >> 2)) * 3072 + 1024 + hd * 256 + 32 * es + (tid & 3) * 8);
    else if (tid < 288) R.x = *(const v4u*)(DEC + bn * 512 + hd * 128 + (tid - 256) * 4);
}
__device__ __forceinline__ void seq_put(const SeqRegs& R, LAS unsigned char* slot, int tid) {
    *(LAS v4u*)(slot + SL_P + (tid >> 3) * 144 + (tid & 7) * 16) = R.p;
    { const int t = tid >> 4, c16 = tid & 15;
      *(LAS v4u*)(slot + SL_QI + t * 272 + c16 * 16) = R.q0; *(LAS v4u*)(slot + SL_QI + (t + 32) * 272 + c16 * 16) = R.q1;
      *(LAS v4u*)(slot + SL_KI + t * 320 + c16 * 16) = R.k0; *(LAS v4u*)(slot + SL_KI + (t + 32) * 320 + c16 * 16) = R.k1; }
    if (tid < 256) *(LAS v4u*)(slot + SL_V + (tid >> 2) * 64 + (tid & 3) * 16) = R.x;
    else if (tid < 288) *(LAS v4u*)(slot + SL_DEC + (tid - 256) * 16) = R.x;
}
#define LTR(p) __builtin_bit_cast(s16x4, __builtin_amdgcn_ds_read_tr16_b64_v4i16((LAS s16x4*)(p)))
__device__ __forceinline__ void seq_out(LAS unsigned char* slot, const LAS unsigned char* sfr, bf16* O, int row0, int ocol, int rb, int lane) {
    const int cl = lane & 31, h = lane >> 5;
    const int trb = (8 * h + ((lane & 15) >> 2)), trc = (16 * ((lane >> 4) & 1) + 4 * (lane & 3)) * 2;
    bf16x8 vt[4], pf[4], sa[4], qw[4];
#pragma unroll
    for (int s = 0; s < 4; ++s) { const s16x4 lo = LTR(slot + SL_V + (16 * s + trb) * 64 + trc), hi = LTR(slot + SL_V + (16 * s + 4 + trb) * 64 + trc); vt[s] = (bf16x8){lo[0], lo[1], lo[2], lo[3], hi[0], hi[1], hi[2], hi[3]}; }
#pragma unroll
    for (int s = 0; s < 4; ++s) pf[s] = *(const LAS bf16x8*)(slot + SL_P + (32 * rb + cl) * 144 + (16 * s + 8 * h) * 2);
#pragma unroll
    for (int i = 0; i < 4; ++i) { sa[i] = *(const LAS bf16x8*)(sfr + i * 1024 + lane * 16); qw[i] = *(const LAS bf16x8*)(slot + SL_QI + (32 * rb + cl) * 272 + (16 * i + 8 * h) * 2); }
    __builtin_amdgcn_sched_barrier(0);
    f32x16 acc = {};
#pragma unroll
    for (int s = 0; s < 4; ++s) acc = MFMA_BF16(vt[s], pf[s], acc);
    __builtin_amdgcn_sched_barrier(0);
#pragma unroll
    for (int i = 0; i < 4; ++i) { vt[i] = *(const LAS bf16x8*)(sfr + (4 + i) * 1024 + lane * 16); pf[i] = *(const LAS bf16x8*)(slot + SL_QI + (32 * rb + cl) * 272 + (16 * (4 + i) + 8 * h) * 2); }
    __builtin_amdgcn_sched_barrier(0);
#pragma unroll
    for (int i = 0; i < 4; ++i) acc = MFMA_BF16(sa[i], qw[i], acc);
#pragma unroll
    for (int i = 0; i < 4; ++i) acc = MFMA_BF16(vt[i], pf[i], acc);
#pragma unroll
    for (int g = 0; g < 4; ++g) { v2u w; w.x = cvtpk(acc[4 * g], acc[4 * g + 1]); w.y = cvtpk(acc[4 * g + 2], acc[4 * g + 3]);
        *(v2u*)(O + (size_t)(row0 + 32 * rb + cl) * DM + ocol + 8 * g + 4 * h) = w; }
}
__device__ __forceinline__ void seq_state(f32x16 (&S)[2], LAS unsigned char* slot, LAS unsigned char* sfw, int blk0, int lane) {
    const int h = lane >> 5;
    const int trb = (8 * h + ((lane & 15) >> 2)), trc = (16 * ((lane >> 4) & 1) + 4 * (lane & 3)) * 2;
    bf16x8 vt[4];
#pragma unroll
    for (int s = 0; s < 4; ++s) { const s16x4 lo = LTR(slot + SL_V + (16 * s + trb) * 64 + trc), hi = LTR(slot + SL_V + (16 * s + 4 + trb) * 64 + trc); vt[s] = (bf16x8){lo[0], lo[1], lo[2], lo[3], hi[0], hi[1], hi[2], hi[3]}; }
#pragma unroll
    for (int bi = 0; bi < 2; ++bi) { const int blk = blk0 + bi;
        bf16x8 ke[4];
#pragma unroll
        for (int s = 0; s < 4; ++s) { const s16x4 lo = LTR(slot + SL_KI + (16 * s + trb) * 320 + 64 * blk + trc), hi = LTR(slot + SL_KI + (16 * s + 4 + trb) * 320 + 64 * blk + trc);
            ke[s] = (bf16x8){lo[0], lo[1], lo[2], lo[3], hi[0], hi[1], hi[2], hi[3]}; }
#pragma unroll
        for (int s = 0; s < 4; ++s) S[bi] = MFMA_BF16(ke[s], vt[s], S[bi]);
#pragma unroll
        for (int g = 0; g < 4; ++g) { const f32x4 d4 = *(const LAS f32x4*)(slot + SL_DEC + (32 * blk + 8 * g + 4 * h) * 4);
#pragma unroll
            for (int ii = 0; ii < 4; ++ii) S[bi][4 * g + ii] *= d4[ii]; }
#pragma unroll
        for (int sp = 0; sp < 2; ++sp) { v4u sw; sw.x = cvtpk(S[bi][8 * sp], S[bi][8 * sp + 1]); sw.y = cvtpk(S[bi][8 * sp + 2], S[bi][8 * sp + 3]); sw.z = cvtpk(S[bi][8 * sp + 4], S[bi][8 * sp + 5]); sw.w = cvtpk(S[bi][8 * sp + 6], S[bi][8 * sp + 7]);
            *(LAS v4u*)(sfw + (2 * blk + sp) * 1024 + lane * 16) = sw; }
    }
}
constexpr int SEQ_SF = 2 * SL_BYTES;
__device__ __forceinline__ void seq_touch(unsigned& d0, unsigned& d1, const unsigned char* ws, int bn, int hd, int es, int t  ) {
    const bf16* QIG = (const bf16*)(ws + WS_QI); const bf16* KIG = (const bf16*)(ws + WS_KET); const bf16* PM = (const bf16*)(ws + WS_PM); const bf16* QKVG = (const bf16*)(ws + WS_QKVG); const float* DEC = (const float*)(ws + WS_DEC);
    const int row0 = bn * 64;
    const bf16* p0;
    if (t < 64) p0 = PM + (size_t)(bn * 4 + hd) * 4096 + t * 64;
    else if (t < 192) p0 = QIG + (size_t)(row0 + ((t - 64) >> 1)) * 512 + hd * 128 + ((t - 64) & 1) * 64;
    else p0 = QKVG + (size_t)(row0 + (t - 192)) * 3072 + 1024 + hd * 256 + 32 * es;
    d0 = *(const unsigned*)p0;
    if (t < 128) d1 = *(const unsigned*)(KIG + (size_t)(row0 + (t >> 1)) * 512 + hd * 128 + (t & 1) * 64);
    else if (t < 132) d1 = *(const unsigned*)(DEC + bn * 512 + hd * 128 + (t - 128) * 32);
}
__device__ __forceinline__ void gla_seq_unit(const Args& A, int u, LAS unsigned char* lds, int tid_in, int wave) {
    int tid = tid_in; asm volatile("" : "+v"(tid)); const int lane = tid & 63;
    unsigned char* ws = A.ws; bf16* O = (bf16*)(ws + WS_XB);
    const int b = u >> 5, hd = (u >> 3) & 3, es = u & 7;
    f32x16 S[2]; S[0] = f32x16{}; S[1] = f32x16{};
    SeqRegs Ra, Rb;
    seq_fetch(Ra, ws, b * 64, hd, es, tid); seq_fetch(Rb, ws, b * 64 + 1, hd, es, tid);
    seq_put(Ra, lds, tid);
    for (int i = tid; i < 8192 / 16; i += 512) *(LAS v4u*)(lds + SEQ_SF + i * 16) = (v4u){0u, 0u, 0u, 0u};
    Ra = Rb; seq_fetch(Rb, ws, b * 64 + 2, hd, es, tid);
    __syncthreads();
#define SEQ_STEP(n, R) do { \
        if ((n) + 1 < 64) { seq_put(R, lds + (((n) + 1) & 1) * SL_BYTES, tid); if ((n) + 3 < 64) seq_fetch(R, ws, b * 64 + (n) + 3, hd, es, tid); } \
        { if (wave < 2) seq_out(lds + ((n) & 1) * SL_BYTES, lds + SEQ_SF + ((n) & 1) * 8192, O, (b * 64 + (n)) * 64, hd * 256 + 32 * es, wave, lane); \
        else if (wave < 4) seq_state(S, lds + ((n) & 1) * SL_BYTES, lds + SEQ_SF + (((n) + 1) & 1) * 8192, 2 * (wave - 2), lane); } \
        __syncthreads(); \
    } while (0)
#pragma unroll 1
    for (int n = 0; n < 64; n += 2) { SEQ_STEP(n, Ra); SEQ_STEP(n + 1, Rb); }
#undef SEQ_STEP
}

constexpr int AT_KB = 18432, AT_VB = 20480, AT_K0 = 0, AT_V0 = 2 * AT_KB, AT_XO = 2 * AT_KB + 2 * AT_VB;
__device__ __forceinline__ float max3f(float a, float b, float c) { return fmaxf(fmaxf(a, b), c); }
#define VTR(p) __builtin_bit_cast(s16x4, __builtin_amdgcn_ds_read_tr16_b64_v4i16((LAS s16x4*)(p)))
#define MFMA_PV(a, b, c) MFMA_BF16(a, b, c)
#define EXP2F(x) __builtin_amdgcn_exp2f(x)
#define VFRAG(lo, hi) ((bf16x8){lo[0], lo[1], lo[2], lo[3], hi[0], hi[1], hi[2], hi[3]})
#define AT_EXP8(P, B, W) do { const float e0 = EXP2F(P[B]), e1 = EXP2F(P[B + 1]), e2 = EXP2F(P[B + 2]), e3 = EXP2F(P[B + 3]), e4 = EXP2F(P[B + 4]), e5 = EXP2F(P[B + 5]), e6 = EXP2F(P[B + 6]), e7 = EXP2F(P[B + 7]); \
        W.x = cvtpk(e0, e1); W.y = cvtpk(e2, e3); W.z = cvtpk(e4, e5); W.w = cvtpk(e6, e7); ra += (e0 + e1) + (e4 + e5); rb += (e2 + e3) + (e6 + e7); } while (0)
__device__ __forceinline__ void glds16_asm(const void* gsrc, unsigned lds_dst) { unsigned keep;
    asm volatile("s_mov_b32 %0, m0\n\ts_mov_b32 m0, %2\n\ts_nop 0\n\tglobal_load_lds_dwordx4 %1, off\n\ts_mov_b32 m0, %0" : "=&s"(keep) : "v"(gsrc), "s"(lds_dst) : "memory"); }
__device__ __forceinline__ void glds16_so(const void* sbase, unsigned voff, unsigned lds_dst) { unsigned keep;
    asm volatile("s_mov_b32 %0, m0\n\ts_mov_b32 m0, %3\n\ts_nop 0\n\tglobal_load_lds_dwordx4 %1, %2\n\ts_mov_b32 m0, %0" : "=&s"(keep) : "v"(voff), "s"(sbase), "s"(lds_dst) : "memory"); }
constexpr int A5_K0 = 0, A5_V0 = 3 * AT_KB;
__device__ __forceinline__ void attn5_tile(LAS unsigned char* vp, LAS unsigned char* kpn  , bool has_next, bf16x8 (&kf)[8], const bf16x8 (&qf)[4], f32x16 (&o)[4], float& m, float& l, f32x16& nmv  ,
                                           int key0, int qrow, int h, bool need_mask, bool first) {
    s16x4 la[4], ha[4], lb[4], hb[4];
#pragma unroll
    for (int eb = 0; eb < 4; ++eb) { la[eb] = VTR(vp + eb * 64); ha[eb] = VTR(vp + 8 * 320 + eb * 64); }
#pragma unroll
    for (int eb = 0; eb < 4; ++eb) { lb[eb] = VTR(vp + 16 * 320 + eb * 64); hb[eb] = VTR(vp + 16 * 320 + 8 * 320 + eb * 64); }
    __builtin_amdgcn_sched_barrier(0);
    f32x16 p0 = MFMA_BF16(kf[0], qf[0], nmv), p1 = MFMA_BF16(kf[1], qf[0], nmv);
#pragma unroll
    for (int s = 1; s < 4; ++s) { p0 = MFMA_BF16(kf[2 * s], qf[s], p0); p1 = MFMA_BF16(kf[2 * s + 1], qf[s], p1); }
    if (need_mask) {
#pragma unroll
        for (int i = 0; i < 16; ++i) { const int key = key0 + (i & 3) + 8 * (i >> 2) + 4 * h; if (key > qrow) p0[i] = -INFINITY; if (key + 32 > qrow) p1[i] = -INFINITY; }
    }
    float ma = max3f(p0[0], p0[1], p1[0]), mb = max3f(p0[2], p0[3], p1[1]), mc = max3f(p0[4], p0[5], p1[2]), md = max3f(p0[6], p0[7], p1[3]);
    ma = max3f(ma, p0[8], p0[9]); mb = max3f(mb, p0[10], p0[11]); mc = max3f(mc, p0[12], p0[13]); md = max3f(md, p0[14], p0[15]);
    ma = max3f(ma, p1[4], p1[5]); mb = max3f(mb, p1[6], p1[7]); mc = max3f(mc, p1[8], p1[9]); md = max3f(md, p1[10], p1[11]);
    ma = max3f(ma, p1[12], p1[13]); mb = max3f(mb, p1[14], p1[15]);
    float mx = fmaxf(fmaxf(ma, mb), fmaxf(mc, md));
    { auto rr = __builtin_amdgcn_permlane32_swap(__builtin_bit_cast(unsigned, mx), __builtin_bit_cast(unsigned, mx), false, false); mx = fmaxf(__builtin_bit_cast(float, rr[0]), __builtin_bit_cast(float, rr[1])); }
    if (first || __any(mx > 8.0f)) {
        const float dl = first ? mx : fmaxf(mx, 0.f); m += dl;
#pragma unroll
        for (int i = 0; i < 16; ++i) { p0[i] -= dl; p1[i] -= dl; nmv[i] = -m; }
        if (!first) { const float al = __builtin_amdgcn_exp2f(-dl); l *= al;
#pragma unroll
            for (int eb = 0; eb < 4; ++eb) o[eb] *= al; }
    }
    float ra = 0.f, rb = 0.f; v4u w0, w1;
    AT_EXP8(p0, 0, w0);
    __builtin_amdgcn_sched_barrier(0);
    { const bf16x8 pf = __builtin_bit_cast(bf16x8, w0);
#pragma unroll
      for (int eb = 0; eb < 4; ++eb) o[eb] = MFMA_PV(VFRAG(la[eb], ha[eb]), pf, o[eb]); }
    AT_EXP8(p0, 8, w1);
    __builtin_amdgcn_sched_barrier(0);
#pragma unroll
    for (int eb = 0; eb < 4; ++eb) { la[eb] = VTR(vp + 32 * 320 + eb * 64); ha[eb] = VTR(vp + 32 * 320 + 8 * 320 + eb * 64); }
    __builtin_amdgcn_sched_barrier(0);
    { const bf16x8 pf = __builtin_bit_cast(bf16x8, w1);
#pragma unroll
      for (int eb = 0; eb < 4; ++eb) o[eb] = MFMA_PV(VFRAG(lb[eb], hb[eb]), pf, o[eb]); }
    AT_EXP8(p1, 0, w0);
    __builtin_amdgcn_sched_barrier(0);
#pragma unroll
    for (int eb = 0; eb < 4; ++eb) { lb[eb] = VTR(vp + 48 * 320 + eb * 64); hb[eb] = VTR(vp + 48 * 320 + 8 * 320 + eb * 64); }
    if (has_next) {
#pragma unroll
        for (int s = 0; s < 4; ++s) { kf[2 * s] = *(const LAS bf16x8*)(kpn + s * 32); kf[2 * s + 1] = *(const LAS bf16x8*)(kpn + 32 * 144 + s * 32); }
    }
    __builtin_amdgcn_sched_barrier(0);
    { const bf16x8 pf = __builtin_bit_cast(bf16x8, w0);
#pragma unroll
      for (int eb = 0; eb < 4; ++eb) o[eb] = MFMA_PV(VFRAG(la[eb], ha[eb]), pf, o[eb]); }
    AT_EXP8(p1, 8, w1);
    __builtin_amdgcn_sched_barrier(0);
    { const bf16x8 pf = __builtin_bit_cast(bf16x8, w1);
#pragma unroll
      for (int eb = 0; eb < 4; ++eb) o[eb] = MFMA_PV(VFRAG(lb[eb], hb[eb]), pf, o[eb]); }
    l += ra + rb;
}
__device__ __forceinline__ void attn8_step(LAS unsigned char* vp, LAS unsigned char* kpn2  , bool has_next, bool has_next2, bf16x8 (&kf)[8], const bf16x8 (&qf)[4], f32x16 (&o)[4], float& m, float& l,
                                           f32x16& p0, f32x16& p1, f32x16& n0, f32x16& n1, int key0, int qrow, int h, bool need_mask, bool first) {
    s16x4 la[4], ha[4], lb[4], hb[4];
#pragma unroll
    for (int eb = 0; eb < 4; ++eb) { la[eb] = VTR(vp + eb * 64); ha[eb] = VTR(vp + 8 * 320 + eb * 64); }
#pragma unroll
    for (int eb = 0; eb < 4; ++eb) { lb[eb] = VTR(vp + 16 * 320 + eb * 64); hb[eb] = VTR(vp + 16 * 320 + 8 * 320 + eb * 64); }
    __builtin_amdgcn_sched_barrier(0);
    { const float nm = -m;
#pragma unroll
        for (int i = 0; i < 16; ++i) { n0[i] = nm; n1[i] = nm; }
#pragma unroll
        for (int s = 0; s < 4; ++s) { n0 = MFMA_BF16(kf[2 * s], qf[s], n0); n1 = MFMA_BF16(kf[2 * s + 1], qf[s], n1); } }
    __builtin_amdgcn_sched_barrier(0);
    if (need_mask) {
#pragma unroll
        for (int i = 0; i < 16; ++i) { const int key = key0 + (i & 3) + 8 * (i >> 2) + 4 * h; if (key > qrow) p0[i] = -INFINITY; if (key + 32 > qrow) p1[i] = -INFINITY; }
    }
    float ma = max3f(p0[0], p0[1], p1[0]), mb = max3f(p0[2], p0[3], p1[1]), mc = max3f(p0[4], p0[5], p1[2]), md = max3f(p0[6], p0[7], p1[3]);
    ma = max3f(ma, p0[8], p0[9]); mb = max3f(mb, p0[10], p0[11]); mc = max3f(mc, p0[12], p0[13]); md = max3f(md, p0[14], p0[15]);
    ma = max3f(ma, p1[4], p1[5]); mb = max3f(mb, p1[6], p1[7]); mc = max3f(mc, p1[8], p1[9]); md = max3f(md, p1[10], p1[11]);
    ma = max3f(ma, p1[12], p1[13]); mb = max3f(mb, p1[14], p1[15]);
    float mx = fmaxf(fmaxf(ma, mb), fmaxf(mc, md));
    { auto rr = __builtin_amdgcn_permlane32_swap(__builtin_bit_cast(unsigned, mx), __builtin_bit_cast(unsigned, mx), false, false); mx = fmaxf(__builtin_bit_cast(float, rr[0]), __builtin_bit_cast(float, rr[1])); }
    if (first || __any(mx > 8.0f)) {
        const float dl = first ? mx : fmaxf(mx, 0.f); m += dl;
#pragma unroll
        for (int i = 0; i < 16; ++i) { p0[i] -= dl; p1[i] -= dl; }
#pragma unroll
        for (int i = 0; i < 16; ++i) { n0[i] -= dl; n1[i] -= dl; }
        if (!first) { const float al = __builtin_amdgcn_exp2f(-dl); l *= al;
#pragma unroll
            for (int eb = 0; eb < 4; ++eb) o[eb] *= al; }
    }
    float ra = 0.f, rb = 0.f; v4u w0, w1;
    AT_EXP8(p0, 0, w0);
    __builtin_amdgcn_sched_barrier(0);
    { const bf16x8 pf = __builtin_bit_cast(bf16x8, w0);
#pragma unroll
      for (int eb = 0; eb < 4; ++eb) o[eb] = MFMA_PV(VFRAG(la[eb], ha[eb]), pf, o[eb]); }
    AT_EXP8(p0, 8, w1);
    __builtin_amdgcn_sched_barrier(0);
#pragma unroll
    for (int eb = 0; eb < 4; ++eb) { la[eb] = VTR(vp + 32 * 320 + eb * 64); ha[eb] = VTR(vp + 32 * 320 + 8 * 320 + eb * 64); }
    __builtin_amdgcn_sched_barrier(0);
    { const bf16x8 pf = __builtin_bit_cast(bf16x8, w1);
#pragma unroll
      for (int eb = 0; eb < 4; ++eb) o[eb] = MFMA_PV(VFRAG(lb[eb], hb[eb]), pf, o[eb]); }
    AT_EXP8(p1, 0, w0);
    __builtin_amdgcn_sched_barrier(0);
#pragma unroll
    for (int eb = 0; eb < 4; ++eb) { lb[eb] = VTR(vp + 48 * 320 + eb * 64); hb[eb] = VTR(vp + 48 * 320 + 8 * 320 + eb * 64); }
    {
#pragma unroll
        for (int s = 0; s < 4; ++s) { kf[2 * s] = *(const LAS bf16x8*)(kpn2 + s * 32); kf[2 * s + 1] = *(const LAS bf16x8*)(kpn2 + 32 * 144 + s * 32); }
    }
    __builtin_amdgcn_sched_barrier(0);
    { const bf16x8 pf = __builtin_bit_cast(bf16x8, w0);
#pragma unroll
      for (int eb = 0; eb < 4; ++eb) o[eb] = MFMA_PV(VFRAG(la[eb], ha[eb]), pf, o[eb]); }
    AT_EXP8(p1, 8, w1);
    __builtin_amdgcn_sched_barrier(0);
    { const bf16x8 pf = __builtin_bit_cast(bf16x8, w1);
#pragma unroll
      for (int eb = 0; eb < 4; ++eb) o[eb] = MFMA_PV(VFRAG(lb[eb], hb[eb]), pf, o[eb]); }
    l += ra + rb;
}
__device__ __forceinline__ unsigned a8_koff(int cc, int i, int lane) { const int t = i + lane, r = (t * 57) >> 9, cq = t - 9 * r; return (unsigned)((cc * 4096 * 64 + (7 * i + r) * 64 + (cq > 7 ? 7 : cq) * 8) * 2); }
__device__ __forceinline__ unsigned a8_voff(int i, int lane) { const int t = 4 * i + lane, r = (t * 205) >> 12, cq = t - 20 * r; return (unsigned)(((3 * i + r) * 128 + (cq > 15 ? 15 : cq) * 8) * 2); }
__device__ __forceinline__ void a8_dma_k(const bf16* kt, unsigned ldsK, int wave, int lane) {
#pragma unroll
    for (int ii = 0; ii < 3; ++ii) { const int g = wave + 8 * ii; if (g < 18) { const int cc = g >= 9 ? 1 : 0, i = g - 9 * cc;
        glds16_so(kt, a8_koff(cc, i, lane), (unsigned)__builtin_amdgcn_readfirstlane((int)(ldsK + cc * 9216 + i * 1024))); } }
}
__device__ __forceinline__ void a8_dma_v(const bf16* vt, unsigned ldsV, int wave, int lane) {
#pragma unroll
    for (int ii = 2; ii < 5; ++ii) { const int g = wave + 8 * ii; if (g >= 18) { const int i = g < 38 ? g - 18 : g - 38;
        glds16_so(vt, a8_voff(i, lane), (unsigned)__builtin_amdgcn_readfirstlane((int)(ldsV + i * 1024))); } }
}
__device__ __forceinline__ void attn_unit(const Args& A, int b, int hh, int qb, float lam, LAS unsigned char* lds, int tid_in, int wave, int lane_in) {
    int tid = tid_in; asm volatile("" : "+v"(tid));
    const int lane = tid & 63; (void)lane_in;
    unsigned char* ws = A.ws;
    const bf16* KR = (const bf16*)(ws + WS_KR); const bf16* VR = (const bf16*)(ws + WS_VR); const bf16* QR = (const bf16*)(ws + WS_QR); bf16* AO = (bf16*)(ws + WS_AO);
    const int cl = lane & 31, h = lane >> 5, c = wave >> 2, qg = wave & 3;
    const int q0 = qb * 128, NT = 2 * (qb + 1), qrow = q0 + 32 * qg + cl, qmax = q0 + 32 * qg + 31, qmin = q0 + 32 * qg;
    bf16x8 qf[4];
    { const bf16* qp = QR + ((size_t)((b * 8 + hh) * 2 + c) * 4096 + qrow) * 64 + 8 * h;
#pragma unroll
        for (int s = 0; s < 4; ++s) qf[s] = *(const bf16x8*)(qp + 16 * s); }
    f32x16 o[4]; o[0] = f32x16{}; o[1] = f32x16{}; o[2] = f32x16{}; o[3] = f32x16{};
    float m = 0.f, l = 0.f;
    constexpr int A7_K0 = 0, A7_V0 = 4 * AT_KB;
    const bf16* const kbase = KR + (size_t)((b * 8 + hh) * 2) * 4096 * 64; const bf16* const vbase = VR + (size_t)(b * 8 + hh) * 4096 * 128;
    const unsigned lds0 = (unsigned)(uintptr_t)lds;
#define A7_DMA_K(t, slot) a8_dma_k(kbase + (size_t)(t) * 64 * 64, lds0 + A7_K0 + (slot) * AT_KB, wave, lane)
#define A7_DMA_V(t, slot) a8_dma_v(vbase + (size_t)(t) * 64 * 128, lds0 + A7_V0 + (slot) * AT_VB, wave, lane)
    LAS unsigned char* const vtr = lds + A7_V0 + (4 * h + ((lane & 15) >> 2)) * 320 + (16 * ((lane >> 4) & 1) + 4 * (lane & 3)) * 2;
    LAS unsigned char* const kfr = lds + A7_K0 + c * 9216 + cl * 144 + 16 * h;
    A7_DMA_K(0, 0); A7_DMA_V(0, 0); A7_DMA_K(1, 1); A7_DMA_V(1, 1);
    if (NT > 2) A7_DMA_K(2, 2);
    asm volatile("s_waitcnt vmcnt(0)" ::: "memory"); __syncthreads();
    asm volatile("" : "+v"(qf[0]), "+v"(qf[1]), "+v"(qf[2]), "+v"(qf[3]));
    bf16x8 kf[8];
#pragma unroll
    for (int s = 0; s < 4; ++s) { kf[2 * s] = *(const LAS bf16x8*)(kfr + s * 32); kf[2 * s + 1] = *(const LAS bf16x8*)(kfr + 32 * 144 + s * 32); }
    f32x16 nmv = {};
    int kv = 0, kv1 = 1, kv2 = 2, kk1 = 1, kk3 = 3;
#pragma unroll 1
    for (int j = 0; j < NT; ++j) {
        if (j + 3 < NT) A7_DMA_K(j + 3, kk3);
        if (j + 2 < NT) A7_DMA_V(j + 2, kv2);
        const bool act_ = (64 * j <= qmax);
        if (act_) attn5_tile(vtr + kv * AT_VB, kfr + kk1 * AT_KB, j + 1 < NT, kf, qf, o, m, l, nmv, 64 * j, qrow, h, 64 * j + 63 > qmin, j == 0);
        if (j + 3 < NT) asm volatile("s_waitcnt vmcnt(5) lgkmcnt(0)\n\ts_barrier" ::: "memory"); else asm volatile("s_waitcnt vmcnt(0) lgkmcnt(0)\n\ts_barrier" ::: "memory");
        kv = kv1; kv1 = kv2; kv2 = (kv2 == 2) ? 0 : kv2 + 1; kk1 = (kk1 + 1) & 3; kk3 = (kk3 + 1) & 3;
    }
    __syncthreads();
    int tid2 = tid; asm volatile("" : "+v"(tid2));
    const int bp32 = ((tid2 & 63) ^ 32) << 2;
    l += __builtin_bit_cast(float, __builtin_amdgcn_ds_bpermute(bp32, __builtin_bit_cast(int, l)));
    const float inv = __builtin_amdgcn_rcpf(l);
    {
    const int lane2 = tid2 & 63, cl = lane2 & 31, h = lane2 >> 5, wave2 = __builtin_amdgcn_readfirstlane(tid2 >> 6), c = wave2 >> 2, qg = wave2 & 3, qrow = q0 + 32 * qg + cl;
    LAS float* XO = (LAS float*)(lds) + qg * 4096;
    if (c == 1) {
        const float f = inv * lam;
#pragma unroll
        for (int eb = 0; eb < 4; ++eb)
#pragma unroll
            for (int i = 0; i < 16; ++i) { const int e = 32 * eb + (i & 3) + 8 * (i >> 2) + 4 * h; XO[e * 32 + cl] = o[eb][i] * f; }
    }
    __syncthreads();
    if (c == 0) {
        float ss = 0.f;
#pragma unroll
        for (int eb = 0; eb < 4; ++eb)
#pragma unroll
            for (int i = 0; i < 16; ++i) { const int e = 32 * eb + (i & 3) + 8 * (i >> 2) + 4 * h; const float v = o[eb][i] * inv - XO[e * 32 + cl]; o[eb][i] = v; ss += v * v; }
        ss += __builtin_bit_cast(float, __builtin_amdgcn_ds_bpermute(bp32, __builtin_bit_cast(int, ss)));
        const float rstd = (1.0f - LAM_INIT) * __builtin_amdgcn_rsqf(ss * (1.0f / 128.0f) + EPS);
        bf16* op = AO + (size_t)(b * 4096 + qrow) * DM + hh * 128;
        f32x4 w4[4][4];
#pragma unroll
        for (int eb = 0; eb < 4; ++eb)
#pragma unroll
            for (int g = 0; g < 4; ++g) w4[eb][g] = *(const f32x4*)(A.in[I_SUBLN] + 32 * eb + 8 * g + 4 * h);
#pragma unroll
        for (int eb = 0; eb < 4; ++eb)
#pragma unroll
            for (int g = 0; g < 4; ++g) { const int e0 = 32 * eb + 8 * g + 4 * h;
                v2u w; w.x = cvtpk(o[eb][4 * g] * rstd * w4[eb][g][0], o[eb][4 * g + 1] * rstd * w4[eb][g][1]); w.y = cvtpk(o[eb][4 * g + 2] * rstd * w4[eb][g][2], o[eb][4 * g + 3] * rstd * w4[eb][g][3]);
                *(v2u*)(op + e0) = w; }
    }
    }
    __syncthreads();
#undef A7_DMA_K
#undef A7_DMA_V
}

constexpr int NPH = 16;
__global__ void __launch_bounds__(NWAVES * 64, 2) yoco_fwd(Args args) {
    extern __shared__ __attribute__((aligned(16))) unsigned char lds_raw[];
    LAS unsigned char* lds = (LAS unsigned char*)lds_raw;
#define FRESH() int tid = threadIdx.x; asm volatile("" : "+v"(tid)); const int lane = tid & 63, wave = __builtin_amdgcn_readfirstlane(tid >> 6); (void)lane; (void)wave
    const int G = gridDim.x; const int bx = blockIdx.x; const int vcu = (G % 8 == 0) ? (bx % 8) * (G / 8) + bx / 8 : bx;
    unsigned char* ws = args.ws;
    for (int u = threadIdx.x; u < (LDS_BYTES - LDSCTL_OFF) / 4; u += NWAVES * 64) ((LAS unsigned*)(lds + LDSCTL_OFF))[u] = 0u;
    __syncthreads();
#if !MK_PER_PHASE
    XcdBarrier bar = xcd_barrier_post((unsigned*)(ws + WS_CTL) + CW_BAR, (volatile LAS unsigned*)(lds + MISC_OFF) + 8);
#define GRID_BAR() xcd_barrier(bar)
#else
#define GRID_BAR() do {} while (0)
#endif
    const int lo = args.ph_lo, hi = args.ph_hi;
#define IN(k) (lo <= (k) && (k) < hi)
#define SEAM(k) do { if (IN((k) + 1)) GRID_BAR(); } while (0)
    float* H = args.out;
    const float* PS = (const float*)(ws + WS_PS);
    if (IN(0)) { FRESH(); { p0_prologue(args, lds, vcu, G, wave, lane, tid); } SEAM(0); }
    if (IN(1)) { FRESH(); {
        pg8::Gemm g{(const bf16*)(ws + WS_XB), (const bf16*)(ws + WS_W1T), T, 3072, DM}; pg8::StaticOrder S; S.init(T, 3072, G, bx);
        pg8::EpiScaleBf16 E{(bf16*)(ws + WS_QKVG), 3072, (const float*)(ws + WS_RSTD), nullptr, 0};
        pg8::gemm_phase<pg8::EpiScaleBf16, pg8::StaticOrder, false, true>(lds, g, S, E); } SEAM(1);
    }
    if (IN(2)) { FRESH(); {
        if (bx & 1) __builtin_amdgcn_s_sleep(127);
        for (int bn = vcu; bn < NBN; bn += G) gla_pre_unit(args, bn, lds, tid, wave); } SEAM(2); }
    if (IN(3)) { FRESH(); { for (int u = vcu; u < 256; u += G) gla_seq_unit(args, u, lds, tid, wave); } SEAM(3); }
    if (IN(4)) { FRESH(); { gla_gate_phase((const bf16*)(ws + WS_XB), (const bf16*)(ws + WS_QKVG), args.in[I_ONORM], (bf16*)(ws + WS_OGATE), vcu, G, wave, lane); } SEAM(4); }
    if (IN(5)) { FRESH(); {
        pg8::Gemm g{(const bf16*)(ws + WS_OGATE), (const bf16*)(ws + WS_WO1T), T, DM, DM}; pg8::StaticOrder S; S.init(T, DM, G, bx);
        pg8::EpiResBf16 E{args.in[I_X], nullptr, (bf16*)(ws + WS_XB), DM, (float*)(ws + WS_PS), (bf16*)(ws + WS_AH)};
        pg8::gemm_phase<pg8::EpiResBf16, pg8::StaticOrder, true, true>(lds, g, S, E); } SEAM(5);
    }
#pragma unroll
    for (int layer = 0; layer < 2; ++layer) {
        const int pb = layer == 0 ? 6 : 12;
        const bf16* WIN = (const bf16*)(ws + (layer == 0 ? WS_WIN0T : WS_WIN1T)); const bf16* WOUT = (const bf16*)(ws + (layer == 0 ? WS_WOUT0T : WS_WOUT1T));
        const float* cw = args.in[I_CONVW] + (size_t)layer * 3 * 2 * DFF; const float* cb = args.in[I_CONVB] + (size_t)layer * 2 * DFF;
        if (IN(pb)) { FRESH(); {
            pg8::Gemm g{(const bf16*)(ws + WS_AH), WIN, 1024, 2 * DFF, DM}; pg8::StaticOrder S; S.init(1024, 2 * DFF, G, bx);
            pg8::EpiScaleBf16 E{(bf16*)(ws + WS_UH), 2 * DFF, nullptr, PS, 1};
            pg8::gemm_phase<pg8::EpiScaleBf16, pg8::StaticOrder, true, true>(lds, g, S, E);
            { const int nidle = G > 88 ? G - 88 : G, me = G > 88 ? bx - 88 : bx;
              if (me >= 0) for (int r = me * (NWAVES * 64) + tid; r < T; r += nidle * NWAVES * 64) ((float*)(ws + WS_RSTD))[r] = pg8::rstd_ps(PS, r); } } SEAM(pb);
        }
        if (IN(pb + 1)) { FRESH(); {
            pg8::Gemm g{(const bf16*)(ws + WS_XB), WIN, T, 2 * DFF, DM}; pg8::StaticOrder S; S.init(T, 2 * DFF, G, bx);
            pg8::EpiConvGate E{(bf16*)(ws + WS_ACT), (const bf16*)(ws + WS_UH), (const float*)(ws + WS_RSTD), cw, cb};
            pg8::gemm_phase<pg8::EpiConvGate, pg8::StaticOrder, true, true>(lds, g, S, E); } SEAM(pb + 1);
        }
        if (IN(pb + 2)) { FRESH(); {
            pg8::Gemm g{(const bf16*)(ws + WS_ACT), WOUT, T, DM, DFF}; pg8::StaticOrder S; S.init(T, DM, G, bx);
            pg8::EpiResBf16 E{nullptr, (const bf16*)(ws + WS_XB), (bf16*)(ws + WS_XB), DM, (float*)(ws + WS_PS), layer == 0 ? (bf16*)(ws + WS_AH) : (bf16*)nullptr};
            pg8::gemm_phase<pg8::EpiResBf16, pg8::StaticOrder, true, true>(lds, g, S, E); } SEAM(pb + 2);
        }
        if (layer == 0) {
            if (IN(9)) { FRESH(); {
                pg8::Gemm g{(const bf16*)(ws + WS_XB), (const bf16*)(ws + WS_WKVQT), T, 3072, DM}; pg8::StaticOrder S; S.init(T, 3072, G, bx);
                pg8::EpiRope E{(bf16*)(ws + WS_KR), (bf16*)(ws + WS_VR), (bf16*)(ws + WS_QR), PS, (const float*)(ws + WS_COS), (const float*)(ws + WS_SIN)};
                pg8::gemm_phase<pg8::EpiRope, pg8::StaticOrder, false, true>(lds, g, S, E); } SEAM(9);
            }
            if (IN(10)) { FRESH(); {
                const float* lp = args.in[I_LAMBDA];
                const float sa = wave_sum(lp[lane] * lp[64 + lane]), sb = wave_sum(lp[128 + lane] * lp[192 + lane]);
                const float lam = __builtin_bit_cast(float, __builtin_amdgcn_readfirstlane(__builtin_bit_cast(int, expf(sa) - expf(sb) + LAM_INIT)));
                const int xg = vcu >> 5, cu = vcu & 31, kq = cu & 15;
                if (G == 256) {
#pragma unroll 1
                    for (int i = 0; i < 8; ++i) { const int pr = xg * 8 + 2 * (i >> 1) + (cu >> 4); const int qb = (i & 1) ? 31 - kq : kq; attn_unit(args, pr >> 3, pr & 7, qb, lam, lds, tid, wave, lane); }
                } else {
#pragma unroll 1
                    for (int it = vcu; it < 1024; it += G) {
#pragma unroll 1
                        for (int i = 0; i < 2; ++i) { const int pr = it >> 4, k2 = it & 15; attn_unit(args, pr >> 3, pr & 7, i ? 31 - k2 : k2, lam, lds, tid, wave, lane); } }
                } }
                SEAM(10);
            }
            if (IN(11)) { FRESH(); {
                pg8::Gemm g{(const bf16*)(ws + WS_AO), (const bf16*)(ws + WS_WO2T), T, DM, DM}; pg8::StaticOrder S; S.init(T, DM, G, bx);
                pg8::EpiResBf16 E{nullptr, (const bf16*)(ws + WS_XB), (bf16*)(ws + WS_XB), DM, (float*)(ws + WS_PS), (bf16*)(ws + WS_AH)};
                pg8::gemm_phase<pg8::EpiResBf16, pg8::StaticOrder, true, true>(lds, g, S, E); } SEAM(11);
            }
        }
    }
    if (IN(15)) { FRESH(); { final_norm_phase((const bf16*)(ws + WS_XB), PS, H, args.in[I_FINAL], vcu, G, wave, lane); } }
#undef IN
#undef SEAM
}

extern "C" void kernel_launch(void* const* d_in, const int* in_sizes, int n_in, void* d_out, int out_size, void* d_ws, size_t ws_size, hipStream_t stream) {
    static int grid = 0;
    if (grid == 0) {
        if (n_in != 20 || out_size != T * DM || ws_size < WS_END) { fprintf(stderr, "kernel_launch: unexpected shapes (n_in %d out %d ws %zu)\n", n_in, out_size, ws_size); grid = -1; return; }
        int dev = 0, cus = 0;
        if (hipGetDevice(&dev) != hipSuccess || hipDeviceGetAttribute(&cus, hipDeviceAttributeMultiprocessorCount, dev) != hipSuccess) { grid = -1; return; }
        if (hipFuncSetAttribute((const void*)yoco_fwd, hipFuncAttributeMaxDynamicSharedMemorySize, LDS_BYTES) != hipSuccess) { grid = -1; return; }
        int per_cu = 0; (void)hipOccupancyMaxActiveBlocksPerMultiprocessor(&per_cu, (const void*)yoco_fwd, NWAVES * 64, LDS_BYTES); (void)hipGetLastError();
        grid = cus;
    }
    if (grid < 0) return;
    if (hipMemsetAsync((char*)d_ws + WS_CTL, 0, CTL_ZERO_BYTES, stream) != hipSuccess) return;
    Args a{};
    for (int i = 0; i < 20; ++i) a.in[i] = (const float*)d_in[i];
    a.out = (float*)d_out; a.ws = (unsigned char*)d_ws;
#if MK_PER_PHASE
    for (int ph = 0; ph < NPH; ++ph) { a.ph_lo = ph; a.ph_hi = ph + 1; hipLaunchKernelGGL(yoco_fwd, dim3(grid), dim3(NWAVES * 64), LDS_BYTES, stream, a); }
#else
    a.ph_lo = 0; a.ph_hi = NPH; hipLaunchKernelGGL(yoco_fwd, dim3(grid), dim3(NWAVES * 64), LDS_BYTES, stream, a);
#endif
}
```

```cpp
#ifndef MK_PER_PHASE
#define MK_PER_PHASE 0
#endif
#include <hip/hip_runtime.h>
#include <cstdio>
#include <cstdint>
namespace pg8 {
#define PG8_LAS __attribute__((address_space(3)))
typedef unsigned short bf16_t;
typedef short bf16x8 __attribute__((ext_vector_type(8)));
typedef float f32x4 __attribute__((ext_vector_type(4)));
typedef unsigned u32x4 __attribute__((ext_vector_type(4)));
constexpr int BM = 256, BK = 64, HALF = 128, HTB = HALF * BK * 2  , STAGE_BYTES = 8 * HTB, NXCD = 8, WGM = 8;

__host__ __device__ __forceinline__ int lds_byte(int r, int c) { const int st = (r >> 4) * 2 + (c >> 5), rr = r & 15, cc = c & 31, ob = rr * 64 + cc * 2; return st * 1024 + (ob ^ (((ob >> 9) & 1) << 5)); }
__host__ __device__ __forceinline__ void stage_rc(int b, int& R, int& C) { const int st = b / 1024, sb = b % 1024, swz = sb ^ (((sb >> 9) & 1) << 5); R = (st >> 1) * 16 + swz / 64; C = (st & 1) * 32 + (swz % 64) / 2; }
__host__ __device__ __forceinline__ int perm32(int rho) { const int n = rho >> 4, i = rho & 15; return 8 * (i >> 2) + 4 * n + (i & 3); }

struct Unit { int pm, pn; };
struct Gemm { const bf16_t* A; const bf16_t* Bt; int M, N, K; };

struct StaticOrder {
    int nM, nN, nwg, G, c;
    __host__ __device__ void init(int M, int N, int G_, int c_) { nM = M / BM; nN = N / BM; nwg = nM * nN; G = G_; c = c_; }
    __host__ __device__ bool next(int i, Unit& u) const {
        const long L = (long)i * G + c; if (L >= nwg) return false;
        int wgid = (int)L; { const int q = nwg / NXCD, r = nwg % NXCD, xcd = wgid % NXCD, off = wgid / NXCD; wgid = (xcd < r ? xcd * (q + 1) : r * (q + 1) + (xcd - r) * q) + off; }
        const int nig = WGM * nN, gid = wgid / nig, fm = gid * WGM, gsz = (nM - fm) < WGM ? (nM - fm) : WGM;
        u.pm = fm + ((wgid % nig) % gsz); u.pn = (wgid % nig) / gsz; return true;
    }
    __device__ __forceinline__ void a_ready(const Unit&) const {}
    __device__ __forceinline__ void done(const Unit&) const {}
};

__device__ __forceinline__ unsigned cvt_pk_bf16(float lo, float hi) { unsigned r; asm volatile("v_cvt_pk_bf16_f32 %0, %1, %2" : "=v"(r) : "v"(lo), "v"(hi)); return r; }
typedef float f32x2 __attribute__((ext_vector_type(2)));
__device__ __forceinline__ float rstd_ps(const float* ps, int row) {
    const f32x4* p = (const f32x4*)(ps + (size_t)row * 16); const f32x4 a = p[0], b = p[1], c = p[2], d = p[3];
    const float s = ((a[0] + a[1]) + (a[2] + a[3])) + ((b[0] + b[1]) + (b[2] + b[3])) + ((c[0] + c[1]) + (c[2] + c[3])) + ((d[0] + d[1]) + (d[2] + d[3]));
    return __builtin_amdgcn_rsqf(s * (1.0f / 1024.0f) + 1e-6f);
}
struct EpiScaleBf16 {
    static constexpr bool PERM = true, AFTER_DRAIN = false, APERM = false;
    bf16_t* O; int ldc; const float* rstd; const float* ps; int halo;
    __device__ __forceinline__ void operator()(const f32x4 (&acc)[2][2][4][2], const Unit& u, int wr, int wc, int fr, int fq) const {
        const int row0 = u.pm * BM + wr * 64 + fr, col0 = u.pn * BM + wc * 32 + 8 * fq;
        float sc[2][4];
#pragma unroll
        for (int ai = 0; ai < 2; ++ai)
#pragma unroll
            for (int m = 0; m < 4; ++m) { const int row = row0 + ai * HALF + m * 16;
                if (rstd) sc[ai][m] = rstd[row];
                else if (halo) { const int st = row >> 1; sc[ai][m] = (st & 63) ? rstd_ps(ps, 64 * st - 2 + (row & 1)) : 0.f; } else sc[ai][m] = rstd_ps(ps, row); }
#pragma unroll
        for (int ai = 0; ai < 2; ++ai)
#pragma unroll
            for (int m = 0; m < 4; ++m) { const int row = row0 + ai * HALF + m * 16; const float s = sc[ai][m];
                bf16_t* rowp = O + (size_t)row * ldc + col0;
#pragma unroll
                for (int bj = 0; bj < 2; ++bj) { const f32x4 v0 = acc[ai][bj][m][0] * s, v1 = acc[ai][bj][m][1] * s;
                    u32x4 w; w.x = cvt_pk_bf16(v0[0], v0[1]); w.y = cvt_pk_bf16(v0[2], v0[3]); w.z = cvt_pk_bf16(v1[0], v1[1]); w.w = cvt_pk_bf16(v1[2], v1[3]);
                    *(u32x4*)(rowp + bj * HALF) = w; } }
    }
};
struct EpiResBf16 {
    static constexpr bool PERM = true, AFTER_DRAIN = false, APERM = false;
    const float* base32; const bf16_t* base16; bf16_t* out; int ldc; float* ps; bf16_t* ah;
    __device__ __forceinline__ void operator()(const f32x4 (&acc)[2][2][4][2], const Unit& u, int wr, int wc, int fr, int fq) const {
        const int row0 = u.pm * BM + wr * 64 + fr, col0 = u.pn * BM + wc * 32 + 8 * fq;
#pragma unroll
        for (int ai = 0; ai < 2; ++ai) {
            f32x4 b0[4][2], b1[4][2];
            if (base32) {
#pragma unroll
                for (int m = 0; m < 4; ++m)
#pragma unroll
                    for (int bj = 0; bj < 2; ++bj) { const size_t off = (size_t)(row0 + ai * HALF + m * 16) * ldc + col0 + bj * HALF; b0[m][bj] = *(const f32x4*)(base32 + off); b1[m][bj] = *(const f32x4*)(base32 + off + 4); }
            } else {
                u32x4 r[4][2];
#pragma unroll
                for (int m = 0; m < 4; ++m)
#pragma unroll
                    for (int bj = 0; bj < 2; ++bj) r[m][bj] = *(const u32x4*)(base16 + (size_t)(row0 + ai * HALF + m * 16) * ldc + col0 + bj * HALF);
#pragma unroll
                for (int m = 0; m < 4; ++m)
#pragma unroll
                    for (int bj = 0; bj < 2; ++bj) { const u32x4 q = r[m][bj];
                        b0[m][bj][0] = __builtin_bit_cast(float, q.x << 16); b0[m][bj][1] = __builtin_bit_cast(float, q.x & 0xffff0000u); b0[m][bj][2] = __builtin_bit_cast(float, q.y << 16); b0[m][bj][3] = __builtin_bit_cast(float, q.y & 0xffff0000u);
                        b1[m][bj][0] = __builtin_bit_cast(float, q.z << 16); b1[m][bj][1] = __builtin_bit_cast(float, q.z & 0xffff0000u); b1[m][bj][2] = __builtin_bit_cast(float, q.w << 16); b1[m][bj][3] = __builtin_bit_cast(float, q.w & 0xffff0000u); }
            }
#pragma unroll
            for (int m = 0; m < 4; ++m) { const int row = row0 + ai * HALF + m * 16; const size_t off = (size_t)row * ldc + col0; float ss = 0.f;
                const bool hrow = (m == 3) && (fr >= 14); const int st = ((row >> 6) + 1) & 511; const bool hw = ah && hrow && (st & 63);
                bf16_t* ahp = ah + (size_t)(2 * st + (fr - 14)) * ldc + col0;
#pragma unroll
                for (int bj = 0; bj < 2; ++bj) {
                    const f32x4 v0 = b0[m][bj] + acc[ai][bj][m][0], v1 = b1[m][bj] + acc[ai][bj][m][1];
                    ss += ((v0[0] * v0[0] + v0[1] * v0[1]) + (v0[2] * v0[2] + v0[3] * v0[3])) + ((v1[0] * v1[0] + v1[1] * v1[1]) + (v1[2] * v1[2] + v1[3] * v1[3]));
                    u32x4 w; w.x = cvt_pk_bf16(v0[0], v0[1]); w.y = cvt_pk_bf16(v0[2], v0[3]); w.z = cvt_pk_bf16(v1[0], v1[1]); w.w = cvt_pk_bf16(v1[2], v1[3]);
                    *(u32x4*)(out + off + bj * HALF) = w;
                    if (hw) *(u32x4*)(ahp + bj * HALF) = w; }
                ss += __shfl_xor(ss, 16); ss += __shfl_xor(ss, 32);
                if (fq == 0) ps[(size_t)row * 16 + u.pn * 4 + wc] = ss; }
        }
    }
};
struct EpiRope {
    static constexpr bool PERM = false, AFTER_DRAIN = false, APERM = false;
    bf16_t* KR; bf16_t* VR; bf16_t* QR; const float* ps; const float* cosT; const float* sinT;
    __device__ __forceinline__ void operator()(const f32x4 (&acc)[2][2][4][2], const Unit& u, int wr, int wc, int fr, int fq) const {
        typedef unsigned u32x2v __attribute__((ext_vector_type(2)));
        const int row0 = u.pm * BM + wr * 64 + fr; const int pn = u.pn;
#pragma unroll
        for (int ai = 0; ai < 2; ++ai) {
            float sc[4];
#pragma unroll
            for (int m = 0; m < 4; ++m) sc[m] = rstd_ps(ps, row0 + ai * HALF + m * 16);
            if (pn >= 4 && pn < 8) {
#pragma unroll
                for (int m = 0; m < 4; ++m) { const int row = row0 + ai * HALF + m * 16; const float s = sc[m]; const int b = row >> 12, sq = row & 4095;
#pragma unroll
                    for (int bj = 0; bj < 2; ++bj) { const int head = 2 * (pn - 4) + bj; bf16_t* p = VR + ((size_t)(b * 8 + head) * 4096 + sq) * 128 + 32 * wc + 4 * fq;
#pragma unroll
                        for (int n = 0; n < 2; ++n) { const f32x4 v = acc[ai][bj][m][n] * s; u32x2v w; w.x = cvt_pk_bf16(v[0], v[1]); w.y = cvt_pk_bf16(v[2], v[3]); *(u32x2v*)(p + 16 * n) = w; } } }
            } else {
                bf16_t* dst = pn < 4 ? KR : QR; const int tl = pn < 4 ? pn : pn - 8; const int d0 = 16 * (wc & 1) + 4 * fq;
                f32x4 cs[4], sn[4];
#pragma unroll
                for (int m = 0; m < 4; ++m) { const int sq = (row0 + ai * HALF + m * 16) & 4095; cs[m] = *(const f32x4*)(cosT + sq * 32 + d0); sn[m] = *(const f32x4*)(sinT + sq * 32 + d0); }
#pragma unroll
                for (int m = 0; m < 4; ++m) { const int row = row0 + ai * HALF + m * 16; const float s = sc[m]; const int b = row >> 12, sq = row & 4095;
#pragma unroll
                    for (int bj = 0; bj < 2; ++bj) { const int gc = tl * 4 + 2 * bj + (wc >> 1), head = gc >> 1, c2 = gc & 1;
                        const f32x4 x1 = acc[ai][bj][m][0] * s, x2 = acc[ai][bj][m][1] * s; const f32x4 o1 = x1 * cs[m] - x2 * sn[m], o2 = x2 * cs[m] + x1 * sn[m];
                        bf16_t* p = dst + ((size_t)((b * 8 + head) * 2 + c2) * 4096 + sq) * 64 + d0;
                        u32x2v w1, w2; w1.x = cvt_pk_bf16(o1[0], o1[1]); w1.y = cvt_pk_bf16(o1[2], o1[3]); w2.x = cvt_pk_bf16(o2[0], o2[1]); w2.y = cvt_pk_bf16(o2[2], o2[3]);
                        *(u32x2v*)p = w1; *(u32x2v*)(p + 32) = w2; } }
            }
        }
    }
};

#define DPPF(oldv, src, ctrl) __builtin_bit_cast(float, __builtin_amdgcn_update_dpp(__builtin_bit_cast(int, (float)(oldv)), __builtin_bit_cast(int, (float)(src)), (ctrl), 0xf, 0xf, false))
struct EpiConvGate {
    static constexpr bool PERM = true, AFTER_DRAIN = false;
    bf16_t* ACT; const bf16_t* UH; const float* rstd; const float* cw; const float* cb;
    __device__ __forceinline__ void operator()(const f32x4 (&acc)[2][2][4][2], const Unit& u, int wr, int wc, int fr, int fq) const {
        typedef unsigned u32x2v __attribute__((ext_vector_type(2)));
        const int row0 = u.pm * BM + wr * 64 + fr;
        float rs[2][4];
#pragma unroll
        for (int ai = 0; ai < 2; ++ai)
#pragma unroll
            for (int m = 0; m < 4; ++m) rs[ai][m] = rstd[row0 + ai * HALF + m * 16];
        u32x2v hq[2][2][4];
#pragma unroll
        for (int n = 0; n < 2; ++n)
#pragma unroll
            for (int ai = 0; ai < 2; ++ai) { const bf16_t* hp = UH + (size_t)(2 * (4 * u.pm + 2 * ai + wr)) * 5632 + u.pn * BM + wc * 32 + 8 * fq + 4 * n;
                hq[n][ai][0] = *(const u32x2v*)hp; hq[n][ai][1] = *(const u32x2v*)(hp + 5632); hq[n][ai][2] = *(const u32x2v*)(hp + HALF); hq[n][ai][3] = *(const u32x2v*)(hp + 5632 + HALF); }
#pragma unroll
        for (int n = 0; n < 2; ++n) {
            const int cha = u.pn * 128 + wc * 32 + 8 * fq + 4 * n, chg = 2816 + cha;
            f32x4 wa[3], wg[3];
#pragma unroll
            for (int j = 0; j < 3; ++j) { wa[j] = *(const f32x4*)(cw + j * 5632 + cha); wg[j] = *(const f32x4*)(cw + j * 5632 + chg); }
            const f32x4 ba = *(const f32x4*)(cb + cha), bg = *(const f32x4*)(cb + chg);
#pragma unroll
            for (int ai = 0; ai < 2; ++ai) {
                const u32x2v ha2 = hq[n][ai][0], ha1 = hq[n][ai][1], hg2 = hq[n][ai][2], hg1 = hq[n][ai][3];
                f32x4 pa, pg;
                { f32x4 a1, a2, g1, g2;
                  a1[0] = __builtin_bit_cast(float, ha1.x << 16); a1[1] = __builtin_bit_cast(float, ha1.x & 0xffff0000u); a1[2] = __builtin_bit_cast(float, ha1.y << 16); a1[3] = __builtin_bit_cast(float, ha1.y & 0xffff0000u);
                  a2[0] = __builtin_bit_cast(float, ha2.x << 16); a2[1] = __builtin_bit_cast(float, ha2.x & 0xffff0000u); a2[2] = __builtin_bit_cast(float, ha2.y << 16); a2[3] = __builtin_bit_cast(float, ha2.y & 0xffff0000u);
                  g1[0] = __builtin_bit_cast(float, hg1.x << 16); g1[1] = __builtin_bit_cast(float, hg1.x & 0xffff0000u); g1[2] = __builtin_bit_cast(float, hg1.y << 16); g1[3] = __builtin_bit_cast(float, hg1.y & 0xffff0000u);
                  g2[0] = __builtin_bit_cast(float, hg2.x << 16); g2[1] = __builtin_bit_cast(float, hg2.x & 0xffff0000u); g2[2] = __builtin_bit_cast(float, hg2.y << 16); g2[3] = __builtin_bit_cast(float, hg2.y & 0xffff0000u);
                  const bool is14 = (fr == 14);
#pragma unroll
                  for (int i = 0; i < 4; ++i) { pa[i] = is14 ? a2[i] : a1[i]; pg[i] = is14 ? g2[i] : g1[i]; } }
#pragma unroll
                for (int m = 0; m < 4; ++m) {
                    const int row = row0 + ai * HALF + m * 16; const float s = rs[ai][m];
                    const f32x4 ua = acc[ai][0][m][n] * s, ug = acc[ai][1][m][n] * s;
                    float r[4];
#pragma unroll
                    for (int i = 0; i < 4; ++i) {
                        const float oa1 = DPPF(0.f, pa[i], 0x121), oa2 = DPPF(0.f, pa[i], 0x122), og1 = DPPF(0.f, pg[i], 0x121), og2 = DPPF(0.f, pg[i], 0x122);
                        const float a1 = DPPF(oa1, ua[i], 0x111), a2 = DPPF(oa2, ua[i], 0x112), g1 = DPPF(og1, ug[i], 0x111), g2 = DPPF(og2, ug[i], 0x112);
                        const float ca = wa[0][i] * a2 + wa[1][i] * a1 + wa[2][i] * ua[i] + ba[i];
                        const float cg = wg[0][i] * g2 + wg[1][i] * g1 + wg[2][i] * ug[i] + bg[i];
                        r[i] = ca * (cg * __builtin_amdgcn_rcpf(1.0f + __builtin_amdgcn_exp2f(-1.4426950408889634f * cg)));
                    }
                    pa = ua; pg = ug;
                    u32x2v w; w.x = cvt_pk_bf16(r[0], r[1]); w.y = cvt_pk_bf16(r[2], r[3]);
                    *(u32x2v*)(ACT + (size_t)row * 2816 + cha) = w;
                }
            }
        }
    }
};
template <class Epi, class Sched, bool ALIGN_EPI = false, bool SP2 = false>
__device__ __forceinline__ void gemm_phase(PG8_LAS unsigned char* lds, const Gemm g, const Sched& S, const Epi& E) {
    int tid_l = threadIdx.x; asm volatile("" : "+v"(tid_l));
    const int tid = tid_l, wid = __builtin_amdgcn_readfirstlane(tid >> 6), lane = tid & 63, wr = wid >> 2, wc = wid & 3, fr = lane & 15, fq = lane >> 4;
    const int K = g.K, nt = K / BK;
    unsigned voffA[2], voffB[2];
#pragma unroll
    for (int i = 0; i < 2; ++i) { int R, C; stage_rc(tid * 16 + i * 8192, R, C); const int Rb = Epi::PERM ? ((R & ~31) + perm32(R & 31)) : R;
        voffA[i] = (unsigned)(R * K + C) * 2u; voffB[i] = (unsigned)(Rb * K + C) * 2u; }
    const size_t kstep = (size_t)(BK * 2);
    const size_t hstep = (size_t)HALF * K * 2;
    const size_t tstep = 2 * hstep;
    const unsigned ldsw = (unsigned)wid * 1024u;
    const int aoff = lds_byte(wr * 64 + fr, fq * 8), boff = lds_byte(wc * 32 + fr, fq * 8);
#define PG8_SA(b, h) (((b) * 2 + (h)) * HTB)
#define PG8_SB(b, h) ((4 + (b) * 2 + (h)) * HTB)
#define PG8_STAGE(bufoff, gbase, voff) do { _Pragma("unroll") for (int _i = 0; _i < 2; ++_i) \
        __builtin_amdgcn_global_load_lds((const unsigned*)((const char*)(gbase) + (voff)[_i]), (PG8_LAS unsigned*)(lds + (bufoff) + ldsw + _i * 8192), 16, 0, 0); } while (0)
#define PG8_LDA(dst, b, h) do { _Pragma("unroll") for (int m = 0; m < 4; ++m) _Pragma("unroll") for (int k = 0; k < 2; ++k) dst[m][k] = *(const PG8_LAS bf16x8*)(lds + PG8_SA(b, h) + aoff + m * 2048 + k * 1024); } while (0)
#define PG8_LDB(dst, b, h) do { _Pragma("unroll") for (int n = 0; n < 2; ++n) _Pragma("unroll") for (int k = 0; k < 2; ++k) dst[n][k] = *(const PG8_LAS bf16x8*)(lds + PG8_SB(b, h) + boff + n * 2048 + k * 1024); } while (0)
#define PG8_MMA(ai, bj, At, Bt) do { __builtin_amdgcn_s_setprio(1); _Pragma("unroll") for (int m = 0; m < 4; ++m) _Pragma("unroll") for (int n = 0; n < 2; ++n) _Pragma("unroll") for (int k = 0; k < 2; ++k) \
        acc[ai][bj][m][n] = __builtin_amdgcn_mfma_f32_16x16x32_bf16(Bt[n][k], At[m][k], acc[ai][bj][m][n], 0, 0, 0); __builtin_amdgcn_s_setprio(0); } while (0)
#define PG8_WAIT_V(n) asm volatile("s_waitcnt vmcnt(" #n ")" ::: "memory")
#define PG8_WAIT_L(n) asm volatile("s_waitcnt lgkmcnt(" #n ")" ::: "memory")
#define PG8_BAR __builtin_amdgcn_s_barrier()
#define PG8_SCHED __builtin_amdgcn_sched_barrier(0)
    Unit cur, nxt; int ui = 0;
    if (!S.next(0, cur)) return;
    f32x4 acc[2][2][4][2];
#pragma unroll
    for (int a = 0; a < 2; ++a)
#pragma unroll
        for (int b = 0; b < 2; ++b)
#pragma unroll
            for (int m = 0; m < 4; ++m)
#pragma unroll
                for (int n = 0; n < 2; ++n) acc[a][b][m][n] = (f32x4){0.f, 0.f, 0.f, 0.f};
    bf16x8 At[4][2], B0[2][2], B1[2][2];
    const char* cA = (const char*)g.A + (size_t)cur.pm * tstep; const char* cB = (const char*)g.Bt + (size_t)cur.pn * tstep;
    S.a_ready(cur);
    if constexpr (SP2) {
        PG8_STAGE(PG8_SB(0, 0), cB, voffB); PG8_STAGE(PG8_SB(0, 1), cB + hstep, voffB); PG8_STAGE(PG8_SA(0, 0), cA, voffA); PG8_STAGE(PG8_SA(0, 1), cA + hstep, voffA);
        if (wr == 1) PG8_BAR;
        PG8_WAIT_V(2); PG8_BAR;
        PG8_STAGE(PG8_SB(1, 0), cB + kstep, voffB); PG8_STAGE(PG8_SA(1, 0), cA + kstep, voffA); PG8_STAGE(PG8_SB(1, 1), cB + hstep + kstep, voffB);
        PG8_WAIT_V(6); PG8_BAR;
    } else {
        PG8_STAGE(PG8_SB(0, 0), cB, voffB); PG8_STAGE(PG8_SA(0, 0), cA, voffA); PG8_STAGE(PG8_SB(0, 1), cB + hstep, voffB); PG8_STAGE(PG8_SA(0, 1), cA + hstep, voffA);
        if (wr == 1) PG8_BAR;
        PG8_WAIT_V(4); PG8_BAR;
        PG8_STAGE(PG8_SB(1, 0), cB + kstep, voffB); PG8_STAGE(PG8_SA(1, 0), cA + kstep, voffA); PG8_STAGE(PG8_SB(1, 1), cB + hstep + kstep, voffB);
        PG8_WAIT_V(6); PG8_BAR;
    }
    for (;;) {
        const bool has_next = S.next(ui + 1, nxt);
        const char* nA = has_next ? (const char*)g.A + (size_t)nxt.pm * tstep : cA; const char* nB = has_next ? (const char*)g.Bt + (size_t)nxt.pn * tstep : cB;
        for (int t = 0; t < nt; t += 2) {
            const bool last = (t == nt - 2);
            const char* a1 = cA + (size_t)(t + 1) * kstep;
            const char* a2 = last ? nA : cA + (size_t)(t + 2) * kstep; const char* b2 = last ? nB : cB + (size_t)(t + 2) * kstep;
            const char* a3 = a2 + kstep; const char* b3 = b2 + kstep;
            if (last && has_next) S.a_ready(nxt);
            if constexpr (SP2) {
            PG8_LDB(B0, 0, 0); PG8_LDB(B1, 0, 1); PG8_SCHED; PG8_LDA(At, 0, 0); PG8_STAGE(PG8_SA(1, 1), a1 + hstep, voffA);
            PG8_WAIT_V(8); PG8_WAIT_L(0); PG8_BAR; PG8_MMA(0, 0, At, B0); PG8_MMA(0, 1, At, B1); PG8_BAR; PG8_SCHED;
            PG8_LDA(At, 0, 1); PG8_STAGE(PG8_SB(0, 0), b2, voffB); PG8_STAGE(PG8_SB(0, 1), b2 + hstep, voffB); PG8_STAGE(PG8_SA(0, 0), a2, voffA);
            PG8_WAIT_V(8); PG8_WAIT_L(0); PG8_BAR; PG8_MMA(1, 0, At, B0); PG8_MMA(1, 1, At, B1); PG8_BAR; PG8_SCHED;
            PG8_LDB(B0, 1, 0); PG8_LDB(B1, 1, 1); PG8_SCHED; PG8_LDA(At, 1, 0); PG8_STAGE(PG8_SA(0, 1), a2 + hstep, voffA);
            PG8_WAIT_V(8); PG8_WAIT_L(0); PG8_BAR; PG8_MMA(0, 0, At, B0); PG8_MMA(0, 1, At, B1); PG8_BAR; PG8_SCHED;
            PG8_LDA(At, 1, 1); PG8_STAGE(PG8_SB(1, 0), b3, voffB); PG8_STAGE(PG8_SB(1, 1), b3 + hstep, voffB); PG8_STAGE(PG8_SA(1, 0), a3, voffA);
            PG8_WAIT_V(8); PG8_WAIT_L(0); PG8_BAR; PG8_MMA(1, 0, At, B0); PG8_MMA(1, 1, At, B1); PG8_BAR; PG8_SCHED;
            } else {
            PG8_LDB(B0, 0, 0); PG8_SCHED; PG8_LDA(At, 0, 0); PG8_STAGE(PG8_SA(1, 1), a1 + hstep, voffA);
            PG8_WAIT_L(8); PG8_BAR; PG8_WAIT_L(0); PG8_MMA(0, 0, At, B0); PG8_BAR; PG8_SCHED;
            PG8_LDB(B1, 0, 1); PG8_STAGE(PG8_SB(0, 0), b2, voffB);
            PG8_BAR; PG8_WAIT_L(0); PG8_MMA(0, 1, At, B1); PG8_BAR;
            PG8_LDA(At, 0, 1); PG8_STAGE(PG8_SA(0, 0), a2, voffA);
            PG8_BAR; PG8_WAIT_L(0); PG8_MMA(1, 0, At, B0); PG8_BAR; PG8_SCHED;
            PG8_STAGE(PG8_SB(0, 1), b2 + hstep, voffB);
            PG8_WAIT_V(6); PG8_BAR; PG8_MMA(1, 1, At, B1); PG8_BAR;
            PG8_LDB(B0, 1, 0); PG8_SCHED; PG8_LDA(At, 1, 0); PG8_STAGE(PG8_SA(0, 1), a2 + hstep, voffA);
            PG8_WAIT_L(8); PG8_BAR; PG8_WAIT_L(0); PG8_MMA(0, 0, At, B0); PG8_BAR; PG8_SCHED;
            PG8_LDB(B1, 1, 1); PG8_STAGE(PG8_SB(1, 0), b3, voffB);
            PG8_BAR; PG8_WAIT_L(0); PG8_MMA(0, 1, At, B1); PG8_BAR;
            PG8_LDA(At, 1, 1); PG8_STAGE(PG8_SA(1, 0), a3, voffA);
            PG8_BAR; PG8_WAIT_L(0); PG8_MMA(1, 0, At, B0); PG8_BAR; PG8_SCHED;
            PG8_STAGE(PG8_SB(1, 1), b3 + hstep, voffB);
            PG8_WAIT_V(6); PG8_BAR; PG8_MMA(1, 1, At, B1); PG8_BAR;
            }
        }
        if constexpr (ALIGN_EPI) { if (wr == 0) PG8_BAR; }
        if constexpr (!Epi::AFTER_DRAIN) { E(acc, cur, wr, wc, fr, fq); S.done(cur); }
        if (!has_next) break;
#pragma unroll
        for (int a = 0; a < 2; ++a)
#pragma unroll
            for (int b = 0; b < 2; ++b)
#pragma unroll
                for (int m = 0; m < 4; ++m)
#pragma unroll
                    for (int n = 0; n < 2; ++n) acc[a][b][m][n] = (f32x4){0.f, 0.f, 0.f, 0.f};
        cur = nxt; cA = nA; cB = nB; ++ui;
        if constexpr (ALIGN_EPI) { if (wr == 1) PG8_BAR; }
    }
    PG8_WAIT_V(0);
    if constexpr (!ALIGN_EPI) { if (wr == 0) PG8_BAR; }
    PG8_BAR;
    if constexpr (Epi::AFTER_DRAIN) { E.fused(acc, cur, wr, wc, fr, fq, lds, wid, lane); S.done(cur); }
#undef PG8_SA
#undef PG8_SB
#undef PG8_STAGE
#undef PG8_LDA
#undef PG8_LDB
#undef PG8_MMA
#undef PG8_WAIT_V
#undef PG8_WAIT_L
#undef PG8_BAR
#undef PG8_SCHED
}
}
constexpr int NWAVES = 8;
constexpr int BATCH = 8, SEQ = 4096, DM = 1024, T = BATCH * SEQ, DFF = 2816, NBN = T / 64;
constexpr float EPS = 1e-6f, LOG2E_ = 1.4426950408889634f;
constexpr float LAM_INIT = 0.35550906759096934f;
constexpr size_t MiB = 1u << 20;
constexpr size_t WS_CTL = 0, CTL_ZERO_BYTES = 1 * MiB;
constexpr size_t WS_W1T = 2 * MiB, WS_WG1T = 8 * MiB, WS_WO1T = 9 * MiB, WS_WIN0T = 11 * MiB, WS_WOUT0T = 22 * MiB, WS_WKVQT = 28 * MiB, WS_WO2T = 34 * MiB, WS_WIN1T = 36 * MiB, WS_WOUT1T = 47 * MiB;
constexpr size_t WS_COS = 53 * MiB, WS_SIN = 53 * MiB + 512 * 1024, WS_RSTD = 54 * MiB, WS_DEC = 55 * MiB;
constexpr size_t WS_XB = 64 * MiB;
constexpr size_t WS_BIG = 128 * MiB;
constexpr size_t WS_QKVG = WS_BIG;
constexpr size_t WS_QI = 320 * MiB, WS_KET = 352 * MiB, WS_PM = 384 * MiB, WS_VT = 400 * MiB;
constexpr size_t WS_OGATE = 320 * MiB;
constexpr size_t WS_U = WS_BIG;
constexpr size_t WS_ACT = 320 * MiB;
constexpr size_t WS_KR = 128 * MiB, WS_VR = 192 * MiB, WS_QR = 256 * MiB, WS_AO = 320 * MiB;
constexpr size_t WS_UH = 496 * MiB, WS_AH = 507 * MiB, WS_RSTDH = 54 * MiB + 256 * 1024;
constexpr size_t WS_PS = 56 * MiB;
constexpr size_t WS_END = 512 * MiB;
constexpr int CW_BAR = 4096;
constexpr int RING_BYTES = 131072, LDSCTL_OFF = 147456, MISC_OFF = LDSCTL_OFF + 320, LDS_BYTES = 155648;

#define GAS __attribute__((address_space(1)))
#define LAS __attribute__((address_space(3)))
typedef unsigned short bf16;
typedef unsigned v4u __attribute__((ext_vector_type(4)));
typedef unsigned v2u __attribute__((ext_vector_type(2)));
typedef float f32x4 __attribute__((ext_vector_type(4)));
typedef float f32x16 __attribute__((ext_vector_type(16)));
typedef short bf16x8 __attribute__((ext_vector_type(8)));
typedef short s16x4 __attribute__((ext_vector_type(4)));
typedef GAS unsigned gu32;
#define RLX_AGENT __ATOMIC_RELAXED, __HIP_MEMORY_SCOPE_AGENT
#define LDS_WAIT() asm volatile("s_waitcnt lgkmcnt(0)" ::: "memory")
__device__ __forceinline__ unsigned f2bf(float f) { unsigned u = __builtin_bit_cast(unsigned, f); return (u + 0x7fffu + ((u >> 16) & 1u)) >> 16; }
typedef float f32x2_t __attribute__((ext_vector_type(2))); typedef __bf16 bf16x2_t __attribute__((ext_vector_type(2)));
__device__ __forceinline__ unsigned cvtpk(float lo, float hi) { f32x2_t v = {lo, hi}; bf16x2_t b = __builtin_convertvector(v, bf16x2_t); return __builtin_bit_cast(unsigned, b); }
__device__ __forceinline__ unsigned pk2(float lo, float hi) { return cvtpk(lo, hi); }
__device__ __forceinline__ float bf2f(unsigned short x) { return __builtin_bit_cast(float, (unsigned)x << 16); }
__device__ __forceinline__ float bflo(unsigned w) { return __builtin_bit_cast(float, w << 16); }
__device__ __forceinline__ float bfhi(unsigned w) { return __builtin_bit_cast(float, w & 0xffff0000u); }
#define MFMA_BF16(a, b, c) __builtin_amdgcn_mfma_f32_32x32x16_bf16(a, b, c, 0, 0, 0)

#define XB_TMO      128
#define XB_XCNT(j)  (256  + 64 * (j))
#define XB_XSUB(j)  (1280 + 64 * (j))
#define XB_XGEN(j)  (2304 + 64 * (j))
#define XB_TOP      3328
#define XB_TOPGEN   3392
#define XCD_BAR_WORDS 3456
#define XB_SPIN_CAP (1u << 18)

__device__ __forceinline__ unsigned xb_ld(unsigned* p)              { return __hip_atomic_load(p, __ATOMIC_RELAXED, __HIP_MEMORY_SCOPE_AGENT); }
__device__ __forceinline__ unsigned xb_add(unsigned* p, unsigned v) { return __hip_atomic_fetch_add(p, v, __ATOMIC_RELAXED, __HIP_MEMORY_SCOPE_AGENT); }
__device__ __forceinline__ unsigned xb_xcc_id() { return (unsigned)__builtin_amdgcn_s_getreg((3 << 11) | 20) & 0xFu; }
#define XB_SPIN(cond, bar) do { unsigned _sp = 0; while (cond) { __builtin_amdgcn_s_sleep(1); \
    if ((++_sp & 255u) == 0u) { if (xb_ld(&(bar)[XB_TMO])) break; if (_sp > XB_SPIN_CAP) { atomicAdd(&(bar)[XB_TMO], 1u); break; } } } } while (0)

struct XcdBarrier {
    unsigned* bar; unsigned x;
    volatile LAS unsigned* st;
};

__device__ __forceinline__ XcdBarrier xcd_barrier_post(unsigned* bar, volatile LAS unsigned* st) {
    XcdBarrier b; b.bar = bar; b.x = xb_xcc_id(); b.st = st;
    if (threadIdx.x == 0) (void)xb_add(&bar[XB_XCNT(b.x)], 1u);
    return b;
}
__device__ __forceinline__ void xcd_barrier_complete(unsigned* bar, unsigned x, unsigned& nloc, unsigned& nx) {
    const unsigned G = gridDim.x * gridDim.y * gridDim.z;
    unsigned sum, cnt, mine, sp = 0u;
    for (;;) {
        sum = 0u; cnt = 0u; mine = 0u;
#pragma unroll
        for (unsigned j = 0; j < 16; ++j) { const unsigned c = xb_ld(&bar[XB_XCNT(j)]); sum += c; cnt += (c > 0u) ? 1u : 0u; mine = (j == x) ? c : mine; }
        if (sum == G) break;
        __builtin_amdgcn_s_sleep(1);
        if ((++sp & 255u) == 0u) { if (xb_ld(&bar[XB_TMO])) break; if (sp > XB_SPIN_CAP) { atomicAdd(&bar[XB_TMO], 1u); break; } }
    }
    nloc = mine > 0u ? mine : 1u; nx = cnt > 0u ? cnt : 1u;
}

__device__ __forceinline__ void xcd_barrier(const XcdBarrier& b) {
    asm volatile("s_waitcnt vmcnt(0)" ::: "memory");
    __syncthreads();
    if (threadIdx.x == 0) {
        unsigned* bar = b.bar; asm volatile("" : "+s"(bar));
        __builtin_amdgcn_s_waitcnt(0);
        unsigned nloc = b.st[0], nx = b.st[1];
        if (nloc == 0u) { xcd_barrier_complete(bar, b.x, nloc, nx); b.st[0] = nloc; b.st[1] = nx; }
        const unsigned old = xb_add(&bar[XB_XSUB(b.x)], 1u);
        const unsigned gen = old / nloc;
        if (old + 1u == (gen + 1u) * nloc) {
            __builtin_amdgcn_fence(__ATOMIC_RELEASE, "agent");
            asm volatile("s_waitcnt vmcnt(0)" ::: "memory");
            const unsigned og = xb_add(&bar[XB_TOP], 1u);
            const unsigned tg = og / nx;
            if (og + 1u == (tg + 1u) * nx) xb_add(&bar[XB_TOPGEN], 1u);
            else XB_SPIN(xb_ld(&bar[XB_TOPGEN]) == tg, bar);
            __builtin_amdgcn_fence(__ATOMIC_ACQUIRE, "agent");
            xb_add(&bar[XB_XGEN(b.x)], 1u);
            asm volatile("s_waitcnt vmcnt(0)" ::: "memory");
        } else {
            XB_SPIN(xb_ld(&bar[XB_XGEN(b.x)]) == gen, bar);
            __builtin_amdgcn_fence(__ATOMIC_ACQUIRE, "agent");
            asm volatile("s_waitcnt vmcnt(0)" ::: "memory");
        }
    }
    __syncthreads();
}


__device__ __forceinline__ float wave_sum(float v) {
#pragma unroll
    for (int o = 1; o < 64; o <<= 1) v += __shfl_xor(v, o);
    return v;
}

struct Args { const float* in[20]; float* out; unsigned char* ws; int ph_lo, ph_hi; };
enum { I_X = 0, I_ATTN_NORM, I_FFN_NORM, I_WQKVG, I_WGK1, I_WGK2, I_BGK, I_ONORM, I_GLA_WO, I_KVNORM, I_WKV, I_WQ, I_LAMBDA, I_SUBLN, I_DIFF_WO, I_WIN, I_CONVW, I_CONVB, I_WOUT, I_FINAL };

template <int MAP> __device__ __forceinline__ int map_row(int s) {
    if (MAP == 0) return s;
    if (MAP == 1) { const int half = s >= DFF ? 1 : 0, j = s - half * DFF; return (j >> 7) * 256 + half * 128 + (j & 127); }
    const int tile = s >> 8, cidx = (s >> 6) & 3, d = s & 63, bj = cidx >> 1, wcp = cidx & 1, n = d >> 5, dd = d & 31;
    return tile * 256 + 128 * bj + 32 * (2 * wcp + (dd >> 4)) + 16 * n + 4 * ((dd & 15) >> 2) + (dd & 3);
}
template <int MAP> __device__ __forceinline__ void transpose_item(const float* W, int ldw, int K, int N, const float* gain, float scale, bf16* WT, int row_off, LAS float* scr, int item, int lane) {
    const int nblk = N / 32, kb = item / nblk, nb = item % nblk, k0 = 64 * kb, n0 = 32 * nb;
#pragma unroll
    for (int i = 0; i < 8; ++i) { const int kk = 8 * i + (lane >> 3), n4 = (lane & 7) * 4; const float g = gain ? gain[k0 + kk] * scale : scale;
        const f32x4 w = *(const f32x4*)(W + (size_t)(k0 + kk) * ldw + n0 + n4);
        scr[kk * 33 + n4] = w[0] * g; scr[kk * 33 + n4 + 1] = w[1] * g; scr[kk * 33 + n4 + 2] = w[2] * g; scr[kk * 33 + n4 + 3] = w[3] * g; }
    LDS_WAIT(); asm volatile("" ::: "memory");
    const int c = lane & 7;
#pragma unroll
    for (int j = 0; j < 4; ++j) { const int n = (lane >> 3) + 8 * j; const LAS float* s = scr + (8 * c) * 33 + n;
        v4u o; o.x = pk2(s[0 * 33], s[1 * 33]); o.y = pk2(s[2 * 33], s[3 * 33]); o.z = pk2(s[4 * 33], s[5 * 33]); o.w = pk2(s[6 * 33], s[7 * 33]);
        *(v4u*)(WT + (size_t)(row_off + map_row<MAP>(n0 + n)) * K + k0 + 8 * c) = o; }
    LDS_WAIT(); asm volatile("" ::: "memory");
}
__device__ __forceinline__ void sincos_d(double x, double& s, double& c) {
    const double k = __builtin_rint(x * 0.15915494309189535);
    double r = __builtin_fma(-k, 6.283185307179586, x); r = __builtin_fma(-k, 2.4492935982947064e-16, r);
    const double y = r * 0.25, y2 = y * y;
    double sy = 1.0 - y2 * (1.0 / 272.0);
    sy = 1.0 - y2 * (1.0 / 210.0) * sy; sy = 1.0 - y2 * (1.0 / 156.0) * sy; sy = 1.0 - y2 * (1.0 / 110.0) * sy; sy = 1.0 - y2 * (1.0 / 72.0) * sy;
    sy = 1.0 - y2 * (1.0 / 42.0) * sy; sy = 1.0 - y2 * (1.0 / 20.0) * sy; sy = 1.0 - y2 * (1.0 / 6.0) * sy; sy = y * sy;
    double cy = 1.0 - y2 * (1.0 / 240.0);
    cy = 1.0 - y2 * (1.0 / 182.0) * cy; cy = 1.0 - y2 * (1.0 / 132.0) * cy; cy = 1.0 - y2 * (1.0 / 90.0) * cy; cy = 1.0 - y2 * (1.0 / 56.0) * cy;
    cy = 1.0 - y2 * (1.0 / 30.0) * cy; cy = 1.0 - y2 * (1.0 / 12.0) * cy; cy = 1.0 - y2 * 0.5 * cy;
    const double s2 = 2.0 * sy * cy, c2 = 1.0 - 2.0 * sy * sy;
    s = 2.0 * s2 * c2; c = 1.0 - 2.0 * s2 * s2;
}
__device__ __forceinline__ void row_to_bf16_ps(const float* xrow, bf16* orow, float* ps_row, int lane) {
    const f32x4* xr = (const f32x4*)xrow + lane;
    f32x4 v[4]; float s = 0.f;
#pragma unroll
    for (int j = 0; j < 4; ++j) { v[j] = xr[64 * j]; s += (v[j].x * v[j].x + v[j].y * v[j].y) + (v[j].z * v[j].z + v[j].w * v[j].w); }
    s = wave_sum(s);
    if (lane < 16) ps_row[lane] = lane == 0 ? s : 0.f;
    unsigned long long* o8 = (unsigned long long*)orow + lane;
#pragma unroll
    for (int j = 0; j < 4; ++j) o8[64 * j] = (unsigned long long)pk2(v[j].x, v[j].y) | ((unsigned long long)pk2(v[j].z, v[j].w) << 32);
}
__device__ __forceinline__ void p0_prologue(const Args& A, LAS unsigned char* lds, int vcu, int G, int wave, int lane, int tid) {
    unsigned char* ws = A.ws;
    LAS float* scr = (LAS float*)(lds + wave * 16384);
    const int gw = vcu * NWAVES + wave, NGW = G * NWAVES;
    constexpr int I0 = (DM / 64) * (3072 / 32), I1 = (DM / 64) * (DM / 32), I2 = (DM / 64) * (2 * DFF / 32), I3 = (DFF / 64) * (DM / 32);
    constexpr int NITEMS = I0 + I1 + I2 + I3 + 3 * I1 + I1 + I2 + I3;
    const float QS = 0.18033688011112042f;
    for (int it = gw; it < NITEMS; it += NGW) {
        int r = it;
        if (r < I0) { transpose_item<0>(A.in[I_WQKVG], 3072, DM, 3072, A.in[I_ATTN_NORM], 1.f, (bf16*)(ws + WS_W1T), 0, scr, r, lane); continue; } r -= I0;
        if (r < I1) { transpose_item<0>(A.in[I_GLA_WO], DM, DM, DM, nullptr, 1.f, (bf16*)(ws + WS_WO1T), 0, scr, r, lane); continue; } r -= I1;
        if (r < I2) { transpose_item<1>(A.in[I_WIN], 2 * DFF, DM, 2 * DFF, A.in[I_FFN_NORM], 1.f, (bf16*)(ws + WS_WIN0T), 0, scr, r, lane); continue; } r -= I2;
        if (r < I3) { transpose_item<0>(A.in[I_WOUT], DM, DFF, DM, nullptr, 1.f, (bf16*)(ws + WS_WOUT0T), 0, scr, r, lane); continue; } r -= I3;
        if (r < I1) { transpose_item<2>(A.in[I_WKV], 2048, DM, 1024, A.in[I_KVNORM], 1.f, (bf16*)(ws + WS_WKVQT), 0, scr, r, lane); continue; } r -= I1;
        if (r < I1) { transpose_item<0>(A.in[I_WKV] + 1024, 2048, DM, 1024, A.in[I_KVNORM], 1.f, (bf16*)(ws + WS_WKVQT), 1024, scr, r, lane); continue; } r -= I1;
        if (r < I1) { transpose_item<2>(A.in[I_WQ], DM, DM, 1024, A.in[I_ATTN_NORM] + DM, QS, (bf16*)(ws + WS_WKVQT), 2048, scr, r, lane); continue; } r -= I1;
        if (r < I1) { transpose_item<0>(A.in[I_DIFF_WO], DM, DM, DM, nullptr, 1.f, (bf16*)(ws + WS_WO2T), 0, scr, r, lane); continue; } r -= I1;
        if (r < I2) { transpose_item<1>(A.in[I_WIN] + (size_t)DM * 2 * DFF, 2 * DFF, DM, 2 * DFF, A.in[I_FFN_NORM] + DM, 1.f, (bf16*)(ws + WS_WIN1T), 0, scr, r, lane); continue; } r -= I2;
        transpose_item<0>(A.in[I_WOUT] + (size_t)DFF * DM, DM, DFF, DM, nullptr, 1.f, (bf16*)(ws + WS_WOUT1T), 0, scr, r, lane);
    }
    const int gt = vcu * (NWAVES * 64) + tid, NGT = G * NWAVES * 64;
    for (int i = gt; i < 32 * DM; i += NGT) { const int j = i >> 10, k = i & 1023; ((bf16*)(ws + WS_WG1T))[i] = j < 16 ? (bf16)f2bf(A.in[I_WGK1][k * 16 + j] * A.in[I_ATTN_NORM][k]) : (bf16)0; }
    for (int i = gt; i < SEQ * 32; i += NGT) { const int pos = i >> 5, fi = i & 31; double inv = 1.0; for (int q = 0; q < fi; ++q) inv *= 0.7498942093324558;
        double s, c; sincos_d((double)pos * inv, s, c); ((float*)(ws + WS_COS))[i] = (float)c; ((float*)(ws + WS_SIN))[i] = (float)s; }
    for (int i = gt; i < 1024 * DM / 8; i += NGT) ((v4u*)(ws + WS_AH))[i] = (v4u){0u, 0u, 0u, 0u};
    for (int m = gw; m < T; m += 2 * NGW) {
        const int m2 = m + NGW; const bool h2 = m2 < T;
        const f32x4* xa = (const f32x4*)(A.in[I_X] + (size_t)m * DM) + lane; const f32x4* xb2 = (const f32x4*)(A.in[I_X] + (size_t)(h2 ? m2 : m) * DM) + lane;
        f32x4 va[4], vb[4]; float sa = 0.f, sb = 0.f;
#pragma unroll
        for (int j = 0; j < 4; ++j) { va[j] = xa[64 * j]; vb[j] = xb2[64 * j]; }
#pragma unroll
        for (int j = 0; j < 4; ++j) { sa += (va[j].x * va[j].x + va[j].y * va[j].y) + (va[j].z * va[j].z + va[j].w * va[j].w); sb += (vb[j].x * vb[j].x + vb[j].y * vb[j].y) + (vb[j].z * vb[j].z + vb[j].w * vb[j].w); }
        sa = wave_sum(sa); sb = wave_sum(sb);
        if (lane == 0) { ((float*)(ws + WS_RSTD))[m] = __builtin_amdgcn_rsqf(sa * (1.0f / DM) + EPS); if (h2) ((float*)(ws + WS_RSTD))[m2] = __builtin_amdgcn_rsqf(sb * (1.0f / DM) + EPS); }
        unsigned long long* oa = (unsigned long long*)((bf16*)(ws + WS_XB) + (size_t)m * DM) + lane; unsigned long long* ob = (unsigned long long*)((bf16*)(ws + WS_XB) + (size_t)m2 * DM) + lane;
#pragma unroll
        for (int j = 0; j < 4; ++j) { oa[64 * j] = (unsigned long long)pk2(va[j].x, va[j].y) | ((unsigned long long)pk2(va[j].z, va[j].w) << 32);
            if (h2) ob[64 * j] = (unsigned long long)pk2(vb[j].x, vb[j].y) | ((unsigned long long)pk2(vb[j].z, vb[j].w) << 32); }
    }
}

__device__ __forceinline__ void final_norm_phase(const bf16* HB, const float* PS, float* out, const float* w, int vcu, int G, int wave, int lane) {
    const int gw = vcu * NWAVES + wave, NGW = G * NWAVES;
    const f32x4* wp = (const f32x4*)w + 2 * lane; const f32x4 w00 = wp[0], w01 = wp[1], w10 = wp[128], w11 = wp[129];
    for (int m0 = gw; m0 < T; m0 += 4 * NGW) {
        v4u r0[4], r1[4]; float rs[4];
#pragma unroll
        for (int q = 0; q < 4; ++q) { const int m = m0 + q * NGW; const int mm = m < T ? m : m0; const v4u* hp = (const v4u*)(HB + (size_t)mm * DM) + lane; r0[q] = hp[0]; r1[q] = hp[64]; rs[q] = pg8::rstd_ps(PS, mm); }
#pragma unroll
        for (int q = 0; q < 4; ++q) { const int m = m0 + q * NGW; if (m < T) { f32x4* op = (f32x4*)(out + (size_t)m * DM) + 2 * lane; const float rstd = rs[q];
            f32x4 a, b; a[0] = bflo(r0[q].x); a[1] = bfhi(r0[q].x); a[2] = bflo(r0[q].y); a[3] = bfhi(r0[q].y); b[0] = bflo(r0[q].z); b[1] = bfhi(r0[q].z); b[2] = bflo(r0[q].w); b[3] = bfhi(r0[q].w);
            op[0] = a * rstd * w00; op[1] = b * rstd * w01;
            a[0] = bflo(r1[q].x); a[1] = bfhi(r1[q].x); a[2] = bflo(r1[q].y); a[3] = bfhi(r1[q].y); b[0] = bflo(r1[q].z); b[1] = bfhi(r1[q].z); b[2] = bflo(r1[q].w); b[3] = bfhi(r1[q].w);
            op[128] = a * rstd * w10; op[129] = b * rstd * w11; } }
    }
}
__device__ __forceinline__ void gla_gate_phase(const bf16* O, const bf16* QKVG, const float* onw, bf16* OG, int vcu, int G, int wave, int lane) {
    const int gw = vcu * NWAVES + wave, NGW = G * NWAVES;
    const f32x4* wp = (const f32x4*)(onw + 16 * (lane & 15)); const f32x4 wq[4] = {wp[0], wp[1], wp[2], wp[3]};
    for (int m0 = gw; m0 < T; m0 += 4 * NGW) {
        v4u o0[4], o1[4], g0[4], g1[4];
#pragma unroll
        for (int q = 0; q < 4; ++q) { const int m = m0 + q * NGW; const int mm = m < T ? m : m0; const v4u* op = (const v4u*)(O + (size_t)mm * DM + 16 * lane); const v4u* gp = (const v4u*)(QKVG + (size_t)mm * 3072 + 2048 + 16 * lane);
            o0[q] = op[0]; o1[q] = op[1]; g0[q] = gp[0]; g1[q] = gp[1]; }
#pragma unroll
        for (int q = 0; q < 4; ++q) { const int m = m0 + q * NGW; if (m < T) {
            float ov[16], gv[16];
#pragma unroll
            for (int i = 0; i < 4; ++i) { ov[2 * i] = bflo(o0[q][i]); ov[2 * i + 1] = bfhi(o0[q][i]); ov[8 + 2 * i] = bflo(o1[q][i]); ov[8 + 2 * i + 1] = bfhi(o1[q][i]);
                                          gv[2 * i] = bflo(g0[q][i]); gv[2 * i + 1] = bfhi(g0[q][i]); gv[8 + 2 * i] = bflo(g1[q][i]); gv[8 + 2 * i + 1] = bfhi(g1[q][i]); }
            float s = 0.f;
#pragma unroll
            for (int i = 0; i < 16; ++i) s += ov[i] * ov[i];
            s += __shfl_xor(s, 1); s += __shfl_xor(s, 2); s += __shfl_xor(s, 4); s += __shfl_xor(s, 8);
            const float rstd = __builtin_amdgcn_rsqf(s * (1.0f / 256.0f) + EPS);
            float r[16];
#pragma unroll
            for (int k = 0; k < 4; ++k)
#pragma unroll
                for (int i = 0; i < 4; ++i) { const float g = gv[4 * k + i]; r[4 * k + i] = ov[4 * k + i] * rstd * wq[k][i] * (g * __builtin_amdgcn_rcpf(1.0f + __builtin_amdgcn_exp2f(-LOG2E_ * g))); }
            v4u w0, w1;
#pragma unroll
            for (int i = 0; i < 4; ++i) { w0[i] = pk2(r[2 * i], r[2 * i + 1]); w1[i] = pk2(r[8 + 2 * i], r[8 + 2 * i + 1]); }
            v4u* dp = (v4u*)(OG + (size_t)m * DM + 16 * lane); dp[0] = w0; dp[1] = w1; } }
    }
}
constexpr float LOG2E = 1.4426950408889634f, LN2 = 0.6931471805599453f;
__device__ __forceinline__ void gla_pre_unit(const Args& A, int bn, LAS unsigned char* lds, int tid_in, int wave) {
    int tid = tid_in; asm volatile("" : "+v"(tid)); const int lane = tid & 63;
    unsigned char* ws = A.ws;
    const bf16* XB = (const bf16*)(ws + WS_XB); const bf16* WG1T = (const bf16*)(ws + WS_WG1T); const float* PS = (const float*)(ws + WS_PS);
    const bf16* QKVG = (const bf16*)(ws + WS_QKVG);
    bf16* QIG = (bf16*)(ws + WS_QI); bf16* KIG = (bf16*)(ws + WS_KET); bf16* PM = (bf16*)(ws + WS_PM); float* DEC = (float*)(ws + WS_DEC);
    const int row0 = bn * 64, cl = lane & 31, h = lane >> 5;
    LAS float* r_lds = (LAS float*)lds;
    LAS float* part = (LAS float*)(lds + 4608);
    LAS unsigned char* QIl = lds + 4608;
    LAS unsigned char* KIl = lds + 4608 + 69632;
    v4u qraw[8], kraw[8];
#pragma unroll
    for (int q = 0; q < 8; ++q) { const int idx = tid + 512 * q, t = idx >> 6, ch8 = idx & 63; const bf16* p = QKVG + (size_t)(row0 + t) * 3072 + ch8 * 8; qraw[q] = *(const v4u*)p; kraw[q] = *(const v4u*)(p + 512); }
    {
        bf16x8 bfr[8], afr[2][8];
        const bf16* bp = WG1T + (size_t)cl * DM + 128 * wave + 8 * h;
#pragma unroll
        for (int s = 0; s < 8; ++s) bfr[s] = *(const bf16x8*)(bp + 16 * s);
#pragma unroll
        for (int rb = 0; rb < 2; ++rb) { const bf16* ap = XB + (size_t)(row0 + 32 * rb + cl) * DM + 128 * wave + 8 * h;
#pragma unroll
            for (int s = 0; s < 8; ++s) afr[rb][s] = *(const bf16x8*)(ap + 16 * s); }
        __builtin_amdgcn_sched_barrier(0);
#pragma unroll
        for (int rb = 0; rb < 2; ++rb) {
            f32x16 acc = {};
#pragma unroll
            for (int s = 0; s < 8; ++s) acc = MFMA_BF16(afr[rb][s], bfr[s], acc);
            if (cl < 16) {
#pragma unroll
                for (int i = 0; i < 16; ++i) { const int row = 32 * rb + (i & 3) + 8 * (i >> 2) + 4 * h; part[(wave * 64 + row) * 16 + cl] = acc[i]; }
            }
        }
    }
    __syncthreads();
    float rsum[2];
#pragma unroll
    for (int q = 0; q < 2; ++q) { const int idx = tid + 512 * q, row = idx >> 4, j = idx & 15; float s = 0.f;
#pragma unroll
        for (int w = 0; w < 8; ++w) s += part[(w * 64 + row) * 16 + j];
        rsum[q] = s * ((const float*)(ws + WS_RSTD))[row0 + row]; }
    __syncthreads();
#pragma unroll
    for (int q = 0; q < 2; ++q) { const int idx = tid + 512 * q, row = idx >> 4, j = idx & 15; r_lds[row * 17 + j] = rsum[q]; }
#pragma unroll
    for (int q = 0; q < 8; ++q) { const int idx = tid + 512 * q, t = idx >> 6, ch8 = idx & 63, hd2 = ch8 >> 4, cc2 = (ch8 & 15) * 8; const int off = ((hd2 * 64 + t) * 136 + cc2) * 2;
        *(LAS v4u*)(QIl + off) = qraw[q]; *(LAS v4u*)(KIl + off) = kraw[q]; }
    __syncthreads();
    const int hd = wave >> 1, chh = wave & 1;
#pragma unroll 1
    for (int cb = 0; cb < 2; ++cb) {
        const int cc = 64 * chh + 32 * cb + cl, c = hd * 128 + cc;
        const float bias = A.in[I_BGK][c];
        float pre = 0.f;
#pragma unroll 1
        for (int rb = 0; rb < 2; ++rb) {
            f32x16 x = {};
#pragma unroll
            for (int s = 0; s < 8; ++s) { const float a = r_lds[(32 * rb + cl) * 17 + 2 * s + h]; const float b = A.in[I_WGK2][(2 * s + h) * 512 + c]; x = __builtin_amdgcn_mfma_f32_32x32x2f32(a, b, x, 0, 0, 0); }
#pragma unroll
            for (int i = 0; i < 16; ++i) { const float v = x[i] + bias; const float e = __builtin_amdgcn_exp2f(-fabsf(v) * LOG2E);
                x[i] = (fminf(v, 0.f) - __builtin_amdgcn_logf(1.0f + e) * LN2) * (0.0625f * LOG2E); }
#pragma unroll
            for (int g = 0; g < 4; ++g) {
                const float own = (x[4 * g] + x[4 * g + 1]) + (x[4 * g + 2] + x[4 * g + 3]); const float oth = __shfl_xor(own, 32);
                const float start = pre + (h ? oth : 0.f);
                x[4 * g] += start; x[4 * g + 1] += x[4 * g]; x[4 * g + 2] += x[4 * g + 1]; x[4 * g + 3] += x[4 * g + 2];
                pre += own + oth;
            }
#pragma unroll
            for (int i = 0; i < 16; ++i) { const int t = 32 * rb + (i & 3) + 8 * (i >> 2) + 4 * h; const int off = ((hd * 64 + t) * 136 + cc) * 2;
                const float qv = bf2f(*(const LAS bf16*)(QIl + off)), kv = bf2f(*(const LAS bf16*)(KIl + off)); const float bb = x[i];
                const float qi = qv * 0.08838834764831845f * __builtin_amdgcn_exp2f(bb), ki = kv * __builtin_amdgcn_exp2f(-bb);
                *(LAS bf16*)(QIl + off) = (bf16)(cvtpk(qi, 0.f) & 0xffffu); *(LAS bf16*)(KIl + off) = (bf16)(cvtpk(ki, 0.f) & 0xffffu); }
        }
        if (h == 0) DEC[bn * 512 + c] = __builtin_amdgcn_exp2f(pre);
    }
    __syncthreads();
#pragma unroll
    for (int q = 0; q < 8; ++q) { const int idx = tid + 512 * q, t = idx >> 6, ch8 = idx & 63, hd2 = ch8 >> 4, cc2 = (ch8 & 15) * 8;
        const v4u kv = *(const LAS v4u*)(KIl + ((hd2 * 64 + t) * 136 + cc2) * 2); *(v4u*)(KIG + (size_t)(row0 + t) * 512 + hd2 * 128 + cc2) = kv;
        const int c0 = (cc2 & ~15) + 4 * ((cc2 >> 3) & 1);
        const v2u qa = *(const LAS v2u*)(QIl + ((hd2 * 64 + t) * 136 + c0) * 2), qb = *(const LAS v2u*)(QIl + ((hd2 * 64 + t) * 136 + c0 + 8) * 2);
        v4u qv; qv.x = qa.x; qv.y = qa.y; qv.z = qb.x; qv.w = qb.y; *(v4u*)(QIG + (size_t)(row0 + t) * 512 + hd2 * 128 + cc2) = qv; }
    { const int rb = wave & 1; const int t = 32 * rb + cl;
#pragma unroll
        for (int cbp = 0; cbp < 2; ++cbp) {
            f32x16 acc = {};
#pragma unroll
            for (int s = 0; s < 8; ++s) { const bf16x8 a = *(const LAS bf16x8*)(KIl + ((hd * 64 + 32 * cbp + cl) * 136 + 16 * s + 8 * h) * 2), b = *(const LAS bf16x8*)(QIl + ((hd * 64 + 32 * rb + cl) * 136 + 16 * s + 8 * h) * 2); acc = MFMA_BF16(a, b, acc); }
#pragma unroll
            for (int g = 0; g < 4; ++g) { const int tp0 = 32 * cbp + 8 * g + 4 * h; float v[4];
#pragma unroll
                for (int ii = 0; ii < 4; ++ii) v[ii] = (tp0 + ii <= t) ? acc[4 * g + ii] : 0.f;
                v2u w; w.x = pk2(v[0], v[1]); w.y = pk2(v[2], v[3]); *(v2u*)(PM + ((size_t)(bn * 4 + hd) * 64 + t) * 64 + tp0) = w; }
        }
    }
    __syncthreads();
}

constexpr int SL_P = 0, SL_QI = 9216, SL_KI = 26624, SL_V = 47104, SL_DEC = 51200, SL_BYTES = 51712;
struct SeqRegs { v4u p, q0, q1, k0, k1, x; };
__device__ __forceinline__ void seq_fetch(SeqRegs& R, const unsigned char* ws, int bn, int hd, int es, int tid) {
    const bf16* QIG = (const bf16*)(ws + WS_QI); const bf16* KIG = (const bf16*)(ws + WS_KET); const bf16* PM = (const bf16*)(ws + WS_PM); const bf16* QKVG = (const bf16*)(ws + WS_QKVG); const float* DEC = (const float*)(ws + WS_DEC);
    const int row0 = bn * 64;
    R.p = *(const v4u*)(PM + ((size_t)(bn * 4 + hd) * 64 + (tid >> 3)) * 64 + (tid & 7) * 8);
    { const int t = tid >> 4, c16 = tid & 15; const size_t o0 = (size_t)(row0 + t) * 512 + hd * 128 + c16 * 8, o1 = o0 + (size_t)32 * 512;
      R.q0 = *(const v4u*)(QIG + o0); R.q1 = *(const v4u*)(QIG + o1); R.k0 = *(const v4u*)(KIG + o0); R.k1 = *(const v4u*)(KIG + o1); }
    if (tid < 256) R.x = *(const v4u*)(QKVG + (size_t)(row0 + (tid >> 2)) * 3072 + 1024 + hd * 256 + 32 * es + (tid & 3) * 8);
    else if (tid < 288) R.x = *(const v4u*)(DEC + bn * 512 + hd * 128 + (tid - 256) * 4);
}
__device__ __forceinline__ void seq_put(const SeqRegs& R, LAS unsigned char* slot, int tid) {
    *(LAS v4u*)(slot + SL_P + (tid >> 3) * 144 + (tid & 7) * 16) = R.p;
    { const int t = tid >> 4, c16 = tid & 15;
      *(LAS v4u*)(slot + SL_QI + t * 272 + c16 * 16) = R.q0; *(LAS v4u*)(slot + SL_QI + (t + 32) * 272 + c16 * 16) = R.q1;
      *(LAS v4u*)(slot + SL_KI + t * 320 + c16 * 16) = R.k0; *(LAS v4u*)(slot + SL_KI + (t + 32) * 320 + c16 * 16) = R.k1; }
    if (tid < 256) *(LAS v4u*)(slot + SL_V + (tid >> 2) * 64 + (tid & 3) * 16) = R.x;
    else if (tid < 288) *(LAS v4u*)(slot + SL_DEC + (tid - 256) * 16) = R.x;
}
#define LTR(p) __builtin_bit_cast(s16x4, __builtin_amdgcn_ds_read_tr16_b64_v4i16((LAS s16x4*)(p)))
__device__ __forceinline__ void seq_out(LAS unsigned char* slot, const LAS unsigned char* sfr, bf16* O, int row0, int ocol, int rb, int lane) {
    const int cl = lane & 31, h = lane >> 5;
    const int trb = (8 * h + ((lane & 15) >> 2)), trc = (16 * ((lane >> 4) & 1) + 4 * (lane & 3)) * 2;
    bf16x8 vt[4], pf[4], sa[4], qw[4];
#pragma unroll
    for (int s = 0; s < 4; ++s) { const s16x4 lo = LTR(slot + SL_V + (16 * s + trb) * 64 + trc), hi = LTR(slot + SL_V + (16 * s + 4 + trb) * 64 + trc); vt[s] = (bf16x8){lo[0], lo[1], lo[2], lo[3], hi[0], hi[1], hi[2], hi[3]}; }
#pragma unroll
    for (int s = 0; s < 4; ++s) pf[s] = *(const LAS bf16x8*)(slot + SL_P + (32 * rb + cl) * 144 + (16 * s + 8 * h) * 2);
#pragma unroll
    for (int i = 0; i < 4; ++i) { sa[i] = *(const LAS bf16x8*)(sfr + i * 1024 + lane * 16); qw[i] = *(const LAS bf16x8*)(slot + SL_QI + (32 * rb + cl) * 272 + (16 * i + 8 * h) * 2); }
    __builtin_amdgcn_sched_barrier(0);
    f32x16 acc = {};
#pragma unroll
    for (int s = 0; s < 4; ++s) acc = MFMA_BF16(vt[s], pf[s], acc);
    __builtin_amdgcn_sched_barrier(0);
#pragma unroll
    for (int i = 0; i < 4; ++i) { vt[i] = *(const LAS bf16x8*)(sfr + (4 + i) * 1024 + lane * 16); pf[i] = *(const LAS bf16x8*)(slot + SL_QI + (32 * rb + cl) * 272 + (16 * (4 + i) + 8 * h) * 2); }
    __builtin_amdgcn_sched_barrier(0);
#pragma unroll
    for (int i = 0; i < 4; ++i) acc = MFMA_BF16(sa[i], qw[i], acc);
#pragma unroll
    for (int i = 0; i < 4; ++i) acc = MFMA_BF16(vt[i], pf[i], acc);
#pragma unroll
    for (int g = 0; g < 4; ++g) { v2u w; w.x = cvtpk(acc[4 * g], acc[4 * g + 1]); w.y = cvtpk(acc[4 * g + 2], acc[4 * g + 3]);
        *(v2u*)(O + (size_t)(row0 + 32 * rb + cl) * DM + ocol + 8 * g + 4 * h) = w; }
}
__device__ __forceinline__ void seq_state(f32x16 (&S)[2], LAS unsigned char* slot, LAS unsigned char* sfw, int blk0, int lane) {
    const int h = lane >> 5;
    const int trb = (8 * h + ((lane & 15) >> 2)), trc = (16 * ((lane >> 4) & 1) + 4 * (lane & 3)) * 2;
    bf16x8 vt[4];
#pragma unroll
    for (int s = 0; s < 4; ++s) { const s16x4 lo = LTR(slot + SL_V + (16 * s + trb) * 64 + trc), hi = LTR(slot + SL_V + (16 * s + 4 + trb) * 64 + trc); vt[s] = (bf16x8){lo[0], lo[1], lo[2], lo[3], hi[0], hi[1], hi[2], hi[3]}; }
#pragma unroll
    for (int bi = 0; bi < 2; ++bi) { const int blk = blk0 + bi;
        bf16x8 ke[4];
#pragma unroll
        for (int s = 0; s < 4; ++s) { const s16x4 lo = LTR(slot + SL_KI + (16 * s + trb) * 320 + 64 * blk + trc), hi = LTR(slot + SL_KI + (16 * s + 4 + trb) * 320 + 64 * blk + trc);
            ke[s] = (bf16x8){lo[0], lo[1], lo[2], lo[3], hi[0], hi[1], hi[2], hi[3]}; }
#pragma unroll
        for (int s = 0; s < 4; ++s) S[bi] = MFMA_BF16(ke[s], vt[s], S[bi]);
#pragma unroll
        for (int g = 0; g < 4; ++g) { const f32x4 d4 = *(const LAS f32x4*)(slot + SL_DEC + (32 * blk + 8 * g + 4 * h) * 4);
#pragma unroll
            for (int ii = 0; ii < 4; ++ii) S[bi][4 * g + ii] *= d4[ii]; }
#pragma unroll
        for (int sp = 0; sp < 2; ++sp) { v4u sw; sw.x = cvtpk(S[bi][8 * sp], S[bi][8 * sp + 1]); sw.y = cvtpk(S[bi][8 * sp + 2], S[bi][8 * sp + 3]); sw.z = cvtpk(S[bi][8 * sp + 4], S[bi][8 * sp + 5]); sw.w = cvtpk(S[bi][8 * sp + 6], S[bi][8 * sp + 7]);
            *(LAS v4u*)(sfw + (2 * blk + sp) * 1024 + lane * 16) = sw; }
    }
}
constexpr int SEQ_SF = 2 * SL_BYTES;
__device__ __forceinline__ void seq_touch(unsigned& d0, unsigned& d1, const unsigned char* ws, int bn, int hd, int es, int t  ) {
    const bf16* QIG = (const bf16*)(ws + WS_QI); const bf16* KIG = (const bf16*)(ws + WS_KET); const bf16* PM = (const bf16*)(ws + WS_PM); const bf16* QKVG = (const bf16*)(ws + WS_QKVG); const float* DEC = (const float*)(ws + WS_DEC);
    const int row0 = bn * 64;
    const bf16* p0;
    if (t < 64) p0 = PM + (size_t)(bn * 4 + hd) * 4096 + t * 64;
    else if (t < 192) p0 = QIG + (size_t)(row0 + ((t - 64) >> 1)) * 512 + hd * 128 + ((t - 64) & 1) * 64;
    else p0 = QKVG + (size_t)(row0 + (t - 192)) * 3072 + 1024 + hd * 256 + 32 * es;
    d0 = *(const unsigned*)p0;
    if (t < 128) d1 = *(const unsigned*)(KIG + (size_t)(row0 + (t >> 1)) * 512 + hd * 128 + (t & 1) * 64);
    else if (t < 132) d1 = *(const unsigned*)(DEC + bn * 512 + hd * 128 + (t - 128) * 32);
}
struct SeqRegs4 { v4u p[2], q[4], k[4], x, d; };
__device__ __forceinline__ void seq_fetch4(SeqRegs4& R, const unsigned char* ws, int bn, int hd, int es, int lt) {
    const bf16* QIG = (const bf16*)(ws + WS_QI); const bf16* KIG = (const bf16*)(ws + WS_KET); const bf16* PM = (const bf16*)(ws + WS_PM); const bf16* QKVG = (const bf16*)(ws + WS_QKVG); const float* DEC = (const float*)(ws + WS_DEC);
    const int row0 = bn * 64;
#pragma unroll
    for (int j = 0; j < 2; ++j) { const int idx = lt + 256 * j; R.p[j] = *(const v4u*)(PM + ((size_t)(bn * 4 + hd) * 64 + (idx >> 3)) * 64 + (idx & 7) * 8); }
#pragma unroll
    for (int j = 0; j < 4; ++j) { const int idx = lt + 256 * j, t = idx >> 4, c16 = idx & 15; const size_t o = (size_t)(row0 + t) * 512 + hd * 128 + c16 * 8; R.q[j] = *(const v4u*)(QIG + o); R.k[j] = *(const v4u*)(KIG + o); }
    R.x = *(const v4u*)(QKVG + (size_t)(row0 + (lt >> 2)) * 3072 + 1024 + hd * 256 + 32 * es + (lt & 3) * 8);
    if (lt < 32) R.d = *(const v4u*)(DEC + bn * 512 + hd * 128 + lt * 4);
}
__device__ __forceinline__ void seq_put4(const SeqRegs4& R, LAS unsigned char* slot, int lt) {
#pragma unroll
    for (int j = 0; j < 2; ++j) { const int idx = lt + 256 * j; *(LAS v4u*)(slot + SL_P + (idx >> 3) * 144 + (idx & 7) * 16) = R.p[j]; }
#pragma unroll
    for (int j = 0; j < 4; ++j) { const int idx = lt + 256 * j, t = idx >> 4, c16 = idx & 15; *(LAS v4u*)(slot + SL_QI + t * 272 + c16 * 16) = R.q[j]; *(LAS v4u*)(slot + SL_KI + t * 320 + c16 * 16) = R.k[j]; }
    *(LAS v4u*)(slot + SL_V + (lt >> 2) * 64 + (lt & 3) * 16) = R.x;
    if (lt < 32) *(LAS v4u*)(slot + SL_DEC + lt * 16) = R.d;
}
__device__ __forceinline__ void gla_seq_unit(const Args& A, int u, LAS unsigned char* lds, int tid_in, int wave) {
    int tid = tid_in; asm volatile("" : "+v"(tid)); const int lane = tid & 63;
    unsigned char* ws = A.ws; bf16* O = (bf16*)(ws + WS_XB);
    const int b = u >> 5, hd = (u >> 3) & 3, es = u & 7;
    for (int i = tid; i < 8192 / 16; i += 512) *(LAS v4u*)(lds + SEQ_SF + i * 16) = (v4u){0u, 0u, 0u, 0u};
    if (wave >= 4) {
        const int lt = tid - 256;
        SeqRegs4 L0, L1, L2, L3;
        seq_fetch4(L0, ws, b * 64, hd, es, lt); seq_fetch4(L1, ws, b * 64 + 1, hd, es, lt); seq_fetch4(L2, ws, b * 64 + 2, hd, es, lt); seq_fetch4(L3, ws, b * 64 + 3, hd, es, lt);
        seq_put4(L0, lds, lt); seq_fetch4(L0, ws, b * 64 + 4, hd, es, lt);
        __syncthreads();
#define SEQ_LOAD(n, R) do { if ((n) + 1 < 64) { seq_put4(R, lds + (((n) + 1) & 1) * SL_BYTES, lt); if ((n) + 5 < 64) seq_fetch4(R, ws, b * 64 + (n) + 5, hd, es, lt); } __syncthreads(); } while (0)
#pragma unroll 1
        for (int n = 0; n < 64; n += 4) { SEQ_LOAD(n, L1); SEQ_LOAD(n + 1, L2); SEQ_LOAD(n + 2, L3); SEQ_LOAD(n + 3, L0); }
#undef SEQ_LOAD
    } else {
        f32x16 S[2]; S[0] = f32x16{}; S[1] = f32x16{};
        __syncthreads();
#pragma unroll 1
        for (int n = 0; n < 64; ++n) {
            if (wave < 2) seq_out(lds + (n & 1) * SL_BYTES, lds + SEQ_SF + (n & 1) * 8192, O, (b * 64 + n) * 64, hd * 256 + 32 * es, wave, lane);
            else seq_state(S, lds + (n & 1) * SL_BYTES, lds + SEQ_SF + ((n + 1) & 1) * 8192, 2 * (wave - 2), lane);
            __syncthreads();
        }
    }
}

constexpr int AT_KB = 18432, AT_VB = 20480, AT_K0 = 0, AT_V0 = 2 * AT_KB, AT_XO = 2 * AT_KB + 2 * AT_VB;
__device__ __forceinline__ float max3f(float a, float b, float c) { return fmaxf(fmaxf(a, b), c); }
#define VTR(p) __builtin_bit_cast(s16x4, __builtin_amdgcn_ds_read_tr16_b64_v4i16((LAS s16x4*)(p)))
#define MFMA_PV(a, b, c) MFMA_BF16(a, b, c)
#define EXP2F(x) __builtin_amdgcn_exp2f(x)
#define VFRAG(lo, hi) ((bf16x8){lo[0], lo[1], lo[2], lo[3], hi[0], hi[1], hi[2], hi[3]})
#define AT_EXP8(P, B, W) do { const float e0 = EXP2F(P[B]), e1 = EXP2F(P[B + 1]), e2 = EXP2F(P[B + 2]), e3 = EXP2F(P[B + 3]), e4 = EXP2F(P[B + 4]), e5 = EXP2F(P[B + 5]), e6 = EXP2F(P[B + 6]), e7 = EXP2F(P[B + 7]); \
        W.x = cvtpk(e0, e1); W.y = cvtpk(e2, e3); W.z = cvtpk(e4, e5); W.w = cvtpk(e6, e7); ra += (e0 + e1) + (e4 + e5); rb += (e2 + e3) + (e6 + e7); } while (0)
__device__ __forceinline__ void glds16_asm(const void* gsrc, unsigned lds_dst) { unsigned keep;
    asm volatile("s_mov_b32 %0, m0\n\ts_mov_b32 m0, %2\n\ts_nop 0\n\tglobal_load_lds_dwordx4 %1, off\n\ts_mov_b32 m0, %0" : "=&s"(keep) : "v"(gsrc), "s"(lds_dst) : "memory"); }
__device__ __forceinline__ void glds16_so(const void* sbase, unsigned voff, unsigned lds_dst) { unsigned keep;
    asm volatile("s_mov_b32 %0, m0\n\ts_mov_b32 m0, %3\n\ts_nop 0\n\tglobal_load_lds_dwordx4 %1, %2\n\ts_mov_b32 m0, %0" : "=&s"(keep) : "v"(voff), "s"(sbase), "s"(lds_dst) : "memory"); }
constexpr int A5_K0 = 0, A5_V0 = 3 * AT_KB;
__device__ __forceinline__ void attn5_tile(LAS unsigned char* vp, LAS unsigned char* kpn  , bool has_next, bf16x8 (&kf)[8], const bf16x8 (&qf)[4], f32x16 (&o)[4], float& m, float& l, f32x16& nmv  ,
                                           int key0, int qrow, int h, bool need_mask, bool first) {
    s16x4 la[4], ha[4], lb[4], hb[4];
#pragma unroll
    for (int eb = 0; eb < 4; ++eb) { la[eb] = VTR(vp + eb * 64); ha[eb] = VTR(vp + 8 * 320 + eb * 64); }
#pragma unroll
    for (int eb = 0; eb < 4; ++eb) { lb[eb] = VTR(vp + 16 * 320 + eb * 64); hb[eb] = VTR(vp + 16 * 320 + 8 * 320 + eb * 64); }
    __builtin_amdgcn_sched_barrier(0);
    f32x16 p0, p1;
    asm volatile("v_mfma_f32_32x32x16_bf16 %0, %2, %3, %4\n\tv_mfma_f32_32x32x16_bf16 %1, %5, %3, %4" : "=&v"(p0), "=&v"(p1) : "v"(kf[0]), "v"(qf[0]), "v"(nmv), "v"(kf[1]));
#pragma unroll
    for (int s = 1; s < 4; ++s) { p0 = MFMA_BF16(kf[2 * s], qf[s], p0); p1 = MFMA_BF16(kf[2 * s + 1], qf[s], p1); }
    if (need_mask) {
#pragma unroll
        for (int i = 0; i < 16; ++i) { const int key = key0 + (i & 3) + 8 * (i >> 2) + 4 * h; if (key > qrow) p0[i] = -INFINITY; if (key + 32 > qrow) p1[i] = -INFINITY; }
    }
    float ma = max3f(p0[0], p0[1], p1[0]), mb = max3f(p0[2], p0[3], p1[1]), mc = max3f(p0[4], p0[5], p1[2]), md = max3f(p0[6], p0[7], p1[3]);
    ma = max3f(ma, p0[8], p0[9]); mb = max3f(mb, p0[10], p0[11]); mc = max3f(mc, p0[12], p0[13]); md = max3f(md, p0[14], p0[15]);
    ma = max3f(ma, p1[4], p1[5]); mb = max3f(mb, p1[6], p1[7]); mc = max3f(mc, p1[8], p1[9]); md = max3f(md, p1[10], p1[11]);
    ma = max3f(ma, p1[12], p1[13]); mb = max3f(mb, p1[14], p1[15]);
    float mx = fmaxf(fmaxf(ma, mb), fmaxf(mc, md));
    { auto rr = __builtin_amdgcn_permlane32_swap(__builtin_bit_cast(unsigned, mx), __builtin_bit_cast(unsigned, mx), false, false); mx = fmaxf(__builtin_bit_cast(float, rr[0]), __builtin_bit_cast(float, rr[1])); }
    if (first || __any(mx > 8.0f)) {
        const float dl = first ? mx : fmaxf(mx, 0.f); m += dl;
#pragma unroll
        for (int i = 0; i < 16; ++i) { p0[i] -= dl; p1[i] -= dl; nmv[i] = -m; }
        if (!first) { const float al = __builtin_amdgcn_exp2f(-dl); l *= al;
#pragma unroll
            for (int eb = 0; eb < 4; ++eb) o[eb] *= al; }
    }
    float ra = 0.f, rb = 0.f; v4u w0, w1;
    AT_EXP8(p0, 0, w0);
    __builtin_amdgcn_sched_barrier(0);
    { const bf16x8 pf = __builtin_bit_cast(bf16x8, w0);
#pragma unroll
      for (int eb = 0; eb < 4; ++eb) o[eb] = MFMA_PV(VFRAG(la[eb], ha[eb]), pf, o[eb]); }
    AT_EXP8(p0, 8, w1);
    __builtin_amdgcn_sched_barrier(0);
#pragma unroll
    for (int eb = 0; eb < 4; ++eb) { la[eb] = VTR(vp + 32 * 320 + eb * 64); ha[eb] = VTR(vp + 32 * 320 + 8 * 320 + eb * 64); }
    __builtin_amdgcn_sched_barrier(0);
    { const bf16x8 pf = __builtin_bit_cast(bf16x8, w1);
#pragma unroll
      for (int eb = 0; eb < 4; ++eb) o[eb] = MFMA_PV(VFRAG(lb[eb], hb[eb]), pf, o[eb]); }
    AT_EXP8(p1, 0, w0);
    __builtin_amdgcn_sched_barrier(0);
#pragma unroll
    for (int eb = 0; eb < 4; ++eb) { lb[eb] = VTR(vp + 48 * 320 + eb * 64); hb[eb] = VTR(vp + 48 * 320 + 8 * 320 + eb * 64); }
    if (has_next) {
#pragma unroll
        for (int s = 0; s < 4; ++s) { kf[2 * s] = *(const LAS bf16x8*)(kpn + s * 32); kf[2 * s + 1] = *(const LAS bf16x8*)(kpn + 32 * 144 + s * 32); }
    }
    __builtin_amdgcn_sched_barrier(0);
    { const bf16x8 pf = __builtin_bit_cast(bf16x8, w0);
#pragma unroll
      for (int eb = 0; eb < 4; ++eb) o[eb] = MFMA_PV(VFRAG(la[eb], ha[eb]), pf, o[eb]); }
    AT_EXP8(p1, 8, w1);
    __builtin_amdgcn_sched_barrier(0);
    { const bf16x8 pf = __builtin_bit_cast(bf16x8, w1);
#pragma unroll
      for (int eb = 0; eb < 4; ++eb) o[eb] = MFMA_PV(VFRAG(lb[eb], hb[eb]), pf, o[eb]); }
    l += ra + rb;
}
__device__ __forceinline__ void attn8_step(LAS unsigned char* vp, LAS unsigned char* kpn2  , bool has_next, bool has_next2, bf16x8 (&kf)[8], const bf16x8 (&qf)[4], f32x16 (&o)[4], float& m, float& l,
                                           f32x16& p0, f32x16& p1, f32x16& n0, f32x16& n1, int key0, int qrow, int h, bool need_mask, bool first) {
    s16x4 la[4], ha[4], lb[4], hb[4];
#pragma unroll
    for (int eb = 0; eb < 4; ++eb) { la[eb] = VTR(vp + eb * 64); ha[eb] = VTR(vp + 8 * 320 + eb * 64); }
#pragma unroll
    for (int eb = 0; eb < 4; ++eb) { lb[eb] = VTR(vp + 16 * 320 + eb * 64); hb[eb] = VTR(vp + 16 * 320 + 8 * 320 + eb * 64); }
    __builtin_amdgcn_sched_barrier(0);
    { const float nm = -m;
#pragma unroll
        for (int i = 0; i < 16; ++i) { n0[i] = nm; n1[i] = nm; }
#pragma unroll
        for (int s = 0; s < 4; ++s) { n0 = MFMA_BF16(kf[2 * s], qf[s], n0); n1 = MFMA_BF16(kf[2 * s + 1], qf[s], n1); } }
    __builtin_amdgcn_sched_barrier(0);
    if (need_mask) {
#pragma unroll
        for (int i = 0; i < 16; ++i) { const int key = key0 + (i & 3) + 8 * (i >> 2) + 4 * h; if (key > qrow) p0[i] = -INFINITY; if (key + 32 > qrow) p1[i] = -INFINITY; }
    }
    float ma = max3f(p0[0], p0[1], p1[0]), mb = max3f(p0[2], p0[3], p1[1]), mc = max3f(p0[4], p0[5], p1[2]), md = max3f(p0[6], p0[7], p1[3]);
    ma = max3f(ma, p0[8], p0[9]); mb = max3f(mb, p0[10], p0[11]); mc = max3f(mc, p0[12], p0[13]); md = max3f(md, p0[14], p0[15]);
    ma = max3f(ma, p1[4], p1[5]); mb = max3f(mb, p1[6], p1[7]); mc = max3f(mc, p1[8], p1[9]); md = max3f(md, p1[10], p1[11]);
    ma = max3f(ma, p1[12], p1[13]); mb = max3f(mb, p1[14], p1[15]);
    float mx = fmaxf(fmaxf(ma, mb), fmaxf(mc, md));
    { auto rr = __builtin_amdgcn_permlane32_swap(__builtin_bit_cast(unsigned, mx), __builtin_bit_cast(unsigned, mx), false, false); mx = fmaxf(__builtin_bit_cast(float, rr[0]), __builtin_bit_cast(float, rr[1])); }
    if (first || __any(mx > 8.0f)) {
        const float dl = first ? mx : fmaxf(mx, 0.f); m += dl;
#pragma unroll
        for (int i = 0; i < 16; ++i) { p0[i] -= dl; p1[i] -= dl; }
#pragma unroll
        for (int i = 0; i < 16; ++i) { n0[i] -= dl; n1[i] -= dl; }
        if (!first) { const float al = __builtin_amdgcn_exp2f(-dl); l *= al;
#pragma unroll
            for (int eb = 0; eb < 4; ++eb) o[eb] *= al; }
    }
    float ra = 0.f, rb = 0.f; v4u w0, w1;
    AT_EXP8(p0, 0, w0);
    __builtin_amdgcn_sched_barrier(0);
    { const bf16x8 pf = __builtin_bit_cast(bf16x8, w0);
#pragma unroll
      for (int eb = 0; eb < 4; ++eb) o[eb] = MFMA_PV(VFRAG(la[eb], ha[eb]), pf, o[eb]); }
    AT_EXP8(p0, 8, w1);
    __builtin_amdgcn_sched_barrier(0);
#pragma unroll
    for (int eb = 0; eb < 4; ++eb) { la[eb] = VTR(vp + 32 * 320 + eb * 64); ha[eb] = VTR(vp + 32 * 320 + 8 * 320 + eb * 64); }
    __builtin_amdgcn_sched_barrier(0);
    { const bf16x8 pf = __builtin_bit_cast(bf16x8, w1);
#pragma unroll
      for (int eb = 0; eb < 4; ++eb) o[eb] = MFMA_PV(VFRAG(lb[eb], hb[eb]), pf, o[eb]); }
    AT_EXP8(p1, 0, w0);
    __builtin_amdgcn_sched_barrier(0);
#pragma unroll
    for (int eb = 0; eb < 4; ++eb) { lb[eb] = VTR(vp + 48 * 320 + eb * 64); hb[eb] = VTR(vp + 48 * 320 + 8 * 320 + eb * 64); }
    {
#pragma unroll
        for (int s = 0; s < 4; ++s) { kf[2 * s] = *(const LAS bf16x8*)(kpn2 + s * 32); kf[2 * s + 1] = *(const LAS bf16x8*)(kpn2 + 32 * 144 + s * 32); }
    }
    __builtin_amdgcn_sched_barrier(0);
    { const bf16x8 pf = __builtin_bit_cast(bf16x8, w0);
#pragma unroll
      for (int eb = 0; eb < 4; ++eb) o[eb] = MFMA_PV(VFRAG(la[eb], ha[eb]), pf, o[eb]); }
    AT_EXP8(p1, 8, w1);
    __builtin_amdgcn_sched_barrier(0);
    { const bf16x8 pf = __builtin_bit_cast(bf16x8, w1);
#pragma unroll
      for (int eb = 0; eb < 4; ++eb) o[eb] = MFMA_PV(VFRAG(lb[eb], hb[eb]), pf, o[eb]); }
    l += ra + rb;
}
__device__ __forceinline__ unsigned a8_koff(int cc, int i, int lane) { const int t = i + lane, r = (t * 57) >> 9, cq = t - 9 * r; return (unsigned)((cc * 4096 * 64 + (7 * i + r) * 64 + (cq > 7 ? 7 : cq) * 8) * 2); }
__device__ __forceinline__ unsigned a8_voff(int i, int lane) { const int t = 4 * i + lane, r = (t * 205) >> 12, cq = t - 20 * r; return (unsigned)(((3 * i + r) * 128 + (cq > 15 ? 15 : cq) * 8) * 2); }
__device__ __forceinline__ void a8_dma_k(const bf16* kt, unsigned ldsK, int wave, int lane) {
#pragma unroll
    for (int ii = 0; ii < 3; ++ii) { const int g = wave + 8 * ii; if (g < 18) { const int cc = g >= 9 ? 1 : 0, i = g - 9 * cc;
        glds16_so(kt, a8_koff(cc, i, lane), (unsigned)__builtin_amdgcn_readfirstlane((int)(ldsK + cc * 9216 + i * 1024))); } }
}
__device__ __forceinline__ void a8_dma_v(const bf16* vt, unsigned ldsV, int wave, int lane) {
#pragma unroll
    for (int ii = 2; ii < 5; ++ii) { const int g = wave + 8 * ii; if (g >= 18) { const int i = g < 38 ? g - 18 : g - 38;
        glds16_so(vt, a8_voff(i, lane), (unsigned)__builtin_amdgcn_readfirstlane((int)(ldsV + i * 1024))); } }
}
__device__ __forceinline__ void attn_unit(const Args& A, int b, int hh, int qb, float lam, LAS unsigned char* lds, int tid_in, int wave, int lane_in) {
    int tid = tid_in; asm volatile("" : "+v"(tid));
    const int lane = tid & 63; (void)lane_in;
    unsigned char* ws = A.ws;
    const bf16* KR = (const bf16*)(ws + WS_KR); const bf16* VR = (const bf16*)(ws + WS_VR); const bf16* QR = (const bf16*)(ws + WS_QR); bf16* AO = (bf16*)(ws + WS_AO);
    const int cl = lane & 31, h = lane >> 5, c = wave >> 2, qg = wave & 3;
    const int q0 = qb * 128, NT = 2 * (qb + 1), qrow = q0 + 32 * qg + cl, qmax = q0 + 32 * qg + 31, qmin = q0 + 32 * qg;
    bf16x8 qf[4];
    { const bf16* qp = QR + ((size_t)((b * 8 + hh) * 2 + c) * 4096 + qrow) * 64 + 8 * h;
#pragma unroll
        for (int s = 0; s < 4; ++s) qf[s] = *(const bf16x8*)(qp + 16 * s); }
    f32x16 o[4]; o[0] = f32x16{}; o[1] = f32x16{}; o[2] = f32x16{}; o[3] = f32x16{};
    float m = 0.f, l = 0.f;
    constexpr int A7_K0 = 0, A7_V0 = 4 * AT_KB;
    const bf16* const kbase = KR + (size_t)((b * 8 + hh) * 2) * 4096 * 64; const bf16* const vbase = VR + (size_t)(b * 8 + hh) * 4096 * 128;
    const unsigned lds0 = (unsigned)(uintptr_t)lds;
#define A7_DMA_K(t, slot) a8_dma_k(kbase + (size_t)(t) * 64 * 64, lds0 + A7_K0 + (slot) * AT_KB, wave, lane)
#define A7_DMA_V(t, slot) a8_dma_v(vbase + (size_t)(t) * 64 * 128, lds0 + A7_V0 + (slot) * AT_VB, wave, lane)
    LAS unsigned char* const vtr = lds + A7_V0 + (4 * h + ((lane & 15) >> 2)) * 320 + (16 * ((lane >> 4) & 1) + 4 * (lane & 3)) * 2;
    LAS unsigned char* const kfr = lds + A7_K0 + c * 9216 + cl * 144 + 16 * h;
    A7_DMA_K(0, 0); A7_DMA_V(0, 0); A7_DMA_K(1, 1); A7_DMA_V(1, 1);
    if (NT > 2) A7_DMA_K(2, 2);
    asm volatile("s_waitcnt vmcnt(0)" ::: "memory"); __syncthreads();
    asm volatile("" : "+v"(qf[0]), "+v"(qf[1]), "+v"(qf[2]), "+v"(qf[3]));
    bf16x8 kf[8];
#pragma unroll
    for (int s = 0; s < 4; ++s) { kf[2 * s] = *(const LAS bf16x8*)(kfr + s * 32); kf[2 * s + 1] = *(const LAS bf16x8*)(kfr + 32 * 144 + s * 32); }
    f32x16 nmv = {};
    int kv = 0, kv1 = 1, kv2 = 2, kk1 = 1, kk3 = 3;
#pragma unroll 1
    for (int j = 0; j < NT; ++j) {
        if (j + 3 < NT) A7_DMA_K(j + 3, kk3);
        if (j + 2 < NT) A7_DMA_V(j + 2, kv2);
        const bool act_ = (64 * j <= qmax);
        if (act_) attn5_tile(vtr + kv * AT_VB, kfr + kk1 * AT_KB, j + 1 < NT, kf, qf, o, m, l, nmv, 64 * j, qrow, h, 64 * j + 63 > qmin, j == 0);
        if (j + 3 < NT) asm volatile("s_waitcnt vmcnt(5) lgkmcnt(0)\n\ts_barrier" ::: "memory"); else asm volatile("s_waitcnt vmcnt(0) lgkmcnt(0)\n\ts_barrier" ::: "memory");
        kv = kv1; kv1 = kv2; kv2 = (kv2 == 2) ? 0 : kv2 + 1; kk1 = (kk1 + 1) & 3; kk3 = (kk3 + 1) & 3;
    }
    __syncthreads();
    int tid2 = tid; asm volatile("" : "+v"(tid2));
    const int bp32 = ((tid2 & 63) ^ 32) << 2;
    l += __builtin_bit_cast(float, __builtin_amdgcn_ds_bpermute(bp32, __builtin_bit_cast(int, l)));
    const float inv = __builtin_amdgcn_rcpf(l);
    {
    const int lane2 = tid2 & 63, cl = lane2 & 31, h = lane2 >> 5, wave2 = __builtin_amdgcn_readfirstlane(tid2 >> 6), c = wave2 >> 2, qg = wave2 & 3, qrow = q0 + 32 * qg + cl;
    LAS float* XO = (LAS float*)(lds) + qg * 4096;
    if (c == 1) {
        const float f = inv * lam;
#pragma unroll
        for (int eb = 0; eb < 4; ++eb)
#pragma unroll
            for (int i = 0; i < 16; ++i) { const int e = 32 * eb + (i & 3) + 8 * (i >> 2) + 4 * h; XO[e * 32 + cl] = o[eb][i] * f; }
    }
    __syncthreads();
    if (c == 0) {
        float ss = 0.f;
#pragma unroll
        for (int eb = 0; eb < 4; ++eb)
#pragma unroll
            for (int i = 0; i < 16; ++i) { const int e = 32 * eb + (i & 3) + 8 * (i >> 2) + 4 * h; const float v = o[eb][i] * inv - XO[e * 32 + cl]; o[eb][i] = v; ss += v * v; }
        ss += __builtin_bit_cast(float, __builtin_amdgcn_ds_bpermute(bp32, __builtin_bit_cast(int, ss)));
        const float rstd = (1.0f - LAM_INIT) * __builtin_amdgcn_rsqf(ss * (1.0f / 128.0f) + EPS);
        LAS unsigned char* ob = lds + qg * 16384 + cl * 272;
        f32x4 w4[4][4];
#pragma unroll
        for (int eb = 0; eb < 4; ++eb)
#pragma unroll
            for (int g = 0; g < 4; ++g) w4[eb][g] = *(const f32x4*)(A.in[I_SUBLN] + 32 * eb + 8 * g + 4 * h);
#pragma unroll
        for (int eb = 0; eb < 4; ++eb)
#pragma unroll
            for (int g = 0; g < 4; ++g) { const int e0 = 32 * eb + 8 * g + 4 * h;
                v2u w; w.x = cvtpk(o[eb][4 * g] * rstd * w4[eb][g][0], o[eb][4 * g + 1] * rstd * w4[eb][g][1]); w.y = cvtpk(o[eb][4 * g + 2] * rstd * w4[eb][g][2], o[eb][4 * g + 3] * rstd * w4[eb][g][3]);
                *(LAS v2u*)(ob + e0 * 2) = w; }
    }
    __syncthreads();
    { bf16* ob0 = AO + (size_t)(b * 4096 + q0) * DM + hh * 128;
      v4u t[4];
#pragma unroll
      for (int it = 0; it < 4; ++it) { const int row = 16 * wave2 + 4 * it + (lane2 >> 4); t[it] = *(const LAS v4u*)(lds + (row >> 5) * 16384 + (row & 31) * 272 + (lane2 & 15) * 16); }
#pragma unroll
      for (int it = 0; it < 4; ++it) { const int row = 16 * wave2 + 4 * it + (lane2 >> 4); *(v4u*)(ob0 + (size_t)row * DM + (lane2 & 15) * 8) = t[it]; } }
    }
    __syncthreads();
#undef A7_DMA_K
#undef A7_DMA_V
}

constexpr int NPH = 16;
__global__ void __launch_bounds__(NWAVES * 64, 2) yoco_fwd(Args args) {
    extern __shared__ __attribute__((aligned(16))) unsigned char lds_raw[];
    LAS unsigned char* lds = (LAS unsigned char*)lds_raw;
#define FRESH() int tid = threadIdx.x; asm volatile("" : "+v"(tid)); const int lane = tid & 63, wave = __builtin_amdgcn_readfirstlane(tid >> 6); (void)lane; (void)wave
    const int G = gridDim.x; const int bx = blockIdx.x; const int vcu = (G % 8 == 0) ? (bx % 8) * (G / 8) + bx / 8 : bx;
    unsigned char* ws = args.ws;
    for (int u = threadIdx.x; u < (LDS_BYTES - LDSCTL_OFF) / 4; u += NWAVES * 64) ((LAS unsigned*)(lds + LDSCTL_OFF))[u] = 0u;
    __syncthreads();
#if !MK_PER_PHASE
    XcdBarrier bar = xcd_barrier_post((unsigned*)(ws + WS_CTL) + CW_BAR, (volatile LAS unsigned*)(lds + MISC_OFF) + 8);
#define GRID_BAR() xcd_barrier(bar)
#else
#define GRID_BAR() do {} while (0)
#endif
    const int lo = args.ph_lo, hi = args.ph_hi;
#define IN(k) (lo <= (k) && (k) < hi)
#define SEAM(k) do { if (IN((k) + 1)) GRID_BAR(); } while (0)
    float* H = args.out;
    const float* PS = (const float*)(ws + WS_PS);
    if (IN(0)) { FRESH(); { p0_prologue(args, lds, vcu, G, wave, lane, tid); } SEAM(0); }
    if (IN(1)) { FRESH(); {
        pg8::Gemm g{(const bf16*)(ws + WS_XB), (const bf16*)(ws + WS_W1T), T, 3072, DM}; pg8::StaticOrder S; S.init(T, 3072, G, bx);
        pg8::EpiScaleBf16 E{(bf16*)(ws + WS_QKVG), 3072, (const float*)(ws + WS_RSTD), nullptr, 0};
        pg8::gemm_phase<pg8::EpiScaleBf16, pg8::StaticOrder, true, true>(lds, g, S, E); } SEAM(1);
    }
    if (IN(2)) { FRESH(); {
        if (bx & 1) __builtin_amdgcn_s_sleep(127);
        for (int bn = vcu; bn < NBN; bn += G) gla_pre_unit(args, bn, lds, tid, wave); } SEAM(2); }
    if (IN(3)) { FRESH(); { for (int u = vcu; u < 256; u += G) gla_seq_unit(args, u, lds, tid, wave); } SEAM(3); }
    if (IN(4)) { FRESH(); { gla_gate_phase((const bf16*)(ws + WS_XB), (const bf16*)(ws + WS_QKVG), args.in[I_ONORM], (bf16*)(ws + WS_OGATE), vcu, G, wave, lane); } SEAM(4); }
    if (IN(5)) { FRESH(); {
        pg8::Gemm g{(const bf16*)(ws + WS_OGATE), (const bf16*)(ws + WS_WO1T), T, DM, DM}; pg8::StaticOrder S; S.init(T, DM, G, bx);
        pg8::EpiResBf16 E{args.in[I_X], nullptr, (bf16*)(ws + WS_XB), DM, (float*)(ws + WS_PS), (bf16*)(ws + WS_AH)};
        pg8::gemm_phase<pg8::EpiResBf16, pg8::StaticOrder, true, true>(lds, g, S, E); } SEAM(5);
    }
#pragma unroll
    for (int layer = 0; layer < 2; ++layer) {
        const int pb = layer == 0 ? 6 : 12;
        const bf16* WIN = (const bf16*)(ws + (layer == 0 ? WS_WIN0T : WS_WIN1T)); const bf16* WOUT = (const bf16*)(ws + (layer == 0 ? WS_WOUT0T : WS_WOUT1T));
        const float* cw = args.in[I_CONVW] + (size_t)layer * 3 * 2 * DFF; const float* cb = args.in[I_CONVB] + (size_t)layer * 2 * DFF;
        if (IN(pb)) { FRESH(); {
            pg8::Gemm g{(const bf16*)(ws + WS_AH), WIN, 1024, 2 * DFF, DM}; pg8::StaticOrder S; S.init(1024, 2 * DFF, G, bx);
            pg8::EpiScaleBf16 E{(bf16*)(ws + WS_UH), 2 * DFF, nullptr, PS, 1};
            pg8::gemm_phase<pg8::EpiScaleBf16, pg8::StaticOrder, true, true>(lds, g, S, E);
            { const int nidle = G > 88 ? G - 88 : G, me = G > 88 ? bx - 88 : bx;
              if (me >= 0) for (int r = me * (NWAVES * 64) + tid; r < T; r += nidle * NWAVES * 64) ((float*)(ws + WS_RSTD))[r] = pg8::rstd_ps(PS, r); } } SEAM(pb);
        }
        if (IN(pb + 1)) { FRESH(); {
            pg8::Gemm g{(const bf16*)(ws + WS_XB), WIN, T, 2 * DFF, DM}; pg8::StaticOrder S; S.init(T, 2 * DFF, G, bx);
            pg8::EpiConvGate E{(bf16*)(ws + WS_ACT), (const bf16*)(ws + WS_UH), (const float*)(ws + WS_RSTD), cw, cb};
            pg8::gemm_phase<pg8::EpiConvGate, pg8::StaticOrder, true, true>(lds, g, S, E); } SEAM(pb + 1);
        }
        if (IN(pb + 2)) { FRESH(); {
            pg8::Gemm g{(const bf16*)(ws + WS_ACT), WOUT, T, DM, DFF}; pg8::StaticOrder S; S.init(T, DM, G, bx);
            pg8::EpiResBf16 E{nullptr, (const bf16*)(ws + WS_XB), (bf16*)(ws + WS_XB), DM, (float*)(ws + WS_PS), layer == 0 ? (bf16*)(ws + WS_AH) : (bf16*)nullptr};
            pg8::gemm_phase<pg8::EpiResBf16, pg8::StaticOrder, true, true>(lds, g, S, E); } SEAM(pb + 2);
        }
        if (layer == 0) {
            if (IN(9)) { FRESH(); {
                pg8::Gemm g{(const bf16*)(ws + WS_XB), (const bf16*)(ws + WS_WKVQT), T, 3072, DM}; pg8::StaticOrder S; S.init(T, 3072, G, bx);
                pg8::EpiRope E{(bf16*)(ws + WS_KR), (bf16*)(ws + WS_VR), (bf16*)(ws + WS_QR), PS, (const float*)(ws + WS_COS), (const float*)(ws + WS_SIN)};
                pg8::gemm_phase<pg8::EpiRope, pg8::StaticOrder, true, true>(lds, g, S, E); } SEAM(9);
            }
            if (IN(10)) { FRESH(); {
                const float* lp = args.in[I_LAMBDA];
                const float sa = wave_sum(lp[lane] * lp[64 + lane]), sb = wave_sum(lp[128 + lane] * lp[192 + lane]);
                const float lam = __builtin_bit_cast(float, __builtin_amdgcn_readfirstlane(__builtin_bit_cast(int, expf(sa) - expf(sb) + LAM_INIT)));
                const int xg = vcu >> 5, cu = vcu & 31, kq = cu & 15;
                if (G == 256) {
#pragma unroll 1
                    for (int i = 0; i < 8; ++i) { const int pr = xg * 8 + 2 * (i >> 1) + (cu >> 4); const int qb = (i & 1) ? 31 - kq : kq; attn_unit(args, pr >> 3, pr & 7, qb, lam, lds, tid, wave, lane); }
                } else {
#pragma unroll 1
                    for (int it = vcu; it < 1024; it += G) {
#pragma unroll 1
                        for (int i = 0; i < 2; ++i) { const int pr = it >> 4, k2 = it & 15; attn_unit(args, pr >> 3, pr & 7, i ? 31 - k2 : k2, lam, lds, tid, wave, lane); } }
                } }
                SEAM(10);
            }
            if (IN(11)) { FRESH(); {
                pg8::Gemm g{(const bf16*)(ws + WS_AO), (const bf16*)(ws + WS_WO2T), T, DM, DM}; pg8::StaticOrder S; S.init(T, DM, G, bx);
                pg8::EpiResBf16 E{nullptr, (const bf16*)(ws + WS_XB), (bf16*)(ws + WS_XB), DM, (float*)(ws + WS_PS), (bf16*)(ws + WS_AH)};
                pg8::gemm_phase<pg8::EpiResBf16, pg8::StaticOrder, true, true>(lds, g, S, E); } SEAM(11);
            }
        }
    }
    if (IN(15)) { FRESH(); { final_norm_phase((const bf16*)(ws + WS_XB), PS, H, args.in[I_FINAL], vcu, G, wave, lane); } }
#undef IN
#undef SEAM
}

extern "C" void kernel_launch(void* const* d_in, const int* in_sizes, int n_in, void* d_out, int out_size, void* d_ws, size_t ws_size, hipStream_t stream) {
    static int grid = 0;
    if (grid == 0) {
        if (n_in != 20 || out_size != T * DM || ws_size < WS_END) { fprintf(stderr, "kernel_launch: unexpected shapes (n_in %d out %d ws %zu)\n", n_in, out_size, ws_size); grid = -1; return; }
        int dev = 0, cus = 0;
        if (hipGetDevice(&dev) != hipSuccess || hipDeviceGetAttribute(&cus, hipDeviceAttributeMultiprocessorCount, dev) != hipSuccess) { grid = -1; return; }
        if (hipFuncSetAttribute((const void*)yoco_fwd, hipFuncAttributeMaxDynamicSharedMemorySize, LDS_BYTES) != hipSuccess) { grid = -1; return; }
        int per_cu = 0; (void)hipOccupancyMaxActiveBlocksPerMultiprocessor(&per_cu, (const void*)yoco_fwd, NWAVES * 64, LDS_BYTES); (void)hipGetLastError();
        grid = cus;
    }
    if (grid < 0) return;
    if (hipMemsetAsync((char*)d_ws + WS_CTL, 0, CTL_ZERO_BYTES, stream) != hipSuccess) return;
    Args a{};
    for (int i = 0; i < 20; ++i) a.in[i] = (const float*)d_in[i];
    a.out = (float*)d_out; a.ws = (unsigned char*)d_ws;
#if MK_PER_PHASE
    for (int ph = 0; ph < NPH; ++ph) { a.ph_lo = ph; a.ph_hi = ph + 1; hipLaunchKernelGGL(yoco_fwd, dim3(grid), dim3(NWAVES * 64), LDS_BYTES, stream, a); }
#else
    a.ph_lo = 0; a.ph_hi = NPH; hipLaunchKernelGGL(yoco_fwd, dim3(grid), dim3(NWAVES * 64), LDS_BYTES, stream, a);
#endif
}
```

```cpp
#ifndef MK_PER_PHASE
#define MK_PER_PHASE 0
#endif
#include <hip/hip_runtime.h>
#include <cstdio>
#include <cstdint>
namespace pg8 {
#define PG8_LAS __attribute__((address_space(3)))
typedef unsigned short bf16_t;
typedef short bf16x8 __attribute__((ext_vector_type(8)));
typedef float f32x4 __attribute__((ext_vector_type(4)));
typedef unsigned u32x4 __attribute__((ext_vector_type(4)));
constexpr int BM = 256, BK = 64, HALF = 128, HTB = HALF * BK * 2  , STAGE_BYTES = 8 * HTB, NXCD = 8, WGM = 8;

__host__ __device__ __forceinline__ int lds_byte(int r, int c) { const int st = (r >> 4) * 2 + (c >> 5), rr = r & 15, cc = c & 31, ob = rr * 64 + cc * 2; return st * 1024 + (ob ^ (((ob >> 9) & 1) << 5)); }
__host__ __device__ __forceinline__ void stage_rc(int b, int& R, int& C) { const int st = b / 1024, sb = b % 1024, swz = sb ^ (((sb >> 9) & 1) << 5); R = (st >> 1) * 16 + swz / 64; C = (st & 1) * 32 + (swz % 64) / 2; }
__host__ __device__ __forceinline__ int perm32(int rho) { const int n = rho >> 4, i = rho & 15; return 8 * (i >> 2) + 4 * n + (i & 3); }

struct Unit { int pm, pn; };
struct Gemm { const bf16_t* A; const bf16_t* Bt; int M, N, K; };

struct StaticOrder {
    int nM, nN, nwg, G, c;
    __host__ __device__ void init(int M, int N, int G_, int c_) { nM = M / BM; nN = N / BM; nwg = nM * nN; G = G_; c = c_; }
    __host__ __device__ bool next(int i, Unit& u) const {
        const long L = (long)i * G + c; if (L >= nwg) return false;
        int wgid = (int)L; { const int q = nwg / NXCD, r = nwg % NXCD, xcd = wgid % NXCD, off = wgid / NXCD; wgid = (xcd < r ? xcd * (q + 1) : r * (q + 1) + (xcd - r) * q) + off; }
        const int nig = WGM * nN, gid = wgid / nig, fm = gid * WGM, gsz = (nM - fm) < WGM ? (nM - fm) : WGM;
        u.pm = fm + ((wgid % nig) % gsz); u.pn = (wgid % nig) / gsz; return true;
    }
    __device__ __forceinline__ void a_ready(const Unit&) const {}
    __device__ __forceinline__ void done(const Unit&) const {}
};

__device__ __forceinline__ unsigned cvt_pk_bf16(float lo, float hi) { unsigned r; asm volatile("v_cvt_pk_bf16_f32 %0, %1, %2" : "=v"(r) : "v"(lo), "v"(hi)); return r; }
typedef float f32x2 __attribute__((ext_vector_type(2)));
__device__ __forceinline__ float rstd_ps(const float* ps, int row) {
    const f32x4* p = (const f32x4*)(ps + (size_t)row * 16); const f32x4 a = p[0], b = p[1], c = p[2], d = p[3];
    const float s = ((a[0] + a[1]) + (a[2] + a[3])) + ((b[0] + b[1]) + (b[2] + b[3])) + ((c[0] + c[1]) + (c[2] + c[3])) + ((d[0] + d[1]) + (d[2] + d[3]));
    return __builtin_amdgcn_rsqf(s * (1.0f / 1024.0f) + 1e-6f);
}
struct EpiScaleBf16 {
    static constexpr bool PERM = true, AFTER_DRAIN = false, APERM = false;
    bf16_t* O; int ldc; const float* rstd; const float* ps; int halo;
    __device__ __forceinline__ void operator()(const f32x4 (&acc)[2][2][4][2], const Unit& u, int wr, int wc, int fr, int fq) const {
        const int row0 = u.pm * BM + wr * 64 + fr, col0 = u.pn * BM + wc * 32 + 8 * fq;
        float sc[2][4];
#pragma unroll
        for (int ai = 0; ai < 2; ++ai)
#pragma unroll
            for (int m = 0; m < 4; ++m) { const int row = row0 + ai * HALF + m * 16;
                if (rstd) sc[ai][m] = rstd[row];
                else if (halo) { const int st = row >> 1; sc[ai][m] = (st & 63) ? rstd_ps(ps, 64 * st - 2 + (row & 1)) : 0.f; } else sc[ai][m] = rstd_ps(ps, row); }
#pragma unroll
        for (int ai = 0; ai < 2; ++ai)
#pragma unroll
            for (int m = 0; m < 4; ++m) { const int row = row0 + ai * HALF + m * 16; const float s = sc[ai][m];
                bf16_t* rowp = O + (size_t)row * ldc + col0;
#pragma unroll
                for (int bj = 0; bj < 2; ++bj) { const f32x4 v0 = acc[ai][bj][m][0] * s, v1 = acc[ai][bj][m][1] * s;
                    u32x4 w; w.x = cvt_pk_bf16(v0[0], v0[1]); w.y = cvt_pk_bf16(v0[2], v0[3]); w.z = cvt_pk_bf16(v1[0], v1[1]); w.w = cvt_pk_bf16(v1[2], v1[3]);
                    *(u32x4*)(rowp + bj * HALF) = w; } }
    }
};
struct EpiResBf16 {
    static constexpr bool PERM = true, AFTER_DRAIN = false, APERM = false;
    const float* base32; const bf16_t* base16; bf16_t* out; int ldc; float* ps; bf16_t* ah;
    __device__ __forceinline__ void operator()(const f32x4 (&acc)[2][2][4][2], const Unit& u, int wr, int wc, int fr, int fq) const {
        const int row0 = u.pm * BM + wr * 64 + fr, col0 = u.pn * BM + wc * 32 + 8 * fq;
#pragma unroll
        for (int ai = 0; ai < 2; ++ai) {
            f32x4 b0[4][2], b1[4][2];
            if (base32) {
#pragma unroll
                for (int m = 0; m < 4; ++m)
#pragma unroll
                    for (int bj = 0; bj < 2; ++bj) { const size_t off = (size_t)(row0 + ai * HALF + m * 16) * ldc + col0 + bj * HALF; b0[m][bj] = *(const f32x4*)(base32 + off); b1[m][bj] = *(const f32x4*)(base32 + off + 4); }
            } else {
                u32x4 r[4][2];
#pragma unroll
                for (int m = 0; m < 4; ++m)
#pragma unroll
                    for (int bj = 0; bj < 2; ++bj) r[m][bj] = *(const u32x4*)(base16 + (size_t)(row0 + ai * HALF + m * 16) * ldc + col0 + bj * HALF);
#pragma unroll
                for (int m = 0; m < 4; ++m)
#pragma unroll
                    for (int bj = 0; bj < 2; ++bj) { const u32x4 q = r[m][bj];
                        b0[m][bj][0] = __builtin_bit_cast(float, q.x << 16); b0[m][bj][1] = __builtin_bit_cast(float, q.x & 0xffff0000u); b0[m][bj][2] = __builtin_bit_cast(float, q.y << 16); b0[m][bj][3] = __builtin_bit_cast(float, q.y & 0xffff0000u);
                        b1[m][bj][0] = __builtin_bit_cast(float, q.z << 16); b1[m][bj][1] = __builtin_bit_cast(float, q.z & 0xffff0000u); b1[m][bj][2] = __builtin_bit_cast(float, q.w << 16); b1[m][bj][3] = __builtin_bit_cast(float, q.w & 0xffff0000u); }
            }
#pragma unroll
            for (int m = 0; m < 4; ++m) { const int row = row0 + ai * HALF + m * 16; const size_t off = (size_t)row * ldc + col0; float ss = 0.f;
                const bool hrow = (m == 3) && (fr >= 14); const int st = ((row >> 6) + 1) & 511; const bool hw = ah && hrow && (st & 63);
                bf16_t* ahp = ah + (size_t)(2 * st + (fr - 14)) * ldc + col0;
#pragma unroll
                for (int bj = 0; bj < 2; ++bj) {
                    const f32x4 v0 = b0[m][bj] + acc[ai][bj][m][0], v1 = b1[m][bj] + acc[ai][bj][m][1];
                    ss += ((v0[0] * v0[0] + v0[1] * v0[1]) + (v0[2] * v0[2] + v0[3] * v0[3])) + ((v1[0] * v1[0] + v1[1] * v1[1]) + (v1[2] * v1[2] + v1[3] * v1[3]));
                    u32x4 w; w.x = cvt_pk_bf16(v0[0], v0[1]); w.y = cvt_pk_bf16(v0[2], v0[3]); w.z = cvt_pk_bf16(v1[0], v1[1]); w.w = cvt_pk_bf16(v1[2], v1[3]);
                    *(u32x4*)(out + off + bj * HALF) = w;
                    if (hw) *(u32x4*)(ahp + bj * HALF) = w; }
                ss += __shfl_xor(ss, 16); ss += __shfl_xor(ss, 32);
                if (fq == 0) ps[(size_t)row * 16 + u.pn * 4 + wc] = ss; }
        }
    }
};
struct EpiRope {
    static constexpr bool PERM = false, AFTER_DRAIN = false, APERM = false;
    bf16_t* KR; bf16_t* VR; bf16_t* QR; const float* ps; const float* cosT; const float* sinT;
    __device__ __forceinline__ void operator()(const f32x4 (&acc)[2][2][4][2], const Unit& u, int wr, int wc, int fr, int fq) const {
        typedef unsigned u32x2v __attribute__((ext_vector_type(2)));
        const int row0 = u.pm * BM + wr * 64 + fr; const int pn = u.pn;
#pragma unroll
        for (int ai = 0; ai < 2; ++ai) {
            float sc[4];
#pragma unroll
            for (int m = 0; m < 4; ++m) sc[m] = rstd_ps(ps, row0 + ai * HALF + m * 16);
            if (pn >= 4 && pn < 8) {
#pragma unroll
                for (int m = 0; m < 4; ++m) { const int row = row0 + ai * HALF + m * 16; const float s = sc[m]; const int b = row >> 12, sq = row & 4095;
#pragma unroll
                    for (int bj = 0; bj < 2; ++bj) { const int head = 2 * (pn - 4) + bj; bf16_t* p = VR + ((size_t)(b * 8 + head) * 4096 + sq) * 128 + 32 * wc + 4 * fq;
#pragma unroll
                        for (int n = 0; n < 2; ++n) { const f32x4 v = acc[ai][bj][m][n] * s; u32x2v w; w.x = cvt_pk_bf16(v[0], v[1]); w.y = cvt_pk_bf16(v[2], v[3]); *(u32x2v*)(p + 16 * n) = w; } } }
            } else {
                bf16_t* dst = pn < 4 ? KR : QR; const int tl = pn < 4 ? pn : pn - 8; const int d0 = 16 * (wc & 1) + 4 * fq;
                f32x4 cs[4], sn[4];
#pragma unroll
                for (int m = 0; m < 4; ++m) { const int sq = (row0 + ai * HALF + m * 16) & 4095; cs[m] = *(const f32x4*)(cosT + sq * 32 + d0); sn[m] = *(const f32x4*)(sinT + sq * 32 + d0); }
#pragma unroll
                for (int m = 0; m < 4; ++m) { const int row = row0 + ai * HALF + m * 16; const float s = sc[m]; const int b = row >> 12, sq = row & 4095;
#pragma unroll
                    for (int bj = 0; bj < 2; ++bj) { const int gc = tl * 4 + 2 * bj + (wc >> 1), head = gc >> 1, c2 = gc & 1;
                        const f32x4 x1 = acc[ai][bj][m][0] * s, x2 = acc[ai][bj][m][1] * s; const f32x4 o1 = x1 * cs[m] - x2 * sn[m], o2 = x2 * cs[m] + x1 * sn[m];
                        bf16_t* p = dst + ((size_t)((b * 8 + head) * 2 + c2) * 4096 + sq) * 64 + d0;
                        u32x2v w1, w2; w1.x = cvt_pk_bf16(o1[0], o1[1]); w1.y = cvt_pk_bf16(o1[2], o1[3]); w2.x = cvt_pk_bf16(o2[0], o2[1]); w2.y = cvt_pk_bf16(o2[2], o2[3]);
                        *(u32x2v*)p = w1; *(u32x2v*)(p + 32) = w2; } }
            }
        }
    }
};

#define DPPF(oldv, src, ctrl) __builtin_bit_cast(float, __builtin_amdgcn_update_dpp(__builtin_bit_cast(int, (float)(oldv)), __builtin_bit_cast(int, (float)(src)), (ctrl), 0xf, 0xf, false))
struct EpiConvGate {
    static constexpr bool PERM = true, AFTER_DRAIN = false;
    bf16_t* ACT; const bf16_t* UH; const float* rstd; const float* cw; const float* cb;
    __device__ __forceinline__ void operator()(const f32x4 (&acc)[2][2][4][2], const Unit& u, int wr, int wc, int fr, int fq) const {
        typedef unsigned u32x2v __attribute__((ext_vector_type(2)));
        const int row0 = u.pm * BM + wr * 64 + fr;
        float rs[2][4];
#pragma unroll
        for (int ai = 0; ai < 2; ++ai)
#pragma unroll
            for (int m = 0; m < 4; ++m) rs[ai][m] = rstd[row0 + ai * HALF + m * 16];
        u32x2v hq[2][2][4];
#pragma unroll
        for (int n = 0; n < 2; ++n)
#pragma unroll
            for (int ai = 0; ai < 2; ++ai) { const bf16_t* hp = UH + (size_t)(2 * (4 * u.pm + 2 * ai + wr)) * 5632 + u.pn * BM + wc * 32 + 8 * fq + 4 * n;
                hq[n][ai][0] = *(const u32x2v*)hp; hq[n][ai][1] = *(const u32x2v*)(hp + 5632); hq[n][ai][2] = *(const u32x2v*)(hp + HALF); hq[n][ai][3] = *(const u32x2v*)(hp + 5632 + HALF); }
#pragma unroll
        for (int n = 0; n < 2; ++n) {
            const int cha = u.pn * 128 + wc * 32 + 8 * fq + 4 * n, chg = 2816 + cha;
            f32x4 wa[3], wg[3];
#pragma unroll
            for (int j = 0; j < 3; ++j) { wa[j] = *(const f32x4*)(cw + j * 5632 + cha); wg[j] = *(const f32x4*)(cw + j * 5632 + chg); }
            const f32x4 ba = *(const f32x4*)(cb + cha), bg = *(const f32x4*)(cb + chg);
#pragma unroll
            for (int ai = 0; ai < 2; ++ai) {
                const u32x2v ha2 = hq[n][ai][0], ha1 = hq[n][ai][1], hg2 = hq[n][ai][2], hg1 = hq[n][ai][3];
                f32x4 pa, pg;
                { f32x4 a1, a2, g1, g2;
                  a1[0] = __builtin_bit_cast(float, ha1.x << 16); a1[1] = __builtin_bit_cast(float, ha1.x & 0xffff0000u); a1[2] = __builtin_bit_cast(float, ha1.y << 16); a1[3] = __builtin_bit_cast(float, ha1.y & 0xffff0000u);
                  a2[0] = __builtin_bit_cast(float, ha2.x << 16); a2[1] = __builtin_bit_cast(float, ha2.x & 0xffff0000u); a2[2] = __builtin_bit_cast(float, ha2.y << 16); a2[3] = __builtin_bit_cast(float, ha2.y & 0xffff0000u);
                  g1[0] = __builtin_bit_cast(float, hg1.x << 16); g1[1] = __builtin_bit_cast(float, hg1.x & 0xffff0000u); g1[2] = __builtin_bit_cast(float, hg1.y << 16); g1[3] = __builtin_bit_cast(float, hg1.y & 0xffff0000u);
                  g2[0] = __builtin_bit_cast(float, hg2.x << 16); g2[1] = __builtin_bit_cast(float, hg2.x & 0xffff0000u); g2[2] = __builtin_bit_cast(float, hg2.y << 16); g2[3] = __builtin_bit_cast(float, hg2.y & 0xffff0000u);
                  const bool is14 = (fr == 14);
#pragma unroll
                  for (int i = 0; i < 4; ++i) { pa[i] = is14 ? a2[i] : a1[i]; pg[i] = is14 ? g2[i] : g1[i]; } }
#pragma unroll
                for (int m = 0; m < 4; ++m) {
                    const int row = row0 + ai * HALF + m * 16; const float s = rs[ai][m];
                    const f32x4 ua = acc[ai][0][m][n] * s, ug = acc[ai][1][m][n] * s;
                    float r[4];
#pragma unroll
                    for (int i = 0; i < 4; ++i) {
                        const float oa1 = DPPF(0.f, pa[i], 0x121), oa2 = DPPF(0.f, pa[i], 0x122), og1 = DPPF(0.f, pg[i], 0x121), og2 = DPPF(0.f, pg[i], 0x122);
                        const float a1 = DPPF(oa1, ua[i], 0x111), a2 = DPPF(oa2, ua[i], 0x112), g1 = DPPF(og1, ug[i], 0x111), g2 = DPPF(og2, ug[i], 0x112);
                        const float ca = wa[0][i] * a2 + wa[1][i] * a1 + wa[2][i] * ua[i] + ba[i];
                        const float cg = wg[0][i] * g2 + wg[1][i] * g1 + wg[2][i] * ug[i] + bg[i];
                        r[i] = ca * (cg * __builtin_amdgcn_rcpf(1.0f + __builtin_amdgcn_exp2f(-1.4426950408889634f * cg)));
                    }
                    pa = ua; pg = ug;
                    u32x2v w; w.x = cvt_pk_bf16(r[0], r[1]); w.y = cvt_pk_bf16(r[2], r[3]);
                    *(u32x2v*)(ACT + (size_t)row * 2816 + cha) = w;
                }
            }
        }
    }
};
template <class Epi, class Sched, bool ALIGN_EPI = false, bool SP2 = false>
__device__ __forceinline__ void gemm_phase(PG8_LAS unsigned char* lds, const Gemm g, const Sched& S, const Epi& E) {
    int tid_l = threadIdx.x; asm volatile("" : "+v"(tid_l));
    const int tid = tid_l, wid = __builtin_amdgcn_readfirstlane(tid >> 6), lane = tid & 63, wr = wid >> 2, wc = wid & 3, fr = lane & 15, fq = lane >> 4;
    const int K = g.K, nt = K / BK;
    unsigned voffA[2], voffB[2];
#pragma unroll
    for (int i = 0; i < 2; ++i) { int R, C; stage_rc(tid * 16 + i * 8192, R, C); const int Rb = Epi::PERM ? ((R & ~31) + perm32(R & 31)) : R;
        voffA[i] = (unsigned)(R * K + C) * 2u; voffB[i] = (unsigned)(Rb * K + C) * 2u; }
    const size_t kstep = (size_t)(BK * 2);
    const size_t hstep = (size_t)HALF * K * 2;
    const size_t tstep = 2 * hstep;
    const unsigned ldsw = (unsigned)wid * 1024u;
    const int aoff = lds_byte(wr * 64 + fr, fq * 8), boff = lds_byte(wc * 32 + fr, fq * 8);
#define PG8_SA(b, h) (((b) * 2 + (h)) * HTB)
#define PG8_SB(b, h) ((4 + (b) * 2 + (h)) * HTB)
#define PG8_STAGE(bufoff, gbase, voff) do { _Pragma("unroll") for (int _i = 0; _i < 2; ++_i) \
        __builtin_amdgcn_global_load_lds((const unsigned*)((const char*)(gbase) + (voff)[_i]), (PG8_LAS unsigned*)(lds + (bufoff) + ldsw + _i * 8192), 16, 0, 0); } while (0)
#define PG8_LDA(dst, b, h) do { _Pragma("unroll") for (int m = 0; m < 4; ++m) _Pragma("unroll") for (int k = 0; k < 2; ++k) dst[m][k] = *(const PG8_LAS bf16x8*)(lds + PG8_SA(b, h) + aoff + m * 2048 + k * 1024); } while (0)
#define PG8_LDB(dst, b, h) do { _Pragma("unroll") for (int n = 0; n < 2; ++n) _Pragma("unroll") for (int k = 0; k < 2; ++k) dst[n][k] = *(const PG8_LAS bf16x8*)(lds + PG8_SB(b, h) + boff + n * 2048 + k * 1024); } while (0)
#define PG8_MMA(ai, bj, At, Bt) do { __builtin_amdgcn_s_setprio(1); _Pragma("unroll") for (int m = 0; m < 4; ++m) _Pragma("unroll") for (int n = 0; n < 2; ++n) _Pragma("unroll") for (int k = 0; k < 2; ++k) \
        acc[ai][bj][m][n] = __builtin_amdgcn_mfma_f32_16x16x32_bf16(Bt[n][k], At[m][k], acc[ai][bj][m][n], 0, 0, 0); __builtin_amdgcn_s_setprio(0); } while (0)
#define PG8_WAIT_V(n) asm volatile("s_waitcnt vmcnt(" #n ")" ::: "memory")
#define PG8_WAIT_L(n) asm volatile("s_waitcnt lgkmcnt(" #n ")" ::: "memory")
#define PG8_BAR __builtin_amdgcn_s_barrier()
#define PG8_SCHED __builtin_amdgcn_sched_barrier(0)
    Unit cur, nxt; int ui = 0;
    if (!S.next(0, cur)) return;
    f32x4 acc[2][2][4][2];
#pragma unroll
    for (int a = 0; a < 2; ++a)
#pragma unroll
        for (int b = 0; b < 2; ++b)
#pragma unroll
            for (int m = 0; m < 4; ++m)
#pragma unroll
                for (int n = 0; n < 2; ++n) acc[a][b][m][n] = (f32x4){0.f, 0.f, 0.f, 0.f};
    bf16x8 At[4][2], B0[2][2], B1[2][2];
    const char* cA = (const char*)g.A + (size_t)cur.pm * tstep; const char* cB = (const char*)g.Bt + (size_t)cur.pn * tstep;
    S.a_ready(cur);
    if constexpr (SP2) {
        PG8_STAGE(PG8_SB(0, 0), cB, voffB); PG8_STAGE(PG8_SB(0, 1), cB + hstep, voffB); PG8_STAGE(PG8_SA(0, 0), cA, voffA); PG8_STAGE(PG8_SA(0, 1), cA + hstep, voffA);
        if (wr == 1) PG8_BAR;
        PG8_WAIT_V(2); PG8_BAR;
        PG8_STAGE(PG8_SB(1, 0), cB + kstep, voffB); PG8_STAGE(PG8_SA(1, 0), cA + kstep, voffA); PG8_STAGE(PG8_SB(1, 1), cB + hstep + kstep, voffB);
        PG8_WAIT_V(6); PG8_BAR;
    } else {
        PG8_STAGE(PG8_SB(0, 0), cB, voffB); PG8_STAGE(PG8_SA(0, 0), cA, voffA); PG8_STAGE(PG8_SB(0, 1), cB + hstep, voffB); PG8_STAGE(PG8_SA(0, 1), cA + hstep, voffA);
        if (wr == 1) PG8_BAR;
        PG8_WAIT_V(4); PG8_BAR;
        PG8_STAGE(PG8_SB(1, 0), cB + kstep, voffB); PG8_STAGE(PG8_SA(1, 0), cA + kstep, voffA); PG8_STAGE(PG8_SB(1, 1), cB + hstep + kstep, voffB);
        PG8_WAIT_V(6); PG8_BAR;
    }
    for (;;) {
        const bool has_next = S.next(ui + 1, nxt);
        const char* nA = has_next ? (const char*)g.A + (size_t)nxt.pm * tstep : cA; const char* nB = has_next ? (const char*)g.Bt + (size_t)nxt.pn * tstep : cB;
        for (int t = 0; t < nt; t += 2) {
            const bool last = (t == nt - 2);
            const char* a1 = cA + (size_t)(t + 1) * kstep;
            const char* a2 = last ? nA : cA + (size_t)(t + 2) * kstep; const char* b2 = last ? nB : cB + (size_t)(t + 2) * kstep;
            const char* a3 = a2 + kstep; const char* b3 = b2 + kstep;
            if (last && has_next) S.a_ready(nxt);
            if constexpr (SP2) {
            PG8_LDB(B0, 0, 0); PG8_LDB(B1, 0, 1); PG8_SCHED; PG8_LDA(At, 0, 0); PG8_STAGE(PG8_SA(1, 1), a1 + hstep, voffA);
            PG8_WAIT_V(8); PG8_WAIT_L(0); PG8_BAR; PG8_MMA(0, 0, At, B0); PG8_MMA(0, 1, At, B1); PG8_BAR; PG8_SCHED;
            PG8_LDA(At, 0, 1); PG8_STAGE(PG8_SB(0, 0), b2, voffB); PG8_STAGE(PG8_SB(0, 1), b2 + hstep, voffB); PG8_STAGE(PG8_SA(0, 0), a2, voffA);
            PG8_WAIT_V(8); PG8_WAIT_L(0); PG8_BAR; PG8_MMA(1, 0, At, B0); PG8_MMA(1, 1, At, B1); PG8_BAR; PG8_SCHED;
            PG8_LDB(B0, 1, 0); PG8_LDB(B1, 1, 1); PG8_SCHED; PG8_LDA(At, 1, 0); PG8_STAGE(PG8_SA(0, 1), a2 + hstep, voffA);
            PG8_WAIT_V(8); PG8_WAIT_L(0); PG8_BAR; PG8_MMA(0, 0, At, B0); PG8_MMA(0, 1, At, B1); PG8_BAR; PG8_SCHED;
            PG8_LDA(At, 1, 1); PG8_STAGE(PG8_SB(1, 0), b3, voffB); PG8_STAGE(PG8_SB(1, 1), b3 + hstep, voffB); PG8_STAGE(PG8_SA(1, 0), a3, voffA);
            PG8_WAIT_V(8); PG8_WAIT_L(0); PG8_BAR; PG8_MMA(1, 0, At, B0); PG8_MMA(1, 1, At, B1); PG8_BAR; PG8_SCHED;
            } else {
            PG8_LDB(B0, 0, 0); PG8_SCHED; PG8_LDA(At, 0, 0); PG8_STAGE(PG8_SA(1, 1), a1 + hstep, voffA);
            PG8_WAIT_L(8); PG8_BAR; PG8_WAIT_L(0); PG8_MMA(0, 0, At, B0); PG8_BAR; PG8_SCHED;
            PG8_LDB(B1, 0, 1); PG8_STAGE(PG8_SB(0, 0), b2, voffB);
            PG8_BAR; PG8_WAIT_L(0); PG8_MMA(0, 1, At, B1); PG8_BAR;
            PG8_LDA(At, 0, 1); PG8_STAGE(PG8_SA(0, 0), a2, voffA);
            PG8_BAR; PG8_WAIT_L(0); PG8_MMA(1, 0, At, B0); PG8_BAR; PG8_SCHED;
            PG8_STAGE(PG8_SB(0, 1), b2 + hstep, voffB);
            PG8_WAIT_V(6); PG8_BAR; PG8_MMA(1, 1, At, B1); PG8_BAR;
            PG8_LDB(B0, 1, 0); PG8_SCHED; PG8_LDA(At, 1, 0); PG8_STAGE(PG8_SA(0, 1), a2 + hstep, voffA);
            PG8_WAIT_L(8); PG8_BAR; PG8_WAIT_L(0); PG8_MMA(0, 0, At, B0); PG8_BAR; PG8_SCHED;
            PG8_LDB(B1, 1, 1); PG8_STAGE(PG8_SB(1, 0), b3, voffB);
            PG8_BAR; PG8_WAIT_L(0); PG8_MMA(0, 1, At, B1); PG8_BAR;
            PG8_LDA(At, 1, 1); PG8_STAGE(PG8_SA(1, 0), a3, voffA);
            PG8_BAR; PG8_WAIT_L(0); PG8_MMA(1, 0, At, B0); PG8_BAR; PG8_SCHED;
            PG8_STAGE(PG8_SB(1, 1), b3 + hstep, voffB);
            PG8_WAIT_V(6); PG8_BAR; PG8_MMA(1, 1, At, B1); PG8_BAR;
            }
        }
        if constexpr (ALIGN_EPI) { if (wr == 0) PG8_BAR; }
        if constexpr (!Epi::AFTER_DRAIN) { E(acc, cur, wr, wc, fr, fq); S.done(cur); }
        if (!has_next) break;
#pragma unroll
        for (int a = 0; a < 2; ++a)
#pragma unroll
            for (int b = 0; b < 2; ++b)
#pragma unroll
                for (int m = 0; m < 4; ++m)
#pragma unroll
                    for (int n = 0; n < 2; ++n) acc[a][b][m][n] = (f32x4){0.f, 0.f, 0.f, 0.f};
        cur = nxt; cA = nA; cB = nB; ++ui;
        if constexpr (ALIGN_EPI) { if (wr == 1) PG8_BAR; }
    }
    PG8_WAIT_V(0);
    if constexpr (!ALIGN_EPI) { if (wr == 0) PG8_BAR; }
    PG8_BAR;
    if constexpr (Epi::AFTER_DRAIN) { E.fused(acc, cur, wr, wc, fr, fq, lds, wid, lane); S.done(cur); }
#undef PG8_SA
#undef PG8_SB
#undef PG8_STAGE
#undef PG8_LDA
#undef PG8_LDB
#undef PG8_MMA
#undef PG8_WAIT_V
#undef PG8_WAIT_L
#undef PG8_BAR
#undef PG8_SCHED
}
}
constexpr int NWAVES = 8;
constexpr int BATCH = 8, SEQ = 4096, DM = 1024, T = BATCH * SEQ, DFF = 2816, NBN = T / 64;
constexpr float EPS = 1e-6f, LOG2E_ = 1.4426950408889634f;
constexpr float LAM_INIT = 0.35550906759096934f;
constexpr size_t MiB = 1u << 20;
constexpr size_t WS_CTL = 0, CTL_ZERO_BYTES = 1 * MiB;
constexpr size_t WS_W1T = 2 * MiB, WS_WG1T = 8 * MiB, WS_WO1T = 9 * MiB, WS_WIN0T = 11 * MiB, WS_WOUT0T = 22 * MiB, WS_WKVQT = 28 * MiB, WS_WO2T = 34 * MiB, WS_WIN1T = 36 * MiB, WS_WOUT1T = 47 * MiB;
constexpr size_t WS_COS = 53 * MiB, WS_SIN = 53 * MiB + 512 * 1024, WS_RSTD = 54 * MiB, WS_DEC = 55 * MiB;
constexpr size_t WS_XB = 64 * MiB;
constexpr size_t WS_BIG = 128 * MiB;
constexpr size_t WS_QKVG = WS_BIG;
constexpr size_t WS_QI = 320 * MiB, WS_KET = 352 * MiB, WS_PM = 384 * MiB, WS_VT = 400 * MiB;
constexpr size_t WS_OGATE = 320 * MiB;
constexpr size_t WS_U = WS_BIG;
constexpr size_t WS_ACT = 320 * MiB;
constexpr size_t WS_KR = 128 * MiB, WS_VR = 192 * MiB, WS_QR = 256 * MiB, WS_AO = 320 * MiB;
constexpr size_t WS_UH = 496 * MiB, WS_AH = 507 * MiB, WS_RSTDH = 54 * MiB + 256 * 1024;
constexpr size_t WS_PS = 56 * MiB;
constexpr size_t WS_END = 512 * MiB;
constexpr int CW_BAR = 4096;
constexpr int RING_BYTES = 131072, LDSCTL_OFF = 147456, MISC_OFF = LDSCTL_OFF + 320, LDS_BYTES = 155648;

#define GAS __attribute__((address_space(1)))
#define LAS __attribute__((address_space(3)))
typedef unsigned short bf16;
typedef unsigned v4u __attribute__((ext_vector_type(4)));
typedef unsigned v2u __attribute__((ext_vector_type(2)));
typedef float f32x4 __attribute__((ext_vector_type(4)));
typedef float f32x16 __attribute__((ext_vector_type(16)));
typedef short bf16x8 __attribute__((ext_vector_type(8)));
typedef short s16x4 __attribute__((ext_vector_type(4)));
typedef GAS unsigned gu32;
#define RLX_AGENT __ATOMIC_RELAXED, __HIP_MEMORY_SCOPE_AGENT
#define LDS_WAIT() asm volatile("s_waitcnt lgkmcnt(0)" ::: "memory")
__device__ __forceinline__ unsigned f2bf(float f) { unsigned u = __builtin_bit_cast(unsigned, f); return (u + 0x7fffu + ((u >> 16) & 1u)) >> 16; }
typedef float f32x2_t __attribute__((ext_vector_type(2))); typedef __bf16 bf16x2_t __attribute__((ext_vector_type(2)));
__device__ __forceinline__ unsigned cvtpk(float lo, float hi) { f32x2_t v = {lo, hi}; bf16x2_t b = __builtin_convertvector(v, bf16x2_t); return __builtin_bit_cast(unsigned, b); }
__device__ __forceinline__ unsigned pk2(float lo, float hi) { return cvtpk(lo, hi); }
__device__ __forceinline__ float bf2f(unsigned short x) { return __builtin_bit_cast(float, (unsigned)x << 16); }
__device__ __forceinline__ float bflo(unsigned w) { return __builtin_bit_cast(float, w << 16); }
__device__ __forceinline__ float bfhi(unsigned w) { return __builtin_bit_cast(float, w & 0xffff0000u); }
#define MFMA_BF16(a, b, c) __builtin_amdgcn_mfma_f32_32x32x16_bf16(a, b, c, 0, 0, 0)

#define XB_TMO      128
#define XB_XCNT(j)  (256  + 64 * (j))
#define XB_XSUB(j)  (1280 + 64 * (j))
#define XB_XGEN(j)  (2304 + 64 * (j))
#define XB_TOP      3328
#define XB_TOPGEN   3392
#define XCD_BAR_WORDS 3456
#define XB_SPIN_CAP (1u << 18)

__device__ __forceinline__ unsigned xb_ld(unsigned* p)              { return __hip_atomic_load(p, __ATOMIC_RELAXED, __HIP_MEMORY_SCOPE_AGENT); }
__device__ __forceinline__ unsigned xb_add(unsigned* p, unsigned v) { return __hip_atomic_fetch_add(p, v, __ATOMIC_RELAXED, __HIP_MEMORY_SCOPE_AGENT); }
__device__ __forceinline__ unsigned xb_xcc_id() { return (unsigned)__builtin_amdgcn_s_getreg((3 << 11) | 20) & 0xFu; }
#define XB_SPIN(cond, bar) do { unsigned _sp = 0; while (cond) { __builtin_amdgcn_s_sleep(1); \
    if ((++_sp & 255u) == 0u) { if (xb_ld(&(bar)[XB_TMO])) break; if (_sp > XB_SPIN_CAP) { atomicAdd(&(bar)[XB_TMO], 1u); break; } } } } while (0)

struct XcdBarrier {
    unsigned* bar; unsigned x;
    volatile LAS unsigned* st;
};

__device__ __forceinline__ XcdBarrier xcd_barrier_post(unsigned* bar, volatile LAS unsigned* st) {
    XcdBarrier b; b.bar = bar; b.x = xb_xcc_id(); b.st = st;
    if (threadIdx.x == 0) (void)xb_add(&bar[XB_XCNT(b.x)], 1u);
    return b;
}
__device__ __forceinline__ void xcd_barrier_complete(unsigned* bar, unsigned x, unsigned& nloc, unsigned& nx) {
    const unsigned G = gridDim.x * gridDim.y * gridDim.z;
    unsigned sum, cnt, mine, sp = 0u;
    for (;;) {
        sum = 0u; cnt = 0u; mine = 0u;
#pragma unroll
        for (unsigned j = 0; j < 16; ++j) { const unsigned c = xb_ld(&bar[XB_XCNT(j)]); sum += c; cnt += (c > 0u) ? 1u : 0u; mine = (j == x) ? c : mine; }
        if (sum == G) break;
        __builtin_amdgcn_s_sleep(1);
        if ((++sp & 255u) == 0u) { if (xb_ld(&bar[XB_TMO])) break; if (sp > XB_SPIN_CAP) { atomicAdd(&bar[XB_TMO], 1u); break; } }
    }
    nloc = mine > 0u ? mine : 1u; nx = cnt > 0u ? cnt : 1u;
}

__device__ __forceinline__ void xcd_barrier(const XcdBarrier& b) {
    asm volatile("s_waitcnt vmcnt(0)" ::: "memory");
    __syncthreads();
    if (threadIdx.x == 0) {
        unsigned* bar = b.bar; asm volatile("" : "+s"(bar));
        __builtin_amdgcn_s_waitcnt(0);
        unsigned nloc = b.st[0], nx = b.st[1];
        if (nloc == 0u) { xcd_barrier_complete(bar, b.x, nloc, nx); b.st[0] = nloc; b.st[1] = nx; }
        const unsigned old = xb_add(&bar[XB_XSUB(b.x)], 1u);
        const unsigned gen = old / nloc;
        if (old + 1u == (gen + 1u) * nloc) {
            __builtin_amdgcn_fence(__ATOMIC_RELEASE, "agent");
            asm volatile("s_waitcnt vmcnt(0)" ::: "memory");
            const unsigned og = xb_add(&bar[XB_TOP], 1u);
            const unsigned tg = og / nx;
            if (og + 1u == (tg + 1u) * nx) xb_add(&bar[XB_TOPGEN], 1u);
            else XB_SPIN(xb_ld(&bar[XB_TOPGEN]) == tg, bar);
            __builtin_amdgcn_fence(__ATOMIC_ACQUIRE, "agent");
            xb_add(&bar[XB_XGEN(b.x)], 1u);
            asm volatile("s_waitcnt vmcnt(0)" ::: "memory");
        } else {
            XB_SPIN(xb_ld(&bar[XB_XGEN(b.x)]) == gen, bar);
            __builtin_amdgcn_fence(__ATOMIC_ACQUIRE, "agent");
            asm volatile("s_waitcnt vmcnt(0)" ::: "memory");
        }
    }
    __syncthreads();
}


__device__ __forceinline__ float wave_sum(float v) {
#pragma unroll
    for (int o = 1; o < 64; o <<= 1) v += __shfl_xor(v, o);
    return v;
}

struct Args { const float* in[20]; float* out; unsigned char* ws; int ph_lo, ph_hi; };
enum { I_X = 0, I_ATTN_NORM, I_FFN_NORM, I_WQKVG, I_WGK1, I_WGK2, I_BGK, I_ONORM, I_GLA_WO, I_KVNORM, I_WKV, I_WQ, I_LAMBDA, I_SUBLN, I_DIFF_WO, I_WIN, I_CONVW, I_CONVB, I_WOUT, I_FINAL };

template <int MAP> __device__ __forceinline__ int map_row(int s) {
    if (MAP == 0) return s;
    if (MAP == 1) { const int half = s >= DFF ? 1 : 0, j = s - half * DFF; return (j >> 7) * 256 + half * 128 + (j & 127); }
    const int tile = s >> 8, cidx = (s >> 6) & 3, d = s & 63, bj = cidx >> 1, wcp = cidx & 1, n = d >> 5, dd = d & 31;
    return tile * 256 + 128 * bj + 32 * (2 * wcp + (dd >> 4)) + 16 * n + 4 * ((dd & 15) >> 2) + (dd & 3);
}
template <int MAP> __device__ __forceinline__ void transpose_item(const float* W, int ldw, int K, int N, const float* gain, float scale, bf16* WT, int row_off, LAS float* scr, int item, int lane) {
    const int nblk = N / 32, kb = item / nblk, nb = item % nblk, k0 = 64 * kb, n0 = 32 * nb;
#pragma unroll
    for (int i = 0; i < 8; ++i) { const int kk = 8 * i + (lane >> 3), n4 = (lane & 7) * 4; const float g = gain ? gain[k0 + kk] * scale : scale;
        const f32x4 w = *(const f32x4*)(W + (size_t)(k0 + kk) * ldw + n0 + n4);
        scr[kk * 33 + n4] = w[0] * g; scr[kk * 33 + n4 + 1] = w[1] * g; scr[kk * 33 + n4 + 2] = w[2] * g; scr[kk * 33 + n4 + 3] = w[3] * g; }
    LDS_WAIT(); asm volatile("" ::: "memory");
    const int c = lane & 7;
#pragma unroll
    for (int j = 0; j < 4; ++j) { const int n = (lane >> 3) + 8 * j; const LAS float* s = scr + (8 * c) * 33 + n;
        v4u o; o.x = pk2(s[0 * 33], s[1 * 33]); o.y = pk2(s[2 * 33], s[3 * 33]); o.z = pk2(s[4 * 33], s[5 * 33]); o.w = pk2(s[6 * 33], s[7 * 33]);
        *(v4u*)(WT + (size_t)(row_off + map_row<MAP>(n0 + n)) * K + k0 + 8 * c) = o; }
    LDS_WAIT(); asm volatile("" ::: "memory");
}
__device__ __forceinline__ void sincos_d(double x, double& s, double& c) {
    const double k = __builtin_rint(x * 0.15915494309189535);
    double r = __builtin_fma(-k, 6.283185307179586, x); r = __builtin_fma(-k, 2.4492935982947064e-16, r);
    const double y = r * 0.25, y2 = y * y;
    double sy = 1.0 - y2 * (1.0 / 272.0);
    sy = 1.0 - y2 * (1.0 / 210.0) * sy; sy = 1.0 - y2 * (1.0 / 156.0) * sy; sy = 1.0 - y2 * (1.0 / 110.0) * sy; sy = 1.0 - y2 * (1.0 / 72.0) * sy;
    sy = 1.0 - y2 * (1.0 / 42.0) * sy; sy = 1.0 - y2 * (1.0 / 20.0) * sy; sy = 1.0 - y2 * (1.0 / 6.0) * sy; sy = y * sy;
    double cy = 1.0 - y2 * (1.0 / 240.0);
    cy = 1.0 - y2 * (1.0 / 182.0) * cy; cy = 1.0 - y2 * (1.0 / 132.0) * cy; cy = 1.0 - y2 * (1.0 / 90.0) * cy; cy = 1.0 - y2 * (1.0 / 56.0) * cy;
    cy = 1.0 - y2 * (1.0 / 30.0) * cy; cy = 1.0 - y2 * (1.0 / 12.0) * cy; cy = 1.0 - y2 * 0.5 * cy;
    const double s2 = 2.0 * sy * cy, c2 = 1.0 - 2.0 * sy * sy;
    s = 2.0 * s2 * c2; c = 1.0 - 2.0 * s2 * s2;
}
__device__ __forceinline__ void row_to_bf16_ps(const float* xrow, bf16* orow, float* ps_row, int lane) {
    const f32x4* xr = (const f32x4*)xrow + lane;
    f32x4 v[4]; float s = 0.f;
#pragma unroll
    for (int j = 0; j < 4; ++j) { v[j] = xr[64 * j]; s += (v[j].x * v[j].x + v[j].y * v[j].y) + (v[j].z * v[j].z + v[j].w * v[j].w); }
    s = wave_sum(s);
    if (lane < 16) ps_row[lane] = lane == 0 ? s : 0.f;
    unsigned long long* o8 = (unsigned long long*)orow + lane;
#pragma unroll
    for (int j = 0; j < 4; ++j) o8[64 * j] = (unsigned long long)pk2(v[j].x, v[j].y) | ((unsigned long long)pk2(v[j].z, v[j].w) << 32);
}
__device__ __forceinline__ void p0_prologue(const Args& A, LAS unsigned char* lds, int vcu, int G, int wave, int lane, int tid) {
    unsigned char* ws = A.ws;
    LAS float* scr = (LAS float*)(lds + wave * 16384);
    const int gw = vcu * NWAVES + wave, NGW = G * NWAVES;
    constexpr int I0 = (DM / 64) * (3072 / 32), I1 = (DM / 64) * (DM / 32), I2 = (DM / 64) * (2 * DFF / 32), I3 = (DFF / 64) * (DM / 32);
    constexpr int NITEMS = I0 + I1 + I2 + I3 + 3 * I1 + I1 + I2 + I3;
    const float QS = 0.18033688011112042f;
    for (int it = gw; it < NITEMS; it += NGW) {
        int r = it;
        if (r < I0) { transpose_item<0>(A.in[I_WQKVG], 3072, DM, 3072, A.in[I_ATTN_NORM], 1.f, (bf16*)(ws + WS_W1T), 0, scr, r, lane); continue; } r -= I0;
        if (r < I1) { transpose_item<0>(A.in[I_GLA_WO], DM, DM, DM, nullptr, 1.f, (bf16*)(ws + WS_WO1T), 0, scr, r, lane); continue; } r -= I1;
        if (r < I2) { transpose_item<1>(A.in[I_WIN], 2 * DFF, DM, 2 * DFF, A.in[I_FFN_NORM], 1.f, (bf16*)(ws + WS_WIN0T), 0, scr, r, lane); continue; } r -= I2;
        if (r < I3) { transpose_item<0>(A.in[I_WOUT], DM, DFF, DM, nullptr, 1.f, (bf16*)(ws + WS_WOUT0T), 0, scr, r, lane); continue; } r -= I3;
        if (r < I1) { transpose_item<2>(A.in[I_WKV], 2048, DM, 1024, A.in[I_KVNORM], 1.f, (bf16*)(ws + WS_WKVQT), 0, scr, r, lane); continue; } r -= I1;
        if (r < I1) { transpose_item<0>(A.in[I_WKV] + 1024, 2048, DM, 1024, A.in[I_KVNORM], 1.f, (bf16*)(ws + WS_WKVQT), 1024, scr, r, lane); continue; } r -= I1;
        if (r < I1) { transpose_item<2>(A.in[I_WQ], DM, DM, 1024, A.in[I_ATTN_NORM] + DM, QS, (bf16*)(ws + WS_WKVQT), 2048, scr, r, lane); continue; } r -= I1;
        if (r < I1) { transpose_item<0>(A.in[I_DIFF_WO], DM, DM, DM, nullptr, 1.f, (bf16*)(ws + WS_WO2T), 0, scr, r, lane); continue; } r -= I1;
        if (r < I2) { transpose_item<1>(A.in[I_WIN] + (size_t)DM * 2 * DFF, 2 * DFF, DM, 2 * DFF, A.in[I_FFN_NORM] + DM, 1.f, (bf16*)(ws + WS_WIN1T), 0, scr, r, lane); continue; } r -= I2;
        transpose_item<0>(A.in[I_WOUT] + (size_t)DFF * DM, DM, DFF, DM, nullptr, 1.f, (bf16*)(ws + WS_WOUT1T), 0, scr, r, lane);
    }
    const int gt = vcu * (NWAVES * 64) + tid, NGT = G * NWAVES * 64;
    for (int i = gt; i < 32 * DM; i += NGT) { const int j = i >> 10, k = i & 1023; ((bf16*)(ws + WS_WG1T))[i] = j < 16 ? (bf16)f2bf(A.in[I_WGK1][k * 16 + j] * A.in[I_ATTN_NORM][k]) : (bf16)0; }
    for (int i = gt; i < SEQ * 32; i += NGT) { const int pos = i >> 5, fi = i & 31; double inv = 1.0; for (int q = 0; q < fi; ++q) inv *= 0.7498942093324558;
        double s, c; sincos_d((double)pos * inv, s, c); ((float*)(ws + WS_COS))[i] = (float)c; ((float*)(ws + WS_SIN))[i] = (float)s; }
    for (int i = gt; i < 1024 * DM / 8; i += NGT) ((v4u*)(ws + WS_AH))[i] = (v4u){0u, 0u, 0u, 0u};
    for (int m = gw; m < T; m += 2 * NGW) {
        const int m2 = m + NGW; const bool h2 = m2 < T;
        const f32x4* xa = (const f32x4*)(A.in[I_X] + (size_t)m * DM) + lane; const f32x4* xb2 = (const f32x4*)(A.in[I_X] + (size_t)(h2 ? m2 : m) * DM) + lane;
        f32x4 va[4], vb[4]; float sa = 0.f, sb = 0.f;
#pragma unroll
        for (int j = 0; j < 4; ++j) { va[j] = xa[64 * j]; vb[j] = xb2[64 * j]; }
#pragma unroll
        for (int j = 0; j < 4; ++j) { sa += (va[j].x * va[j].x + va[j].y * va[j].y) + (va[j].z * va[j].z + va[j].w * va[j].w); sb += (vb[j].x * vb[j].x + vb[j].y * vb[j].y) + (vb[j].z * vb[j].z + vb[j].w * vb[j].w); }
        sa = wave_sum(sa); sb = wave_sum(sb);
        if (lane == 0) { ((float*)(ws + WS_RSTD))[m] = __builtin_amdgcn_rsqf(sa * (1.0f / DM) + EPS); if (h2) ((float*)(ws + WS_RSTD))[m2] = __builtin_amdgcn_rsqf(sb * (1.0f / DM) + EPS); }
        unsigned long long* oa = (unsigned long long*)((bf16*)(ws + WS_XB) + (size_t)m * DM) + lane; unsigned long long* ob = (unsigned long long*)((bf16*)(ws + WS_XB) + (size_t)m2 * DM) + lane;
#pragma unroll
        for (int j = 0; j < 4; ++j) { oa[64 * j] = (unsigned long long)pk2(va[j].x, va[j].y) | ((unsigned long long)pk2(va[j].z, va[j].w) << 32);
            if (h2) ob[64 * j] = (unsigned long long)pk2(vb[j].x, vb[j].y) | ((unsigned long long)pk2(vb[j].z, vb[j].w) << 32); }
    }
}

__device__ __forceinline__ void final_norm_phase(const bf16* HB, const float* PS, float* out, const float* w, int vcu, int G, int wave, int lane) {
    const int gw = vcu * NWAVES + wave, NGW = G * NWAVES;
    const f32x4* wp = (const f32x4*)w + 2 * lane; const f32x4 w00 = wp[0], w01 = wp[1], w10 = wp[128], w11 = wp[129];
    for (int m0 = gw; m0 < T; m0 += 4 * NGW) {
        v4u r0[4], r1[4]; float rs[4];
#pragma unroll
        for (int q = 0; q < 4; ++q) { const int m = m0 + q * NGW; const int mm = m < T ? m : m0; const v4u* hp = (const v4u*)(HB + (size_t)mm * DM) + lane; r0[q] = hp[0]; r1[q] = hp[64]; rs[q] = pg8::rstd_ps(PS, mm); }
#pragma unroll
        for (int q = 0; q < 4; ++q) { const int m = m0 + q * NGW; if (m < T) { f32x4* op = (f32x4*)(out + (size_t)m * DM) + 2 * lane; const float rstd = rs[q];
            f32x4 a, b; a[0] = bflo(r0[q].x); a[1] = bfhi(r0[q].x); a[2] = bflo(r0[q].y); a[3] = bfhi(r0[q].y); b[0] = bflo(r0[q].z); b[1] = bfhi(r0[q].z); b[2] = bflo(r0[q].w); b[3] = bfhi(r0[q].w);
            op[0] = a * rstd * w00; op[1] = b * rstd * w01;
            a[0] = bflo(r1[q].x); a[1] = bfhi(r1[q].x); a[2] = bflo(r1[q].y); a[3] = bfhi(r1[q].y); b[0] = bflo(r1[q].z); b[1] = bfhi(r1[q].z); b[2] = bflo(r1[q].w); b[3] = bfhi(r1[q].w);
            op[128] = a * rstd * w10; op[129] = b * rstd * w11; } }
    }
}
__device__ __forceinline__ void gla_gate_phase(const bf16* O, const bf16* QKVG, const float* onw, bf16* OG, int vcu, int G, int wave, int lane) {
    const int gw = vcu * NWAVES + wave, NGW = G * NWAVES;
    const f32x4* wp = (const f32x4*)(onw + 16 * (lane & 15)); const f32x4 wq[4] = {wp[0], wp[1], wp[2], wp[3]};
    for (int m0 = gw; m0 < T; m0 += 4 * NGW) {
        v4u o0[4], o1[4], g0[4], g1[4];
#pragma unroll
        for (int q = 0; q < 4; ++q) { const int m = m0 + q * NGW; const int mm = m < T ? m : m0; const v4u* op = (const v4u*)(O + (size_t)mm * DM + 16 * lane); const v4u* gp = (const v4u*)(QKVG + (size_t)mm * 3072 + 2048 + 16 * lane);
            o0[q] = op[0]; o1[q] = op[1]; g0[q] = gp[0]; g1[q] = gp[1]; }
#pragma unroll
        for (int q = 0; q < 4; ++q) { const int m = m0 + q * NGW; if (m < T) {
            float ov[16], gv[16];
#pragma unroll
            for (int i = 0; i < 4; ++i) { ov[2 * i] = bflo(o0[q][i]); ov[2 * i + 1] = bfhi(o0[q][i]); ov[8 + 2 * i] = bflo(o1[q][i]); ov[8 + 2 * i + 1] = bfhi(o1[q][i]);
                                          gv[2 * i] = bflo(g0[q][i]); gv[2 * i + 1] = bfhi(g0[q][i]); gv[8 + 2 * i] = bflo(g1[q][i]); gv[8 + 2 * i + 1] = bfhi(g1[q][i]); }
            float s = 0.f;
#pragma unroll
            for (int i = 0; i < 16; ++i) s += ov[i] * ov[i];
            s += __shfl_xor(s, 1); s += __shfl_xor(s, 2); s += __shfl_xor(s, 4); s += __shfl_xor(s, 8);
            const float rstd = __builtin_amdgcn_rsqf(s * (1.0f / 256.0f) + EPS);
            float r[16];
#pragma unroll
            for (int k = 0; k < 4; ++k)
#pragma unroll
                for (int i = 0; i < 4; ++i) { const float g = gv[4 * k + i]; r[4 * k + i] = ov[4 * k + i] * rstd * wq[k][i] * (g * __builtin_amdgcn_rcpf(1.0f + __builtin_amdgcn_exp2f(-LOG2E_ * g))); }
            v4u w0, w1;
#pragma unroll
            for (int i = 0; i < 4; ++i) { w0[i] = pk2(r[2 * i], r[2 * i + 1]); w1[i] = pk2(r[8 + 2 * i], r[8 + 2 * i + 1]); }
            v4u* dp = (v4u*)(OG + (size_t)m * DM + 16 * lane); dp[0] = w0; dp[1] = w1; } }
    }
}
constexpr float LOG2E = 1.4426950408889634f, LN2 = 0.6931471805599453f;
struct PreRegs { v4u qraw[8], kraw[8]; bf16x8 afr[2][8]; };
__device__ __forceinline__ void gla_pre_loads(PreRegs& R, const unsigned char* ws, int bn, int tid, int wave) {
    const bf16* XB = (const bf16*)(ws + WS_XB); const bf16* QKVG = (const bf16*)(ws + WS_QKVG);
    const int lane = tid & 63, row0 = bn * 64, cl = lane & 31, h = lane >> 5;
#pragma unroll
    for (int rb = 0; rb < 2; ++rb) { const bf16* ap = XB + (size_t)(row0 + 32 * rb + cl) * DM + 128 * wave + 8 * h;
#pragma unroll
        for (int s = 0; s < 8; ++s) R.afr[rb][s] = *(const bf16x8*)(ap + 16 * s); }
#pragma unroll
    for (int q = 0; q < 8; ++q) { const int idx = tid + 512 * q, t = idx >> 6, ch8 = idx & 63; const bf16* p = QKVG + (size_t)(row0 + t) * 3072 + ch8 * 8; R.qraw[q] = *(const v4u*)p; R.kraw[q] = *(const v4u*)(p + 512); }
}
__device__ __forceinline__ void gla_pre_unit(const Args& A, int bn, int nbn, PreRegs& R, const bf16x8 (&bfr)[8], LAS unsigned char* lds, int tid_in, int wave) {
    int tid = tid_in; asm volatile("" : "+v"(tid)); const int lane = tid & 63;
    unsigned char* ws = A.ws;
    const bf16* XB = (const bf16*)(ws + WS_XB); const bf16* WG1T = (const bf16*)(ws + WS_WG1T); const float* PS = (const float*)(ws + WS_PS);
    const bf16* QKVG = (const bf16*)(ws + WS_QKVG);
    bf16* QIG = (bf16*)(ws + WS_QI); bf16* KIG = (bf16*)(ws + WS_KET); bf16* PM = (bf16*)(ws + WS_PM); float* DEC = (float*)(ws + WS_DEC);
    const int row0 = bn * 64, cl = lane & 31, h = lane >> 5;
    LAS float* r_lds = (LAS float*)lds;
    LAS float* part = (LAS float*)(lds + 4608);
    LAS unsigned char* QIl = lds + 4608;
    LAS unsigned char* KIl = lds + 4608 + 69632;
    {
        __builtin_amdgcn_sched_barrier(0);
#pragma unroll
        for (int rb = 0; rb < 2; ++rb) {
            f32x16 acc = {};
#pragma unroll
            for (int s = 0; s < 8; ++s) acc = MFMA_BF16(R.afr[rb][s], bfr[s], acc);
            if (cl < 16) {
#pragma unroll
                for (int i = 0; i < 16; ++i) { const int row = 32 * rb + (i & 3) + 8 * (i >> 2) + 4 * h; part[(wave * 64 + row) * 16 + cl] = acc[i]; }
            }
        }
    }
    __syncthreads();
    float rsum[2];
#pragma unroll
    for (int q = 0; q < 2; ++q) { const int idx = tid + 512 * q, row = idx >> 4, j = idx & 15; float s = 0.f;
#pragma unroll
        for (int w = 0; w < 8; ++w) s += part[(w * 64 + row) * 16 + j];
        rsum[q] = s * ((const float*)(ws + WS_RSTD))[row0 + row]; }
    __syncthreads();
#pragma unroll
    for (int q = 0; q < 2; ++q) { const int idx = tid + 512 * q, row = idx >> 4, j = idx & 15; r_lds[row * 17 + j] = rsum[q]; }
#pragma unroll
    for (int q = 0; q < 8; ++q) { const int idx = tid + 512 * q, t = idx >> 6, ch8 = idx & 63, hd2 = ch8 >> 4, cc2 = (ch8 & 15) * 8; const int off = ((hd2 * 64 + t) * 136 + cc2) * 2;
        *(LAS v4u*)(QIl + off) = R.qraw[q]; *(LAS v4u*)(KIl + off) = R.kraw[q]; }
    __syncthreads();
    const int hd = wave >> 1, chh = wave & 1;
    float bw[2][8], bias2[2];
#pragma unroll
    for (int cb = 0; cb < 2; ++cb) { const int c = hd * 128 + 64 * chh + 32 * cb + cl; bias2[cb] = A.in[I_BGK][c];
#pragma unroll
        for (int s = 0; s < 8; ++s) bw[cb][s] = A.in[I_WGK2][(2 * s + h) * 512 + c]; }
    asm volatile("" : "+v"(bias2[0]), "+v"(bias2[1]));
#pragma unroll
    for (int cb = 0; cb < 2; ++cb) asm volatile("" : "+v"(bw[cb][0]), "+v"(bw[cb][1]), "+v"(bw[cb][2]), "+v"(bw[cb][3]), "+v"(bw[cb][4]), "+v"(bw[cb][5]), "+v"(bw[cb][6]), "+v"(bw[cb][7]));
    if (nbn >= 0) gla_pre_loads(R, ws, nbn, tid, wave);
#pragma unroll
    for (int cb = 0; cb < 2; ++cb) {
        const int cc = 64 * chh + 32 * cb + cl, c = hd * 128 + cc;
        const float bias = bias2[cb];
        float pre = 0.f;
#pragma unroll 1
        for (int rb = 0; rb < 2; ++rb) {
            f32x16 x = {};
#pragma unroll
            for (int s = 0; s < 8; ++s) { const float a = r_lds[(32 * rb + cl) * 17 + 2 * s + h]; const float b = bw[cb][s]; x = __builtin_amdgcn_mfma_f32_32x32x2f32(a, b, x, 0, 0, 0); }
#pragma unroll
            for (int i = 0; i < 16; ++i) { const float v = x[i] + bias; const float e = __builtin_amdgcn_exp2f(-fabsf(v) * LOG2E);
                x[i] = (fminf(v, 0.f) - __builtin_amdgcn_logf(1.0f + e) * LN2) * (0.0625f * LOG2E); }
#pragma unroll
            for (int g = 0; g < 4; ++g) {
                const float own = (x[4 * g] + x[4 * g + 1]) + (x[4 * g + 2] + x[4 * g + 3]); const float oth = __shfl_xor(own, 32);
                const float start = pre + (h ? oth : 0.f);
                x[4 * g] += start; x[4 * g + 1] += x[4 * g]; x[4 * g + 2] += x[4 * g + 1]; x[4 * g + 3] += x[4 * g + 2];
                pre += own + oth;
            }
#pragma unroll
            for (int i = 0; i < 16; ++i) { const int t = 32 * rb + (i & 3) + 8 * (i >> 2) + 4 * h; const int off = ((hd * 64 + t) * 136 + cc) * 2;
                const float qv = bf2f(*(const LAS bf16*)(QIl + off)), kv = bf2f(*(const LAS bf16*)(KIl + off)); const float bb = x[i];
                const float qi = qv * 0.08838834764831845f * __builtin_amdgcn_exp2f(bb), ki = kv * __builtin_amdgcn_exp2f(-bb);
                *(LAS bf16*)(QIl + off) = (bf16)(cvtpk(qi, 0.f) & 0xffffu); *(LAS bf16*)(KIl + off) = (bf16)(cvtpk(ki, 0.f) & 0xffffu); }
        }
        if (h == 0) DEC[bn * 512 + c] = __builtin_amdgcn_exp2f(pre);
    }
    __syncthreads();
#pragma unroll
    for (int q = 0; q < 8; ++q) { const int idx = tid + 512 * q, t = idx >> 6, ch8 = idx & 63, hd2 = ch8 >> 4, cc2 = (ch8 & 15) * 8;
        const v4u kv = *(const LAS v4u*)(KIl + ((hd2 * 64 + t) * 136 + cc2) * 2); *(v4u*)(KIG + (size_t)(row0 + t) * 512 + hd2 * 128 + cc2) = kv;
        const int c0 = (cc2 & ~15) + 4 * ((cc2 >> 3) & 1);
        const v2u qa = *(const LAS v2u*)(QIl + ((hd2 * 64 + t) * 136 + c0) * 2), qb = *(const LAS v2u*)(QIl + ((hd2 * 64 + t) * 136 + c0 + 8) * 2);
        v4u qv; qv.x = qa.x; qv.y = qa.y; qv.z = qb.x; qv.w = qb.y; *(v4u*)(QIG + (size_t)(row0 + t) * 512 + hd2 * 128 + cc2) = qv; }
    { const int rb = wave & 1; const int t = 32 * rb + cl;
#pragma unroll
        for (int cbp = 0; cbp < 2; ++cbp) {
            f32x16 acc = {};
#pragma unroll
            for (int s = 0; s < 8; ++s) { const bf16x8 a = *(const LAS bf16x8*)(KIl + ((hd * 64 + 32 * cbp + cl) * 136 + 16 * s + 8 * h) * 2), b = *(const LAS bf16x8*)(QIl + ((hd * 64 + 32 * rb + cl) * 136 + 16 * s + 8 * h) * 2); acc = MFMA_BF16(a, b, acc); }
#pragma unroll
            for (int g = 0; g < 4; ++g) { const int tp0 = 32 * cbp + 8 * g + 4 * h; float v[4];
#pragma unroll
                for (int ii = 0; ii < 4; ++ii) v[ii] = (tp0 + ii <= t) ? acc[4 * g + ii] : 0.f;
                v2u w; w.x = pk2(v[0], v[1]); w.y = pk2(v[2], v[3]); *(v2u*)(PM + ((size_t)(bn * 4 + hd) * 64 + t) * 64 + tp0) = w; }
        }
    }
    __syncthreads();
}

constexpr int SL_P = 0, SL_QI = 9216, SL_KI = 26624, SL_V = 47104, SL_DEC = 51200, SL_BYTES = 51712;
struct SeqRegs { v4u p, q0, q1, k0, k1, x; };
__device__ __forceinline__ void seq_fetch(SeqRegs& R, const unsigned char* ws, int bn, int hd, int es, int tid) {
    const bf16* QIG = (const bf16*)(ws + WS_QI); const bf16* KIG = (const bf16*)(ws + WS_KET); const bf16* PM = (const bf16*)(ws + WS_PM); const bf16* QKVG = (const bf16*)(ws + WS_QKVG); const float* DEC = (const float*)(ws + WS_DEC);
    const int row0 = bn * 64;
    R.p = *(const v4u*)(PM + ((size_t)(bn * 4 + hd) * 64 + (tid >> 3)) * 64 + (tid & 7) * 8);
    { const int t = tid >> 4, c16 = tid & 15; const size_t o0 = (size_t)(row0 + t) * 512 + hd * 128 + c16 * 8, o1 = o0 + (size_t)32 * 512;
      R.q0 = *(const v4u*)(QIG + o0); R.q1 = *(const v4u*)(QIG + o1); R.k0 = *(const v4u*)(KIG + o0); R.k1 = *(const v4u*)(KIG + o1); }
    if (tid < 256) R.x = *(const v4u*)(QKVG + (size_t)(row0 + (tid >> 2)) * 3072 + 1024 + hd * 256 + 32 * es + (tid & 3) * 8);
    else if (tid < 288) R.x = *(const v4u*)(DEC + bn * 512 + hd * 128 + (tid - 256) * 4);
}
__device__ __forceinline__ void seq_put(const SeqRegs& R, LAS unsigned char* slot, int tid) {
    *(LAS v4u*)(slot + SL_P + (tid >> 3) * 144 + (tid & 7) * 16) = R.p;
    { const int t = tid >> 4, c16 = tid & 15;
      *(LAS v4u*)(slot + SL_QI + t * 272 + c16 * 16) = R.q0; *(LAS v4u*)(slot + SL_QI + (t + 32) * 272 + c16 * 16) = R.q1;
      *(LAS v4u*)(slot + SL_KI + t * 320 + c16 * 16) = R.k0; *(LAS v4u*)(slot + SL_KI + (t + 32) * 320 + c16 * 16) = R.k1; }
    if (tid < 256) *(LAS v4u*)(slot + SL_V + (tid >> 2) * 64 + (tid & 3) * 16) = R.x;
    else if (tid < 288) *(LAS v4u*)(slot + SL_DEC + (tid - 256) * 16) = R.x;
}
#define LTR(p) __builtin_bit_cast(s16x4, __builtin_amdgcn_ds_read_tr16_b64_v4i16((LAS s16x4*)(p)))
__device__ __forceinline__ void seq_out(LAS unsigned char* slot, const LAS unsigned char* sfr, bf16* O, int row0, int ocol, int rb, int lane) {
    const int cl = lane & 31, h = lane >> 5;
    const int trb = (8 * h + ((lane & 15) >> 2)), trc = (16 * ((lane >> 4) & 1) + 4 * (lane & 3)) * 2;
    bf16x8 vt[4], pf[4], sa[4], qw[4];
#pragma unroll
    for (int s = 0; s < 4; ++s) { const s16x4 lo = LTR(slot + SL_V + (16 * s + trb) * 64 + trc), hi = LTR(slot + SL_V + (16 * s + 4 + trb) * 64 + trc); vt[s] = (bf16x8){lo[0], lo[1], lo[2], lo[3], hi[0], hi[1], hi[2], hi[3]}; }
#pragma unroll
    for (int s = 0; s < 4; ++s) pf[s] = *(const LAS bf16x8*)(slot + SL_P + (32 * rb + cl) * 144 + (16 * s + 8 * h) * 2);
#pragma unroll
    for (int i = 0; i < 4; ++i) { sa[i] = *(const LAS bf16x8*)(sfr + i * 1024 + lane * 16); qw[i] = *(const LAS bf16x8*)(slot + SL_QI + (32 * rb + cl) * 272 + (16 * i + 8 * h) * 2); }
    __builtin_amdgcn_sched_barrier(0);
    f32x16 acc = {};
#pragma unroll
    for (int s = 0; s < 4; ++s) acc = MFMA_BF16(vt[s], pf[s], acc);
    __builtin_amdgcn_sched_barrier(0);
#pragma unroll
    for (int i = 0; i < 4; ++i) { vt[i] = *(const LAS bf16x8*)(sfr + (4 + i) * 1024 + lane * 16); pf[i] = *(const LAS bf16x8*)(slot + SL_QI + (32 * rb + cl) * 272 + (16 * (4 + i) + 8 * h) * 2); }
    __builtin_amdgcn_sched_barrier(0);
#pragma unroll
    for (int i = 0; i < 4; ++i) acc = MFMA_BF16(sa[i], qw[i], acc);
#pragma unroll
    for (int i = 0; i < 4; ++i) acc = MFMA_BF16(vt[i], pf[i], acc);
#pragma unroll
    for (int g = 0; g < 4; ++g) { v2u w; w.x = cvtpk(acc[4 * g], acc[4 * g + 1]); w.y = cvtpk(acc[4 * g + 2], acc[4 * g + 3]);
        *(v2u*)(O + (size_t)(row0 + 32 * rb + cl) * DM + ocol + 8 * g + 4 * h) = w; }
}
__device__ __forceinline__ void seq_state(f32x16 (&S)[2], LAS unsigned char* slot, LAS unsigned char* sfw, int blk0, int lane) {
    const int h = lane >> 5;
    const int trb = (8 * h + ((lane & 15) >> 2)), trc = (16 * ((lane >> 4) & 1) + 4 * (lane & 3)) * 2;
    bf16x8 vt[4];
#pragma unroll
    for (int s = 0; s < 4; ++s) { const s16x4 lo = LTR(slot + SL_V + (16 * s + trb) * 64 + trc), hi = LTR(slot + SL_V + (16 * s + 4 + trb) * 64 + trc); vt[s] = (bf16x8){lo[0], lo[1], lo[2], lo[3], hi[0], hi[1], hi[2], hi[3]}; }
#pragma unroll
    for (int bi = 0; bi < 2; ++bi) { const int blk = blk0 + bi;
        bf16x8 ke[4];
#pragma unroll
        for (int s = 0; s < 4; ++s) { const s16x4 lo = LTR(slot + SL_KI + (16 * s + trb) * 320 + 64 * blk + trc), hi = LTR(slot + SL_KI + (16 * s + 4 + trb) * 320 + 64 * blk + trc);
            ke[s] = (bf16x8){lo[0], lo[1], lo[2], lo[3], hi[0], hi[1], hi[2], hi[3]}; }
#pragma unroll
        for (int s = 0; s < 4; ++s) S[bi] = MFMA_BF16(ke[s], vt[s], S[bi]);
#pragma unroll
        for (int g = 0; g < 4; ++g) { const f32x4 d4 = *(const LAS f32x4*)(slot + SL_DEC + (32 * blk + 8 * g + 4 * h) * 4);
#pragma unroll
            for (int ii = 0; ii < 4; ++ii) S[bi][4 * g + ii] *= d4[ii]; }
#pragma unroll
        for (int sp = 0; sp < 2; ++sp) { v4u sw; sw.x = cvtpk(S[bi][8 * sp], S[bi][8 * sp + 1]); sw.y = cvtpk(S[bi][8 * sp + 2], S[bi][8 * sp + 3]); sw.z = cvtpk(S[bi][8 * sp + 4], S[bi][8 * sp + 5]); sw.w = cvtpk(S[bi][8 * sp + 6], S[bi][8 * sp + 7]);
            *(LAS v4u*)(sfw + (2 * blk + sp) * 1024 + lane * 16) = sw; }
    }
}
constexpr int SEQ_SF = 2 * SL_BYTES;
__device__ __forceinline__ void seq_touch(unsigned& d0, unsigned& d1, const unsigned char* ws, int bn, int hd, int es, int t  ) {
    const bf16* QIG = (const bf16*)(ws + WS_QI); const bf16* KIG = (const bf16*)(ws + WS_KET); const bf16* PM = (const bf16*)(ws + WS_PM); const bf16* QKVG = (const bf16*)(ws + WS_QKVG); const float* DEC = (const float*)(ws + WS_DEC);
    const int row0 = bn * 64;
    const bf16* p0;
    if (t < 64) p0 = PM + (size_t)(bn * 4 + hd) * 4096 + t * 64;
    else if (t < 192) p0 = QIG + (size_t)(row0 + ((t - 64) >> 1)) * 512 + hd * 128 + ((t - 64) & 1) * 64;
    else p0 = QKVG + (size_t)(row0 + (t - 192)) * 3072 + 1024 + hd * 256 + 32 * es;
    d0 = *(const unsigned*)p0;
    if (t < 128) d1 = *(const unsigned*)(KIG + (size_t)(row0 + (t >> 1)) * 512 + hd * 128 + (t & 1) * 64);
    else if (t < 132) d1 = *(const unsigned*)(DEC + bn * 512 + hd * 128 + (t - 128) * 32);
}
struct SeqRegs4 { v4u p[2], q[4], k[4], x, d; };
__device__ __forceinline__ void seq_fetch4(SeqRegs4& R, const unsigned char* ws, int bn, int hd, int es, int lt) {
    const bf16* QIG = (const bf16*)(ws + WS_QI); const bf16* KIG = (const bf16*)(ws + WS_KET); const bf16* PM = (const bf16*)(ws + WS_PM); const bf16* QKVG = (const bf16*)(ws + WS_QKVG); const float* DEC = (const float*)(ws + WS_DEC);
    const int row0 = bn * 64;
#pragma unroll
    for (int j = 0; j < 2; ++j) { const int idx = lt + 256 * j; R.p[j] = *(const v4u*)(PM + ((size_t)(bn * 4 + hd) * 64 + (idx >> 3)) * 64 + (idx & 7) * 8); }
#pragma unroll
    for (int j = 0; j < 4; ++j) { const int idx = lt + 256 * j, t = idx >> 4, c16 = idx & 15; const size_t o = (size_t)(row0 + t) * 512 + hd * 128 + c16 * 8; R.q[j] = *(const v4u*)(QIG + o); R.k[j] = *(const v4u*)(KIG + o); }
    R.x = *(const v4u*)(QKVG + (size_t)(row0 + (lt >> 2)) * 3072 + 1024 + hd * 256 + 32 * es + (lt & 3) * 8);
    if (lt < 32) R.d = *(const v4u*)(DEC + bn * 512 + hd * 128 + lt * 4);
}
__device__ __forceinline__ void seq_put4(const SeqRegs4& R, LAS unsigned char* slot, int lt) {
#pragma unroll
    for (int j = 0; j < 2; ++j) { const int idx = lt + 256 * j; *(LAS v4u*)(slot + SL_P + (idx >> 3) * 144 + (idx & 7) * 16) = R.p[j]; }
#pragma unroll
    for (int j = 0; j < 4; ++j) { const int idx = lt + 256 * j, t = idx >> 4, c16 = idx & 15; *(LAS v4u*)(slot + SL_QI + t * 272 + c16 * 16) = R.q[j]; *(LAS v4u*)(slot + SL_KI + t * 320 + c16 * 16) = R.k[j]; }
    *(LAS v4u*)(slot + SL_V + (lt >> 2) * 64 + (lt & 3) * 16) = R.x;
    if (lt < 32) *(LAS v4u*)(slot + SL_DEC + lt * 16) = R.d;
}
__device__ __forceinline__ void gla_seq_unit(const Args& A, int u, LAS unsigned char* lds, int tid_in, int wave) {
    int tid = tid_in; asm volatile("" : "+v"(tid)); const int lane = tid & 63;
    unsigned char* ws = A.ws; bf16* O = (bf16*)(ws + WS_XB);
    const int b = u >> 5, hd = (u >> 3) & 3, es = u & 7;
    for (int i = tid; i < 8192 / 16; i += 512) *(LAS v4u*)(lds + SEQ_SF + i * 16) = (v4u){0u, 0u, 0u, 0u};
    if (wave >= 4) {
        const int lt = tid - 256;
        SeqRegs4 L0, L1, L2, L3;
        seq_fetch4(L0, ws, b * 64, hd, es, lt); seq_fetch4(L1, ws, b * 64 + 1, hd, es, lt); seq_fetch4(L2, ws, b * 64 + 2, hd, es, lt); seq_fetch4(L3, ws, b * 64 + 3, hd, es, lt);
        seq_put4(L0, lds, lt); seq_fetch4(L0, ws, b * 64 + 4, hd, es, lt);
        __syncthreads();
#define SEQ_LOAD(n, R) do { if ((n) + 1 < 64) { seq_put4(R, lds + (((n) + 1) & 1) * SL_BYTES, lt); if ((n) + 5 < 64) seq_fetch4(R, ws, b * 64 + (n) + 5, hd, es, lt); } __syncthreads(); } while (0)
#pragma unroll 1
        for (int n = 0; n < 64; n += 4) { SEQ_LOAD(n, L1); SEQ_LOAD(n + 1, L2); SEQ_LOAD(n + 2, L3); SEQ_LOAD(n + 3, L0); }
#undef SEQ_LOAD
    } else {
        f32x16 S[2]; S[0] = f32x16{}; S[1] = f32x16{};
        __syncthreads();
#pragma unroll 1
        for (int n = 0; n < 64; ++n) {
            if (wave < 2) seq_out(lds + (n & 1) * SL_BYTES, lds + SEQ_SF + (n & 1) * 8192, O, (b * 64 + n) * 64, hd * 256 + 32 * es, wave, lane);
            else seq_state(S, lds + (n & 1) * SL_BYTES, lds + SEQ_SF + ((n + 1) & 1) * 8192, 2 * (wave - 2), lane);
            __syncthreads();
        }
    }
}

constexpr int AT_KB = 18432, AT_VB = 20480, AT_K0 = 0, AT_V0 = 2 * AT_KB, AT_XO = 2 * AT_KB + 2 * AT_VB;
__device__ __forceinline__ float max3f(float a, float b, float c) { return fmaxf(fmaxf(a, b), c); }
#define VTR(p) __builtin_bit_cast(s16x4, __builtin_amdgcn_ds_read_tr16_b64_v4i16((LAS s16x4*)(p)))
#define MFMA_PV(a, b, c) MFMA_BF16(a, b, c)
#define EXP2F(x) __builtin_amdgcn_exp2f(x)
#define VFRAG(lo, hi) ((bf16x8){lo[0], lo[1], lo[2], lo[3], hi[0], hi[1], hi[2], hi[3]})
#define AT_EXP8(P, B, W) do { const float e0 = EXP2F(P[B]), e1 = EXP2F(P[B + 1]), e2 = EXP2F(P[B + 2]), e3 = EXP2F(P[B + 3]), e4 = EXP2F(P[B + 4]), e5 = EXP2F(P[B + 5]), e6 = EXP2F(P[B + 6]), e7 = EXP2F(P[B + 7]); \
        W.x = cvtpk(e0, e1); W.y = cvtpk(e2, e3); W.z = cvtpk(e4, e5); W.w = cvtpk(e6, e7); ra += (e0 + e1) + (e4 + e5); rb += (e2 + e3) + (e6 + e7); } while (0)
__device__ __forceinline__ void glds16_asm(const void* gsrc, unsigned lds_dst) { unsigned keep;
    asm volatile("s_mov_b32 %0, m0\n\ts_mov_b32 m0, %2\n\ts_nop 0\n\tglobal_load_lds_dwordx4 %1, off\n\ts_mov_b32 m0, %0" : "=&s"(keep) : "v"(gsrc), "s"(lds_dst) : "memory"); }
__device__ __forceinline__ void glds16_so(const void* sbase, unsigned voff, unsigned lds_dst) { unsigned keep;
    asm volatile("s_mov_b32 %0, m0\n\ts_mov_b32 m0, %3\n\ts_nop 0\n\tglobal_load_lds_dwordx4 %1, %2\n\ts_mov_b32 m0, %0" : "=&s"(keep) : "v"(voff), "s"(sbase), "s"(lds_dst) : "memory"); }
constexpr int A5_K0 = 0, A5_V0 = 3 * AT_KB;
__device__ __forceinline__ void attn5_tile(LAS unsigned char* vp, LAS unsigned char* kpn  , bool has_next, bf16x8 (&kf)[8], const bf16x8 (&qf)[4], f32x16 (&o)[4], float& m, float& l, f32x16& nmv  ,
                                           int key0, int qrow, int h, bool need_mask, bool first) {
    s16x4 la[4], ha[4], lb[4], hb[4];
#pragma unroll
    for (int eb = 0; eb < 4; ++eb) { la[eb] = VTR(vp + eb * 64); ha[eb] = VTR(vp + 8 * 320 + eb * 64); }
#pragma unroll
    for (int eb = 0; eb < 4; ++eb) { lb[eb] = VTR(vp + 16 * 320 + eb * 64); hb[eb] = VTR(vp + 16 * 320 + 8 * 320 + eb * 64); }
    __builtin_amdgcn_sched_barrier(0);
    f32x16 p0, p1;
    asm volatile("v_mfma_f32_32x32x16_bf16 %0, %2, %3, %4\n\tv_mfma_f32_32x32x16_bf16 %1, %5, %3, %4" : "=&v"(p0), "=&v"(p1) : "v"(kf[0]), "v"(qf[0]), "v"(nmv), "v"(kf[1]));
#pragma unroll
    for (int s = 1; s < 4; ++s) { p0 = MFMA_BF16(kf[2 * s], qf[s], p0); p1 = MFMA_BF16(kf[2 * s + 1], qf[s], p1); }
    if (need_mask) {
#pragma unroll
        for (int i = 0; i < 16; ++i) { const int key = key0 + (i & 3) + 8 * (i >> 2) + 4 * h; if (key > qrow) p0[i] = -INFINITY; if (key + 32 > qrow) p1[i] = -INFINITY; }
    }
    float ma = max3f(p0[0], p0[1], p1[0]), mb = max3f(p0[2], p0[3], p1[1]), mc = max3f(p0[4], p0[5], p1[2]), md = max3f(p0[6], p0[7], p1[3]);
    ma = max3f(ma, p0[8], p0[9]); mb = max3f(mb, p0[10], p0[11]); mc = max3f(mc, p0[12], p0[13]); md = max3f(md, p0[14], p0[15]);
    ma = max3f(ma, p1[4], p1[5]); mb = max3f(mb, p1[6], p1[7]); mc = max3f(mc, p1[8], p1[9]); md = max3f(md, p1[10], p1[11]);
    ma = max3f(ma, p1[12], p1[13]); mb = max3f(mb, p1[14], p1[15]);
    float mx = fmaxf(fmaxf(ma, mb), fmaxf(mc, md));
    { auto rr = __builtin_amdgcn_permlane32_swap(__builtin_bit_cast(unsigned, mx), __builtin_bit_cast(unsigned, mx), false, false); mx = fmaxf(__builtin_bit_cast(float, rr[0]), __builtin_bit_cast(float, rr[1])); }
    if (first || __any(mx > 8.0f)) {
        const float dl = first ? mx : fmaxf(mx, 0.f); m += dl;
#pragma unroll
        for (int i = 0; i < 16; ++i) { p0[i] -= dl; p1[i] -= dl; nmv[i] = -m; }
        if (!first) { const float al = __builtin_amdgcn_exp2f(-dl); l *= al;
#pragma unroll
            for (int eb = 0; eb < 4; ++eb) o[eb] *= al; }
    }
    float ra = 0.f, rb = 0.f; v4u w0, w1;
    AT_EXP8(p0, 0, w0);
    __builtin_amdgcn_sched_barrier(0);
    { const bf16x8 pf = __builtin_bit_cast(bf16x8, w0);
#pragma unroll
      for (int eb = 0; eb < 4; ++eb) o[eb] = MFMA_PV(VFRAG(la[eb], ha[eb]), pf, o[eb]); }
    AT_EXP8(p0, 8, w1);
    __builtin_amdgcn_sched_barrier(0);
#pragma unroll
    for (int eb = 0; eb < 4; ++eb) { la[eb] = VTR(vp + 32 * 320 + eb * 64); ha[eb] = VTR(vp + 32 * 320 + 8 * 320 + eb * 64); }
    __builtin_amdgcn_sched_barrier(0);
    { const bf16x8 pf = __builtin_bit_cast(bf16x8, w1);
#pragma unroll
      for (int eb = 0; eb < 4; ++eb) o[eb] = MFMA_PV(VFRAG(lb[eb], hb[eb]), pf, o[eb]); }
    AT_EXP8(p1, 0, w0);
    __builtin_amdgcn_sched_barrier(0);
#pragma unroll
    for (int eb = 0; eb < 4; ++eb) { lb[eb] = VTR(vp + 48 * 320 + eb * 64); hb[eb] = VTR(vp + 48 * 320 + 8 * 320 + eb * 64); }
    if (has_next) {
#pragma unroll
        for (int s = 0; s < 4; ++s) { kf[2 * s] = *(const LAS bf16x8*)(kpn + s * 32); kf[2 * s + 1] = *(const LAS bf16x8*)(kpn + 32 * 144 + s * 32); }
    }
    __builtin_amdgcn_sched_barrier(0);
    { const bf16x8 pf = __builtin_bit_cast(bf16x8, w0);
#pragma unroll
      for (int eb = 0; eb < 4; ++eb) o[eb] = MFMA_PV(VFRAG(la[eb], ha[eb]), pf, o[eb]); }
    AT_EXP8(p1, 8, w1);
    __builtin_amdgcn_sched_barrier(0);
    { const bf16x8 pf = __builtin_bit_cast(bf16x8, w1);
#pragma unroll
      for (int eb = 0; eb < 4; ++eb) o[eb] = MFMA_PV(VFRAG(lb[eb], hb[eb]), pf, o[eb]); }
    l += ra + rb;
}
__device__ __forceinline__ void attn8_step(LAS unsigned char* vp, LAS unsigned char* kpn2  , bool has_next, bool has_next2, bf16x8 (&kf)[8], const bf16x8 (&qf)[4], f32x16 (&o)[4], float& m, float& l,
                                           f32x16& p0, f32x16& p1, f32x16& n0, f32x16& n1, int key0, int qrow, int h, bool need_mask, bool first) {
    s16x4 la[4], ha[4], lb[4], hb[4];
#pragma unroll
    for (int eb = 0; eb < 4; ++eb) { la[eb] = VTR(vp + eb * 64); ha[eb] = VTR(vp + 8 * 320 + eb * 64); }
#pragma unroll
    for (int eb = 0; eb < 4; ++eb) { lb[eb] = VTR(vp + 16 * 320 + eb * 64); hb[eb] = VTR(vp + 16 * 320 + 8 * 320 + eb * 64); }
    __builtin_amdgcn_sched_barrier(0);
    { const float nm = -m;
#pragma unroll
        for (int i = 0; i < 16; ++i) { n0[i] = nm; n1[i] = nm; }
#pragma unroll
        for (int s = 0; s < 4; ++s) { n0 = MFMA_BF16(kf[2 * s], qf[s], n0); n1 = MFMA_BF16(kf[2 * s + 1], qf[s], n1); } }
    __builtin_amdgcn_sched_barrier(0);
    if (need_mask) {
#pragma unroll
        for (int i = 0; i < 16; ++i) { const int key = key0 + (i & 3) + 8 * (i >> 2) + 4 * h; if (key > qrow) p0[i] = -INFINITY; if (key + 32 > qrow) p1[i] = -INFINITY; }
    }
    float ma = max3f(p0[0], p0[1], p1[0]), mb = max3f(p0[2], p0[3], p1[1]), mc = max3f(p0[4], p0[5], p1[2]), md = max3f(p0[6], p0[7], p1[3]);
    ma = max3f(ma, p0[8], p0[9]); mb = max3f(mb, p0[10], p0[11]); mc = max3f(mc, p0[12], p0[13]); md = max3f(md, p0[14], p0[15]);
    ma = max3f(ma, p1[4], p1[5]); mb = max3f(mb, p1[6], p1[7]); mc = max3f(mc, p1[8], p1[9]); md = max3f(md, p1[10], p1[11]);
    ma = max3f(ma, p1[12], p1[13]); mb = max3f(mb, p1[14], p1[15]);
    float mx = fmaxf(fmaxf(ma, mb), fmaxf(mc, md));
    { auto rr = __builtin_amdgcn_permlane32_swap(__builtin_bit_cast(unsigned, mx), __builtin_bit_cast(unsigned, mx), false, false); mx = fmaxf(__builtin_bit_cast(float, rr[0]), __builtin_bit_cast(float, rr[1])); }
    if (first || __any(mx > 8.0f)) {
        const float dl = first ? mx : fmaxf(mx, 0.f); m += dl;
#pragma unroll
        for (int i = 0; i < 16; ++i) { p0[i] -= dl; p1[i] -= dl; }
#pragma unroll
        for (int i = 0; i < 16; ++i) { n0[i] -= dl; n1[i] -= dl; }
        if (!first) { const float al = __builtin_amdgcn_exp2f(-dl); l *= al;
#pragma unroll
            for (int eb = 0; eb < 4; ++eb) o[eb] *= al; }
    }
    float ra = 0.f, rb = 0.f; v4u w0, w1;
    AT_EXP8(p0, 0, w0);
    __builtin_amdgcn_sched_barrier(0);
    { const bf16x8 pf = __builtin_bit_cast(bf16x8, w0);
#pragma unroll
      for (int eb = 0; eb < 4; ++eb) o[eb] = MFMA_PV(VFRAG(la[eb], ha[eb]), pf, o[eb]); }
    AT_EXP8(p0, 8, w1);
    __builtin_amdgcn_sched_barrier(0);
#pragma unroll
    for (int eb = 0; eb < 4; ++eb) { la[eb] = VTR(vp + 32 * 320 + eb * 64); ha[eb] = VTR(vp + 32 * 320 + 8 * 320 + eb * 64); }
    __builtin_amdgcn_sched_barrier(0);
    { const bf16x8 pf = __builtin_bit_cast(bf16x8, w1);
#pragma unroll
      for (int eb = 0; eb < 4; ++eb) o[eb] = MFMA_PV(VFRAG(lb[eb], hb[eb]), pf, o[eb]); }
    AT_EXP8(p1, 0, w0);
    __builtin_amdgcn_sched_barrier(0);
#pragma unroll
    for (int eb = 0; eb < 4; ++eb) { lb[eb] = VTR(vp + 48 * 320 + eb * 64); hb[eb] = VTR(vp + 48 * 320 + 8 * 320 + eb * 64); }
    {
#pragma unroll
        for (int s = 0; s < 4; ++s) { kf[2 * s] = *(const LAS bf16x8*)(kpn2 + s * 32); kf[2 * s + 1] = *(const LAS bf16x8*)(kpn2 + 32 * 144 + s * 32); }
    }
    __builtin_amdgcn_sched_barrier(0);
    { const bf16x8 pf = __builtin_bit_cast(bf16x8, w0);
#pragma unroll
      for (int eb = 0; eb < 4; ++eb) o[eb] = MFMA_PV(VFRAG(la[eb], ha[eb]), pf, o[eb]); }
    AT_EXP8(p1, 8, w1);
    __builtin_amdgcn_sched_barrier(0);
    { const bf16x8 pf = __builtin_bit_cast(bf16x8, w1);
#pragma unroll
      for (int eb = 0; eb < 4; ++eb) o[eb] = MFMA_PV(VFRAG(lb[eb], hb[eb]), pf, o[eb]); }
    l += ra + rb;
}
__device__ __forceinline__ unsigned a8_koff(int cc, int i, int lane) { const int t = i + lane, r = (t * 57) >> 9, cq = t - 9 * r; return (unsigned)((cc * 4096 * 64 + (7 * i + r) * 64 + (cq > 7 ? 7 : cq) * 8) * 2); }
__device__ __forceinline__ unsigned a8_voff(int i, int lane) { const int t = 4 * i + lane, r = (t * 205) >> 12, cq = t - 20 * r; return (unsigned)(((3 * i + r) * 128 + (cq > 15 ? 15 : cq) * 8) * 2); }
__device__ __forceinline__ void a8_dma_k(const bf16* kt, unsigned ldsK, int wave, int lane) {
#pragma unroll
    for (int ii = 0; ii < 3; ++ii) { const int g = wave + 8 * ii; if (g < 18) { const int cc = g >= 9 ? 1 : 0, i = g - 9 * cc;
        glds16_so(kt, a8_koff(cc, i, lane), (unsigned)__builtin_amdgcn_readfirstlane((int)(ldsK + cc * 9216 + i * 1024))); } }
}
__device__ __forceinline__ void a8_dma_v(const bf16* vt, unsigned ldsV, int wave, int lane) {
#pragma unroll
    for (int ii = 2; ii < 5; ++ii) { const int g = wave + 8 * ii; if (g >= 18) { const int i = g < 38 ? g - 18 : g - 38;
        glds16_so(vt, a8_voff(i, lane), (unsigned)__builtin_amdgcn_readfirstlane((int)(ldsV + i * 1024))); } }
}
__device__ __forceinline__ void attn_unit(const Args& A, int b, int hh, int qb, float lam, LAS unsigned char* lds, int tid_in, int wave, int lane_in) {
    int tid = tid_in; asm volatile("" : "+v"(tid));
    const int lane = tid & 63; (void)lane_in;
    unsigned char* ws = A.ws;
    const bf16* KR = (const bf16*)(ws + WS_KR); const bf16* VR = (const bf16*)(ws + WS_VR); const bf16* QR = (const bf16*)(ws + WS_QR); bf16* AO = (bf16*)(ws + WS_AO);
    const int cl = lane & 31, h = lane >> 5, c = wave >> 2, qg = wave & 3;
    const int q0 = qb * 128, NT = 2 * (qb + 1), qrow = q0 + 32 * qg + cl, qmax = q0 + 32 * qg + 31, qmin = q0 + 32 * qg;
    bf16x8 qf[4];
    { const bf16* qp = QR + ((size_t)((b * 8 + hh) * 2 + c) * 4096 + qrow) * 64 + 8 * h;
#pragma unroll
        for (int s = 0; s < 4; ++s) qf[s] = *(const bf16x8*)(qp + 16 * s); }
    f32x16 o[4]; o[0] = f32x16{}; o[1] = f32x16{}; o[2] = f32x16{}; o[3] = f32x16{};
    float m = 0.f, l = 0.f;
    constexpr int A7_K0 = 0, A7_V0 = 4 * AT_KB;
    const bf16* const kbase = KR + (size_t)((b * 8 + hh) * 2) * 4096 * 64; const bf16* const vbase = VR + (size_t)(b * 8 + hh) * 4096 * 128;
    const unsigned lds0 = (unsigned)(uintptr_t)lds;
#define A7_DMA_K(t, slot) a8_dma_k(kbase + (size_t)(t) * 64 * 64, lds0 + A7_K0 + (slot) * AT_KB, wave, lane)
#define A7_DMA_V(t, slot) a8_dma_v(vbase + (size_t)(t) * 64 * 128, lds0 + A7_V0 + (slot) * AT_VB, wave, lane)
    LAS unsigned char* const vtr = lds + A7_V0 + (4 * h + ((lane & 15) >> 2)) * 320 + (16 * ((lane >> 4) & 1) + 4 * (lane & 3)) * 2;
    LAS unsigned char* const kfr = lds + A7_K0 + c * 9216 + cl * 144 + 16 * h;
    A7_DMA_K(0, 0); A7_DMA_V(0, 0); A7_DMA_K(1, 1); A7_DMA_V(1, 1);
    if (NT > 2) A7_DMA_K(2, 2);
    asm volatile("s_waitcnt vmcnt(0)" ::: "memory"); __syncthreads();
    asm volatile("" : "+v"(qf[0]), "+v"(qf[1]), "+v"(qf[2]), "+v"(qf[3]));
    bf16x8 kf[8];
#pragma unroll
    for (int s = 0; s < 4; ++s) { kf[2 * s] = *(const LAS bf16x8*)(kfr + s * 32); kf[2 * s + 1] = *(const LAS bf16x8*)(kfr + 32 * 144 + s * 32); }
    f32x16 nmv = {};
    int kv = 0, kv1 = 1, kv2 = 2, kk1 = 1, kk3 = 3;
#pragma unroll 1
    for (int j = 0; j < NT; ++j) {
        if (j + 3 < NT) A7_DMA_K(j + 3, kk3);
        if (j + 2 < NT) A7_DMA_V(j + 2, kv2);
        const bool act_ = (64 * j <= qmax);
        if (act_) attn5_tile(vtr + kv * AT_VB, kfr + kk1 * AT_KB, j + 1 < NT, kf, qf, o, m, l, nmv, 64 * j, qrow, h, 64 * j + 63 > qmin, j == 0);
        if (j + 3 < NT) asm volatile("s_waitcnt vmcnt(5) lgkmcnt(0)\n\ts_barrier" ::: "memory"); else asm volatile("s_waitcnt vmcnt(0) lgkmcnt(0)\n\ts_barrier" ::: "memory");
        kv = kv1; kv1 = kv2; kv2 = (kv2 == 2) ? 0 : kv2 + 1; kk1 = (kk1 + 1) & 3; kk3 = (kk3 + 1) & 3;
    }
    __syncthreads();
    int tid2 = tid; asm volatile("" : "+v"(tid2));
    const int bp32 = ((tid2 & 63) ^ 32) << 2;
    l += __builtin_bit_cast(float, __builtin_amdgcn_ds_bpermute(bp32, __builtin_bit_cast(int, l)));
    const float inv = __builtin_amdgcn_rcpf(l);
    {
    const int lane2 = tid2 & 63, cl = lane2 & 31, h = lane2 >> 5, wave2 = __builtin_amdgcn_readfirstlane(tid2 >> 6), c = wave2 >> 2, qg = wave2 & 3, qrow = q0 + 32 * qg + cl;
    LAS float* XO = (LAS float*)(lds) + qg * 4096;
    if (c == 1) {
        const float f = inv * lam;
#pragma unroll
        for (int eb = 0; eb < 4; ++eb)
#pragma unroll
            for (int i = 0; i < 16; ++i) { const int e = 32 * eb + (i & 3) + 8 * (i >> 2) + 4 * h; XO[e * 32 + cl] = o[eb][i] * f; }
    }
    __syncthreads();
    if (c == 0) {
        float ss = 0.f;
#pragma unroll
        for (int eb = 0; eb < 4; ++eb)
#pragma unroll
            for (int i = 0; i < 16; ++i) { const int e = 32 * eb + (i & 3) + 8 * (i >> 2) + 4 * h; const float v = o[eb][i] * inv - XO[e * 32 + cl]; o[eb][i] = v; ss += v * v; }
        ss += __builtin_bit_cast(float, __builtin_amdgcn_ds_bpermute(bp32, __builtin_bit_cast(int, ss)));
        const float rstd = (1.0f - LAM_INIT) * __builtin_amdgcn_rsqf(ss * (1.0f / 128.0f) + EPS);
        LAS unsigned char* ob = lds + qg * 16384 + cl * 272;
        f32x4 w4[4][4];
#pragma unroll
        for (int eb = 0; eb < 4; ++eb)
#pragma unroll
            for (int g = 0; g < 4; ++g) w4[eb][g] = *(const f32x4*)(A.in[I_SUBLN] + 32 * eb + 8 * g + 4 * h);
#pragma unroll
        for (int eb = 0; eb < 4; ++eb)
#pragma unroll
            for (int g = 0; g < 4; ++g) { const int e0 = 32 * eb + 8 * g + 4 * h;
                v2u w; w.x = cvtpk(o[eb][4 * g] * rstd * w4[eb][g][0], o[eb][4 * g + 1] * rstd * w4[eb][g][1]); w.y = cvtpk(o[eb][4 * g + 2] * rstd * w4[eb][g][2], o[eb][4 * g + 3] * rstd * w4[eb][g][3]);
                *(LAS v2u*)(ob + e0 * 2) = w; }
    }
    __syncthreads();
    { bf16* ob0 = AO + (size_t)(b * 4096 + q0) * DM + hh * 128;
      v4u t[4];
#pragma unroll
      for (int it = 0; it < 4; ++it) { const int row = 16 * wave2 + 4 * it + (lane2 >> 4); t[it] = *(const LAS v4u*)(lds + (row >> 5) * 16384 + (row & 31) * 272 + (lane2 & 15) * 16); }
#pragma unroll
      for (int it = 0; it < 4; ++it) { const int row = 16 * wave2 + 4 * it + (lane2 >> 4); *(v4u*)(ob0 + (size_t)row * DM + (lane2 & 15) * 8) = t[it]; } }
    }
    __syncthreads();
#undef A7_DMA_K
#undef A7_DMA_V
}

constexpr int NPH = 16;
__global__ void __launch_bounds__(NWAVES * 64, 2) yoco_fwd(Args args) {
    extern __shared__ __attribute__((aligned(16))) unsigned char lds_raw[];
    LAS unsigned char* lds = (LAS unsigned char*)lds_raw;
#define FRESH() int tid = threadIdx.x; asm volatile("" : "+v"(tid)); const int lane = tid & 63, wave = __builtin_amdgcn_readfirstlane(tid >> 6); (void)lane; (void)wave
    const int G = gridDim.x; const int bx = blockIdx.x; const int vcu = (G % 8 == 0) ? (bx % 8) * (G / 8) + bx / 8 : bx;
    unsigned char* ws = args.ws;
    for (int u = threadIdx.x; u < (LDS_BYTES - LDSCTL_OFF) / 4; u += NWAVES * 64) ((LAS unsigned*)(lds + LDSCTL_OFF))[u] = 0u;
    __syncthreads();
#if !MK_PER_PHASE
    XcdBarrier bar = xcd_barrier_post((unsigned*)(ws + WS_CTL) + CW_BAR, (volatile LAS unsigned*)(lds + MISC_OFF) + 8);
#define GRID_BAR() xcd_barrier(bar)
#else
#define GRID_BAR() do {} while (0)
#endif
    const int lo = args.ph_lo, hi = args.ph_hi;
#define IN(k) (lo <= (k) && (k) < hi)
#define SEAM(k) do { if (IN((k) + 1)) GRID_BAR(); } while (0)
    float* H = args.out;
    const float* PS = (const float*)(ws + WS_PS);
    if (IN(0)) { FRESH(); { p0_prologue(args, lds, vcu, G, wave, lane, tid); } SEAM(0); }
    if (IN(1)) { FRESH(); {
        pg8::Gemm g{(const bf16*)(ws + WS_XB), (const bf16*)(ws + WS_W1T), T, 3072, DM}; pg8::StaticOrder S; S.init(T, 3072, G, bx);
        pg8::EpiScaleBf16 E{(bf16*)(ws + WS_QKVG), 3072, (const float*)(ws + WS_RSTD), nullptr, 0};
        pg8::gemm_phase<pg8::EpiScaleBf16, pg8::StaticOrder, true, true>(lds, g, S, E); } SEAM(1);
    }
    if (IN(2)) { FRESH(); {
        if (bx & 1) __builtin_amdgcn_s_sleep(127);
        PreRegs R; bf16x8 bfr[8];
        { const bf16* bp = (const bf16*)(ws + WS_WG1T) + (size_t)(lane & 31) * DM + 128 * wave + 8 * (lane >> 5);
#pragma unroll
          for (int s = 0; s < 8; ++s) bfr[s] = *(const bf16x8*)(bp + 16 * s); }
        if (vcu < NBN) gla_pre_loads(R, ws, vcu, tid, wave);
        for (int bn = vcu; bn < NBN; bn += G) gla_pre_unit(args, bn, bn + G < NBN ? bn + G : -1, R, bfr, lds, tid, wave); } SEAM(2); }
    if (IN(3)) { FRESH(); { for (int u = vcu; u < 256; u += G) gla_seq_unit(args, u, lds, tid, wave); } SEAM(3); }
    if (IN(4)) { FRESH(); { gla_gate_phase((const bf16*)(ws + WS_XB), (const bf16*)(ws + WS_QKVG), args.in[I_ONORM], (bf16*)(ws + WS_OGATE), vcu, G, wave, lane); } SEAM(4); }
    if (IN(5)) { FRESH(); {
        pg8::Gemm g{(const bf16*)(ws + WS_OGATE), (const bf16*)(ws + WS_WO1T), T, DM, DM}; pg8::StaticOrder S; S.init(T, DM, G, bx);
        pg8::EpiResBf16 E{args.in[I_X], nullptr, (bf16*)(ws + WS_XB), DM, (float*)(ws + WS_PS), (bf16*)(ws + WS_AH)};
        pg8::gemm_phase<pg8::EpiResBf16, pg8::StaticOrder, true, true>(lds, g, S, E); } SEAM(5);
    }
#pragma unroll
    for (int layer = 0; layer < 2; ++layer) {
        const int pb = layer == 0 ? 6 : 12;
        const bf16* WIN = (const bf16*)(ws + (layer == 0 ? WS_WIN0T : WS_WIN1T)); const bf16* WOUT = (const bf16*)(ws + (layer == 0 ? WS_WOUT0T : WS_WOUT1T));
        const float* cw = args.in[I_CONVW] + (size_t)layer * 3 * 2 * DFF; const float* cb = args.in[I_CONVB] + (size_t)layer * 2 * DFF;
        if (IN(pb)) { FRESH(); {
            pg8::Gemm g{(const bf16*)(ws + WS_AH), WIN, 1024, 2 * DFF, DM}; pg8::StaticOrder S; S.init(1024, 2 * DFF, G, bx);
            pg8::EpiScaleBf16 E{(bf16*)(ws + WS_UH), 2 * DFF, nullptr, PS, 1};
            pg8::gemm_phase<pg8::EpiScaleBf16, pg8::StaticOrder, true, true>(lds, g, S, E);
            { const int nidle = G > 88 ? G - 88 : G, me = G > 88 ? bx - 88 : bx;
              if (me >= 0) for (int r = me * (NWAVES * 64) + tid; r < T; r += nidle * NWAVES * 64) ((float*)(ws + WS_RSTD))[r] = pg8::rstd_ps(PS, r); } } SEAM(pb);
        }
        if (IN(pb + 1)) { FRESH(); {
            pg8::Gemm g{(const bf16*)(ws + WS_XB), WIN, T, 2 * DFF, DM}; pg8::StaticOrder S; S.init(T, 2 * DFF, G, bx);
            pg8::EpiConvGate E{(bf16*)(ws + WS_ACT), (const bf16*)(ws + WS_UH), (const float*)(ws + WS_RSTD), cw, cb};
            pg8::gemm_phase<pg8::EpiConvGate, pg8::StaticOrder, true, true>(lds, g, S, E); } SEAM(pb + 1);
        }
        if (IN(pb + 2)) { FRESH(); {
            pg8::Gemm g{(const bf16*)(ws + WS_ACT), WOUT, T, DM, DFF}; pg8::StaticOrder S; S.init(T, DM, G, bx);
            pg8::EpiResBf16 E{nullptr, (const bf16*)(ws + WS_XB), (bf16*)(ws + WS_XB), DM, (float*)(ws + WS_PS), layer == 0 ? (bf16*)(ws + WS_AH) : (bf16*)nullptr};
            pg8::gemm_phase<pg8::EpiResBf16, pg8::StaticOrder, true, true>(lds, g, S, E); } SEAM(pb + 2);
        }
        if (layer == 0) {
            if (IN(9)) { FRESH(); {
                pg8::Gemm g{(const bf16*)(ws + WS_XB), (const bf16*)(ws + WS_WKVQT), T, 3072, DM}; pg8::StaticOrder S; S.init(T, 3072, G, bx);
                pg8::EpiRope E{(bf16*)(ws + WS_KR), (bf16*)(ws + WS_VR), (bf16*)(ws + WS_QR), PS, (const float*)(ws + WS_COS), (const float*)(ws + WS_SIN)};
                pg8::gemm_phase<pg8::EpiRope, pg8::StaticOrder, true, true>(lds, g, S, E); } SEAM(9);
            }
            if (IN(10)) { FRESH(); {
                const float* lp = args.in[I_LAMBDA];
                const float sa = wave_sum(lp[lane] * lp[64 + lane]), sb = wave_sum(lp[128 + lane] * lp[192 + lane]);
                const float lam = __builtin_bit_cast(float, __builtin_amdgcn_readfirstlane(__builtin_bit_cast(int, expf(sa) - expf(sb) + LAM_INIT)));
                const int xg = vcu >> 5, cu = vcu & 31, kq = cu & 15;
                if (G == 256) {
#pragma unroll 1
                    for (int i = 0; i < 8; ++i) { const int pr = xg * 8 + 2 * (i >> 1) + (cu >> 4); const int qb = (i & 1) ? 31 - kq : kq; attn_unit(args, pr >> 3, pr & 7, qb, lam, lds, tid, wave, lane); }
                } else {
#pragma unroll 1
                    for (int it = vcu; it < 1024; it += G) {
#pragma unroll 1
                        for (int i = 0; i < 2; ++i) { const int pr = it >> 4, k2 = it & 15; attn_unit(args, pr >> 3, pr & 7, i ? 31 - k2 : k2, lam, lds, tid, wave, lane); } }
                } }
                SEAM(10);
            }
            if (IN(11)) { FRESH(); {
                pg8::Gemm g{(const bf16*)(ws + WS_AO), (const bf16*)(ws + WS_WO2T), T, DM, DM}; pg8::StaticOrder S; S.init(T, DM, G, bx);
                pg8::EpiResBf16 E{nullptr, (const bf16*)(ws + WS_XB), (bf16*)(ws + WS_XB), DM, (float*)(ws + WS_PS), (bf16*)(ws + WS_AH)};
                pg8::gemm_phase<pg8::EpiResBf16, pg8::StaticOrder, true, true>(lds, g, S, E); } SEAM(11);
            }
        }
    }
    if (IN(15)) { FRESH(); { final_norm_phase((const bf16*)(ws + WS_XB), PS, H, args.in[I_FINAL], vcu, G, wave, lane); } }
#undef IN
#undef SEAM
}

extern "C" void kernel_launch(void* const* d_in, const int* in_sizes, int n_in, void* d_out, int out_size, void* d_ws, size_t ws_size, hipStream_t stream) {
    static int grid = 0;
    if (grid == 0) {
        if (n_in != 20 || out_size != T * DM || ws_size < WS_END) { fprintf(stderr, "kernel_launch: unexpected shapes (n_in %d out %d ws %zu)\n", n_in, out_size, ws_size); grid = -1; return; }
        int dev = 0, cus = 0;
        if (hipGetDevice(&dev) != hipSuccess || hipDeviceGetAttribute(&cus, hipDeviceAttributeMultiprocessorCount, dev) != hipSuccess) { grid = -1; return; }
        if (hipFuncSetAttribute((const void*)yoco_fwd, hipFuncAttributeMaxDynamicSharedMemorySize, LDS_BYTES) != hipSuccess) { grid = -1; return; }
        int per_cu = 0; (void)hipOccupancyMaxActiveBlocksPerMultiprocessor(&per_cu, (const void*)yoco_fwd, NWAVES * 64, LDS_BYTES); (void)hipGetLastError();
        grid = cus;
    }
    if (grid < 0) return;
    if (hipMemsetAsync((char*)d_ws + WS_CTL, 0, CTL_ZERO_BYTES, stream) != hipSuccess) return;
    Args a{};
    for (int i = 0; i < 20; ++i) a.in[i] = (const float*)d_in[i];
    a.out = (float*)d_out; a.ws = (unsigned char*)d_ws;
#if MK_PER_PHASE
    for (int ph = 0; ph < NPH; ++ph) { a.ph_lo = ph; a.ph_hi = ph + 1; hipLaunchKernelGGL(yoco_fwd, dim3(grid), dim3(NWAVES * 64), LDS_BYTES, stream, a); }
#else
    a.ph_lo = 0; a.ph_hi = NPH; hipLaunchKernelGGL(yoco_fwd, dim3(grid), dim3(NWAVES * 64), LDS_BYTES, stream, a);
#endif
}
```

```cpp
#ifndef MK_PER_PHASE
#define MK_PER_PHASE 0
#endif
#include <hip/hip_runtime.h>
#include <cstdio>
#include <cstdint>
namespace pg8 {
#define PG8_LAS __attribute__((address_space(3)))
typedef unsigned short bf16_t;
typedef short bf16x8 __attribute__((ext_vector_type(8)));
typedef float f32x4 __attribute__((ext_vector_type(4)));
typedef unsigned u32x4 __attribute__((ext_vector_type(4)));
constexpr int BM = 256, BK = 64, HALF = 128, HTB = HALF * BK * 2  , STAGE_BYTES = 8 * HTB, NXCD = 8, WGM = 8;

__host__ __device__ __forceinline__ int lds_byte(int r, int c) { const int st = (r >> 4) * 2 + (c >> 5), rr = r & 15, cc = c & 31, ob = rr * 64 + cc * 2; return st * 1024 + (ob ^ (((ob >> 9) & 1) << 5)); }
__host__ __device__ __forceinline__ void stage_rc(int b, int& R, int& C) { const int st = b / 1024, sb = b % 1024, swz = sb ^ (((sb >> 9) & 1) << 5); R = (st >> 1) * 16 + swz / 64; C = (st & 1) * 32 + (swz % 64) / 2; }
__host__ __device__ __forceinline__ int perm32(int rho) { const int n = rho >> 4, i = rho & 15; return 8 * (i >> 2) + 4 * n + (i & 3); }

struct Unit { int pm, pn; };
struct Gemm { const bf16_t* A; const bf16_t* Bt; int M, N, K; };

struct StaticOrder {
    int nM, nN, nwg, G, c;
    __host__ __device__ void init(int M, int N, int G_, int c_) { nM = M / BM; nN = N / BM; nwg = nM * nN; G = G_; c = c_; }
    __host__ __device__ bool next(int i, Unit& u) const {
        const long L = (long)i * G + c; if (L >= nwg) return false;
        int wgid = (int)L; { const int q = nwg / NXCD, r = nwg % NXCD, xcd = wgid % NXCD, off = wgid / NXCD; wgid = (xcd < r ? xcd * (q + 1) : r * (q + 1) + (xcd - r) * q) + off; }
        const int nig = WGM * nN, gid = wgid / nig, fm = gid * WGM, gsz = (nM - fm) < WGM ? (nM - fm) : WGM;
        u.pm = fm + ((wgid % nig) % gsz); u.pn = (wgid % nig) / gsz; return true;
    }
    __device__ __forceinline__ void a_ready(const Unit&) const {}
    __device__ __forceinline__ void done(const Unit&) const {}
};

__device__ __forceinline__ unsigned cvt_pk_bf16(float lo, float hi) { unsigned r; asm volatile("v_cvt_pk_bf16_f32 %0, %1, %2" : "=v"(r) : "v"(lo), "v"(hi)); return r; }
typedef float f32x2 __attribute__((ext_vector_type(2)));
__device__ __forceinline__ float rstd_ps(const float* ps, int row) {
    const f32x4* p = (const f32x4*)(ps + (size_t)row * 16); const f32x4 a = p[0], b = p[1], c = p[2], d = p[3];
    const float s = ((a[0] + a[1]) + (a[2] + a[3])) + ((b[0] + b[1]) + (b[2] + b[3])) + ((c[0] + c[1]) + (c[2] + c[3])) + ((d[0] + d[1]) + (d[2] + d[3]));
    return __builtin_amdgcn_rsqf(s * (1.0f / 1024.0f) + 1e-6f);
}
struct EpiScaleBf16 {
    static constexpr bool PERM = true, AFTER_DRAIN = false, APERM = false;
    bf16_t* O; int ldc; const float* rstd; const float* ps; int halo;
    __device__ __forceinline__ void operator()(const f32x4 (&acc)[2][2][4][2], const Unit& u, int wr, int wc, int fr, int fq) const {
        const int row0 = u.pm * BM + wr * 64 + fr, col0 = u.pn * BM + wc * 32 + 8 * fq;
        float sc[2][4];
#pragma unroll
        for (int ai = 0; ai < 2; ++ai)
#pragma unroll
            for (int m = 0; m < 4; ++m) { const int row = row0 + ai * HALF + m * 16;
                if (rstd) sc[ai][m] = rstd[row];
                else if (halo) { const int st = row >> 1; sc[ai][m] = (st & 63) ? rstd_ps(ps, 64 * st - 2 + (row & 1)) : 0.f; } else sc[ai][m] = rstd_ps(ps, row); }
#pragma unroll
        for (int ai = 0; ai < 2; ++ai)
#pragma unroll
            for (int m = 0; m < 4; ++m) { const int row = row0 + ai * HALF + m * 16; const float s = sc[ai][m];
                bf16_t* rowp = O + (size_t)row * ldc + col0;
#pragma unroll
                for (int bj = 0; bj < 2; ++bj) { const f32x4 v0 = acc[ai][bj][m][0] * s, v1 = acc[ai][bj][m][1] * s;
                    u32x4 w; w.x = cvt_pk_bf16(v0[0], v0[1]); w.y = cvt_pk_bf16(v0[2], v0[3]); w.z = cvt_pk_bf16(v1[0], v1[1]); w.w = cvt_pk_bf16(v1[2], v1[3]);
                    *(u32x4*)(rowp + bj * HALF) = w; } }
    }
};
struct EpiResBf16 {
    static constexpr bool PERM = true, AFTER_DRAIN = false, APERM = false;
    const float* base32; const bf16_t* base16; bf16_t* out; int ldc; float* ps; bf16_t* ah;
    __device__ __forceinline__ void operator()(const f32x4 (&acc)[2][2][4][2], const Unit& u, int wr, int wc, int fr, int fq) const {
        const int row0 = u.pm * BM + wr * 64 + fr, col0 = u.pn * BM + wc * 32 + 8 * fq;
#pragma unroll
        for (int ai = 0; ai < 2; ++ai) {
            f32x4 b0[4][2], b1[4][2];
            if (base32) {
#pragma unroll
                for (int m = 0; m < 4; ++m)
#pragma unroll
                    for (int bj = 0; bj < 2; ++bj) { const size_t off = (size_t)(row0 + ai * HALF + m * 16) * ldc + col0 + bj * HALF; b0[m][bj] = *(const f32x4*)(base32 + off); b1[m][bj] = *(const f32x4*)(base32 + off + 4); }
            } else {
                u32x4 r[4][2];
#pragma unroll
                for (int m = 0; m < 4; ++m)
#pragma unroll
                    for (int bj = 0; bj < 2; ++bj) r[m][bj] = *(const u32x4*)(base16 + (size_t)(row0 + ai * HALF + m * 16) * ldc + col0 + bj * HALF);
#pragma unroll
                for (int m = 0; m < 4; ++m)
#pragma unroll
                    for (int bj = 0; bj < 2; ++bj) { const u32x4 q = r[m][bj];
                        b0[m][bj][0] = __builtin_bit_cast(float, q.x << 16); b0[m][bj][1] = __builtin_bit_cast(float, q.x & 0xffff0000u); b0[m][bj][2] = __builtin_bit_cast(float, q.y << 16); b0[m][bj][3] = __builtin_bit_cast(float, q.y & 0xffff0000u);
                        b1[m][bj][0] = __builtin_bit_cast(float, q.z << 16); b1[m][bj][1] = __builtin_bit_cast(float, q.z & 0xffff0000u); b1[m][bj][2] = __builtin_bit_cast(float, q.w << 16); b1[m][bj][3] = __builtin_bit_cast(float, q.w & 0xffff0000u); }
            }
#pragma unroll
            for (int m = 0; m < 4; ++m) { const int row = row0 + ai * HALF + m * 16; const size_t off = (size_t)row * ldc + col0; float ss = 0.f;
                const bool hrow = (m == 3) && (fr >= 14); const int st = ((row >> 6) + 1) & 511; const bool hw = ah && hrow && (st & 63);
                bf16_t* ahp = ah + (size_t)(2 * st + (fr - 14)) * ldc + col0;
#pragma unroll
                for (int bj = 0; bj < 2; ++bj) {
                    const f32x4 v0 = b0[m][bj] + acc[ai][bj][m][0], v1 = b1[m][bj] + acc[ai][bj][m][1];
                    ss += ((v0[0] * v0[0] + v0[1] * v0[1]) + (v0[2] * v0[2] + v0[3] * v0[3])) + ((v1[0] * v1[0] + v1[1] * v1[1]) + (v1[2] * v1[2] + v1[3] * v1[3]));
                    u32x4 w; w.x = cvt_pk_bf16(v0[0], v0[1]); w.y = cvt_pk_bf16(v0[2], v0[3]); w.z = cvt_pk_bf16(v1[0], v1[1]); w.w = cvt_pk_bf16(v1[2], v1[3]);
                    *(u32x4*)(out + off + bj * HALF) = w;
                    if (hw) *(u32x4*)(ahp + bj * HALF) = w; }
                ss += __shfl_xor(ss, 16); ss += __shfl_xor(ss, 32);
                if (fq == 0) ps[(size_t)row * 16 + u.pn * 4 + wc] = ss; }
        }
    }
};
struct EpiRope {
    static constexpr bool PERM = false, AFTER_DRAIN = false, APERM = false;
    bf16_t* KR; bf16_t* VR; bf16_t* QR; const float* ps; const float* cosT; const float* sinT;
    __device__ __forceinline__ void operator()(const f32x4 (&acc)[2][2][4][2], const Unit& u, int wr, int wc, int fr, int fq) const {
        typedef unsigned u32x2v __attribute__((ext_vector_type(2)));
        const int row0 = u.pm * BM + wr * 64 + fr; const int pn = u.pn;
#pragma unroll
        for (int ai = 0; ai < 2; ++ai) {
            float sc[4];
#pragma unroll
            for (int m = 0; m < 4; ++m) sc[m] = rstd_ps(ps, row0 + ai * HALF + m * 16);
            if (pn >= 4 && pn < 8) {
#pragma unroll
                for (int m = 0; m < 4; ++m) { const int row = row0 + ai * HALF + m * 16; const float s = sc[m]; const int b = row >> 12, sq = row & 4095;
#pragma unroll
                    for (int bj = 0; bj < 2; ++bj) { const int head = 2 * (pn - 4) + bj; bf16_t* p = VR + ((size_t)(b * 8 + head) * 4096 + sq) * 128 + 32 * wc + 4 * fq;
#pragma unroll
                        for (int n = 0; n < 2; ++n) { const f32x4 v = acc[ai][bj][m][n] * s; u32x2v w; w.x = cvt_pk_bf16(v[0], v[1]); w.y = cvt_pk_bf16(v[2], v[3]); *(u32x2v*)(p + 16 * n) = w; } } }
            } else {
                bf16_t* dst = pn < 4 ? KR : QR; const int tl = pn < 4 ? pn : pn - 8; const int d0 = 16 * (wc & 1) + 4 * fq;
                f32x4 cs[4], sn[4];
#pragma unroll
                for (int m = 0; m < 4; ++m) { const int sq = (row0 + ai * HALF + m * 16) & 4095; cs[m] = *(const f32x4*)(cosT + sq * 32 + d0); sn[m] = *(const f32x4*)(sinT + sq * 32 + d0); }
#pragma unroll
                for (int m = 0; m < 4; ++m) { const int row = row0 + ai * HALF + m * 16; const float s = sc[m]; const int b = row >> 12, sq = row & 4095;
#pragma unroll
                    for (int bj = 0; bj < 2; ++bj) { const int gc = tl * 4 + 2 * bj + (wc >> 1), head = gc >> 1, c2 = gc & 1;
                        const f32x4 x1 = acc[ai][bj][m][0] * s, x2 = acc[ai][bj][m][1] * s; const f32x4 o1 = x1 * cs[m] - x2 * sn[m], o2 = x2 * cs[m] + x1 * sn[m];
                        bf16_t* p = dst + ((size_t)((b * 8 + head) * 2 + c2) * 4096 + sq) * 64 + d0;
                        u32x2v w1, w2; w1.x = cvt_pk_bf16(o1[0], o1[1]); w1.y = cvt_pk_bf16(o1[2], o1[3]); w2.x = cvt_pk_bf16(o2[0], o2[1]); w2.y = cvt_pk_bf16(o2[2], o2[3]);
                        *(u32x2v*)p = w1; *(u32x2v*)(p + 32) = w2; } }
            }
        }
    }
};

#define DPPF(oldv, src, ctrl) __builtin_bit_cast(float, __builtin_amdgcn_update_dpp(__builtin_bit_cast(int, (float)(oldv)), __builtin_bit_cast(int, (float)(src)), (ctrl), 0xf, 0xf, false))
struct EpiConvGate {
    static constexpr bool PERM = true, AFTER_DRAIN = false;
    bf16_t* ACT; const bf16_t* UH; const float* rstd; const float* cw; const float* cb;
    __device__ __forceinline__ void operator()(const f32x4 (&acc)[2][2][4][2], const Unit& u, int wr, int wc, int fr, int fq) const {
        typedef unsigned u32x2v __attribute__((ext_vector_type(2)));
        const int row0 = u.pm * BM + wr * 64 + fr;
        float rs[2][4];
#pragma unroll
        for (int ai = 0; ai < 2; ++ai)
#pragma unroll
            for (int m = 0; m < 4; ++m) rs[ai][m] = rstd[row0 + ai * HALF + m * 16];
        u32x2v hq[2][2][4];
#pragma unroll
        for (int n = 0; n < 2; ++n)
#pragma unroll
            for (int ai = 0; ai < 2; ++ai) { const bf16_t* hp = UH + (size_t)(2 * (4 * u.pm + 2 * ai + wr)) * 5632 + u.pn * BM + wc * 32 + 8 * fq + 4 * n;
                hq[n][ai][0] = *(const u32x2v*)hp; hq[n][ai][1] = *(const u32x2v*)(hp + 5632); hq[n][ai][2] = *(const u32x2v*)(hp + HALF); hq[n][ai][3] = *(const u32x2v*)(hp + 5632 + HALF); }
#pragma unroll
        for (int n = 0; n < 2; ++n) {
            const int cha = u.pn * 128 + wc * 32 + 8 * fq + 4 * n, chg = 2816 + cha;
            f32x4 wa[3], wg[3];
#pragma unroll
            for (int j = 0; j < 3; ++j) { wa[j] = *(const f32x4*)(cw + j * 5632 + cha); wg[j] = *(const f32x4*)(cw + j * 5632 + chg); }
            const f32x4 ba = *(const f32x4*)(cb + cha), bg = *(const f32x4*)(cb + chg);
#pragma unroll
            for (int ai = 0; ai < 2; ++ai) {
                const u32x2v ha2 = hq[n][ai][0], ha1 = hq[n][ai][1], hg2 = hq[n][ai][2], hg1 = hq[n][ai][3];
                f32x4 pa, pg;
                { f32x4 a1, a2, g1, g2;
                  a1[0] = __builtin_bit_cast(float, ha1.x << 16); a1[1] = __builtin_bit_cast(float, ha1.x & 0xffff0000u); a1[2] = __builtin_bit_cast(float, ha1.y << 16); a1[3] = __builtin_bit_cast(float, ha1.y & 0xffff0000u);
                  a2[0] = __builtin_bit_cast(float, ha2.x << 16); a2[1] = __builtin_bit_cast(float, ha2.x & 0xffff0000u); a2[2] = __builtin_bit_cast(float, ha2.y << 16); a2[3] = __builtin_bit_cast(float, ha2.y & 0xffff0000u);
                  g1[0] = __builtin_bit_cast(float, hg1.x << 16); g1[1] = __builtin_bit_cast(float, hg1.x & 0xffff0000u); g1[2] = __builtin_bit_cast(float, hg1.y << 16); g1[3] = __builtin_bit_cast(float, hg1.y & 0xffff0000u);
                  g2[0] = __builtin_bit_cast(float, hg2.x << 16); g2[1] = __builtin_bit_cast(float, hg2.x & 0xffff0000u); g2[2] = __builtin_bit_cast(float, hg2.y << 16); g2[3] = __builtin_bit_cast(float, hg2.y & 0xffff0000u);
                  const bool is14 = (fr == 14);
#pragma unroll
                  for (int i = 0; i < 4; ++i) { pa[i] = is14 ? a2[i] : a1[i]; pg[i] = is14 ? g2[i] : g1[i]; } }
#pragma unroll
                for (int m = 0; m < 4; ++m) {
                    const int row = row0 + ai * HALF + m * 16; const float s = rs[ai][m];
                    const f32x4 ua = acc[ai][0][m][n] * s, ug = acc[ai][1][m][n] * s;
                    float r[4];
#pragma unroll
                    for (int i = 0; i < 4; ++i) {
                        const float oa1 = DPPF(0.f, pa[i], 0x121), oa2 = DPPF(0.f, pa[i], 0x122), og1 = DPPF(0.f, pg[i], 0x121), og2 = DPPF(0.f, pg[i], 0x122);
                        const float a1 = DPPF(oa1, ua[i], 0x111), a2 = DPPF(oa2, ua[i], 0x112), g1 = DPPF(og1, ug[i], 0x111), g2 = DPPF(og2, ug[i], 0x112);
                        const float ca = wa[0][i] * a2 + wa[1][i] * a1 + wa[2][i] * ua[i] + ba[i];
                        const float cg = wg[0][i] * g2 + wg[1][i] * g1 + wg[2][i] * ug[i] + bg[i];
                        r[i] = ca * (cg * __builtin_amdgcn_rcpf(1.0f + __builtin_amdgcn_exp2f(-1.4426950408889634f * cg)));
                    }
                    pa = ua; pg = ug;
                    u32x2v w; w.x = cvt_pk_bf16(r[0], r[1]); w.y = cvt_pk_bf16(r[2], r[3]);
                    *(u32x2v*)(ACT + (size_t)row * 2816 + cha) = w;
                }
            }
        }
    }
};
template <class Epi, class Sched, bool ALIGN_EPI = false, bool SP2 = false>
__device__ __forceinline__ void gemm_phase(PG8_LAS unsigned char* lds, const Gemm g, const Sched& S, const Epi& E) {
    int tid_l = threadIdx.x; asm volatile("" : "+v"(tid_l));
    const int tid = tid_l, wid = __builtin_amdgcn_readfirstlane(tid >> 6), lane = tid & 63, wr = wid >> 2, wc = wid & 3, fr = lane & 15, fq = lane >> 4;
    const int K = g.K, nt = K / BK;
    unsigned voffA[2], voffB[2];
#pragma unroll
    for (int i = 0; i < 2; ++i) { int R, C; stage_rc(tid * 16 + i * 8192, R, C); const int Rb = Epi::PERM ? ((R & ~31) + perm32(R & 31)) : R;
        voffA[i] = (unsigned)(R * K + C) * 2u; voffB[i] = (unsigned)(Rb * K + C) * 2u; }
    const size_t kstep = (size_t)(BK * 2);
    const size_t hstep = (size_t)HALF * K * 2;
    const size_t tstep = 2 * hstep;
    const unsigned ldsw = (unsigned)wid * 1024u;
    const int aoff = lds_byte(wr * 64 + fr, fq * 8), boff = lds_byte(wc * 32 + fr, fq * 8);
#define PG8_SA(b, h) (((b) * 2 + (h)) * HTB)
#define PG8_SB(b, h) ((4 + (b) * 2 + (h)) * HTB)
#define PG8_STAGE(bufoff, gbase, voff) do { _Pragma("unroll") for (int _i = 0; _i < 2; ++_i) \
        __builtin_amdgcn_global_load_lds((const unsigned*)((const char*)(gbase) + (voff)[_i]), (PG8_LAS unsigned*)(lds + (bufoff) + ldsw + _i * 8192), 16, 0, 0); } while (0)
#define PG8_LDA(dst, b, h) do { _Pragma("unroll") for (int m = 0; m < 4; ++m) _Pragma("unroll") for (int k = 0; k < 2; ++k) dst[m][k] = *(const PG8_LAS bf16x8*)(lds + PG8_SA(b, h) + aoff + m * 2048 + k * 1024); } while (0)
#define PG8_LDB(dst, b, h) do { _Pragma("unroll") for (int n = 0; n < 2; ++n) _Pragma("unroll") for (int k = 0; k < 2; ++k) dst[n][k] = *(const PG8_LAS bf16x8*)(lds + PG8_SB(b, h) + boff + n * 2048 + k * 1024); } while (0)
#define PG8_MMA(ai, bj, At, Bt) do { __builtin_amdgcn_s_setprio(1); _Pragma("unroll") for (int m = 0; m < 4; ++m) _Pragma("unroll") for (int n = 0; n < 2; ++n) _Pragma("unroll") for (int k = 0; k < 2; ++k) \
        acc[ai][bj][m][n] = __builtin_amdgcn_mfma_f32_16x16x32_bf16(Bt[n][k], At[m][k], acc[ai][bj][m][n], 0, 0, 0); __builtin_amdgcn_s_setprio(0); } while (0)
#define PG8_WAIT_V(n) asm volatile("s_waitcnt vmcnt(" #n ")" ::: "memory")
#define PG8_WAIT_L(n) asm volatile("s_waitcnt lgkmcnt(" #n ")" ::: "memory")
#define PG8_BAR __builtin_amdgcn_s_barrier()
#define PG8_SCHED __builtin_amdgcn_sched_barrier(0)
    Unit cur, nxt; int ui = 0;
    if (!S.next(0, cur)) return;
    f32x4 acc[2][2][4][2];
#pragma unroll
    for (int a = 0; a < 2; ++a)
#pragma unroll
        for (int b = 0; b < 2; ++b)
#pragma unroll
            for (int m = 0; m < 4; ++m)
#pragma unroll
                for (int n = 0; n < 2; ++n) acc[a][b][m][n] = (f32x4){0.f, 0.f, 0.f, 0.f};
    bf16x8 At[4][2], B0[2][2], B1[2][2];
    const char* cA = (const char*)g.A + (size_t)cur.pm * tstep; const char* cB = (const char*)g.Bt + (size_t)cur.pn * tstep;
    S.a_ready(cur);
    if constexpr (SP2) {
        PG8_STAGE(PG8_SB(0, 0), cB, voffB); PG8_STAGE(PG8_SB(0, 1), cB + hstep, voffB); PG8_STAGE(PG8_SA(0, 0), cA, voffA); PG8_STAGE(PG8_SA(0, 1), cA + hstep, voffA);
        if (wr == 1) PG8_BAR;
        PG8_WAIT_V(2); PG8_BAR;
        PG8_STAGE(PG8_SB(1, 0), cB + kstep, voffB); PG8_STAGE(PG8_SA(1, 0), cA + kstep, voffA); PG8_STAGE(PG8_SB(1, 1), cB + hstep + kstep, voffB);
        PG8_WAIT_V(6); PG8_BAR;
    } else {
        PG8_STAGE(PG8_SB(0, 0), cB, voffB); PG8_STAGE(PG8_SA(0, 0), cA, voffA); PG8_STAGE(PG8_SB(0, 1), cB + hstep, voffB); PG8_STAGE(PG8_SA(0, 1), cA + hstep, voffA);
        if (wr == 1) PG8_BAR;
        PG8_WAIT_V(4); PG8_BAR;
        PG8_STAGE(PG8_SB(1, 0), cB + kstep, voffB); PG8_STAGE(PG8_SA(1, 0), cA + kstep, voffA); PG8_STAGE(PG8_SB(1, 1), cB + hstep + kstep, voffB);
        PG8_WAIT_V(6); PG8_BAR;
    }
    for (;;) {
        const bool has_next = S.next(ui + 1, nxt);
        const char* nA = has_next ? (const char*)g.A + (size_t)nxt.pm * tstep : cA; const char* nB = has_next ? (const char*)g.Bt + (size_t)nxt.pn * tstep : cB;
        for (int t = 0; t < nt; t += 2) {
            const bool last = (t == nt - 2);
            const char* a1 = cA + (size_t)(t + 1) * kstep;
            const char* a2 = last ? nA : cA + (size_t)(t + 2) * kstep; const char* b2 = last ? nB : cB + (size_t)(t + 2) * kstep;
            const char* a3 = a2 + kstep; const char* b3 = b2 + kstep;
            if (last && has_next) S.a_ready(nxt);
            if constexpr (SP2) {
            PG8_LDB(B0, 0, 0); PG8_LDB(B1, 0, 1); PG8_SCHED; PG8_LDA(At, 0, 0); PG8_STAGE(PG8_SA(1, 1), a1 + hstep, voffA);
            PG8_WAIT_V(8); PG8_WAIT_L(0); PG8_BAR; PG8_MMA(0, 0, At, B0); PG8_MMA(0, 1, At, B1); PG8_BAR; PG8_SCHED;
            PG8_LDA(At, 0, 1); PG8_STAGE(PG8_SB(0, 0), b2, voffB); PG8_STAGE(PG8_SB(0, 1), b2 + hstep, voffB); PG8_STAGE(PG8_SA(0, 0), a2, voffA);
            PG8_WAIT_V(8); PG8_WAIT_L(0); PG8_BAR; PG8_MMA(1, 0, At, B0); PG8_MMA(1, 1, At, B1); PG8_BAR; PG8_SCHED;
            PG8_LDB(B0, 1, 0); PG8_LDB(B1, 1, 1); PG8_SCHED; PG8_LDA(At, 1, 0); PG8_STAGE(PG8_SA(0, 1), a2 + hstep, voffA);
            PG8_WAIT_V(8); PG8_WAIT_L(0); PG8_BAR; PG8_MMA(0, 0, At, B0); PG8_MMA(0, 1, At, B1); PG8_BAR; PG8_SCHED;
            PG8_LDA(At, 1, 1); PG8_STAGE(PG8_SB(1, 0), b3, voffB); PG8_STAGE(PG8_SB(1, 1), b3 + hstep, voffB); PG8_STAGE(PG8_SA(1, 0), a3, voffA);
            PG8_WAIT_V(8); PG8_WAIT_L(0); PG8_BAR; PG8_MMA(1, 0, At, B0); PG8_MMA(1, 1, At, B1); PG8_BAR; PG8_SCHED;
            } else {
            PG8_LDB(B0, 0, 0); PG8_SCHED; PG8_LDA(At, 0, 0); PG8_STAGE(PG8_SA(1, 1), a1 + hstep, voffA);
            PG8_WAIT_L(8); PG8_BAR; PG8_WAIT_L(0); PG8_MMA(0, 0, At, B0); PG8_BAR; PG8_SCHED;
            PG8_LDB(B1, 0, 1); PG8_STAGE(PG8_SB(0, 0), b2, voffB);
            PG8_BAR; PG8_WAIT_L(0); PG8_MMA(0, 1, At, B1); PG8_BAR;
            PG8_LDA(At, 0, 1); PG8_STAGE(PG8_SA(0, 0), a2, voffA);
            PG8_BAR; PG8_WAIT_L(0); PG8_MMA(1, 0, At, B0); PG8_BAR; PG8_SCHED;
            PG8_STAGE(PG8_SB(0, 1), b2 + hstep, voffB);
            PG8_WAIT_V(6); PG8_BAR; PG8_MMA(1, 1, At, B1); PG8_BAR;
            PG8_LDB(B0, 1, 0); PG8_SCHED; PG8_LDA(At, 1, 0); PG8_STAGE(PG8_SA(0, 1), a2 + hstep, voffA);
            PG8_WAIT_L(8); PG8_BAR; PG8_WAIT_L(0); PG8_MMA(0, 0, At, B0); PG8_BAR; PG8_SCHED;
            PG8_LDB(B1, 1, 1); PG8_STAGE(PG8_SB(1, 0), b3, voffB);
            PG8_BAR; PG8_WAIT_L(0); PG8_MMA(0, 1, At, B1); PG8_BAR;
            PG8_LDA(At, 1, 1); PG8_STAGE(PG8_SA(1, 0), a3, voffA);
            PG8_BAR; PG8_WAIT_L(0); PG8_MMA(1, 0, At, B0); PG8_BAR; PG8_SCHED;
            PG8_STAGE(PG8_SB(1, 1), b3 + hstep, voffB);
            PG8_WAIT_V(6); PG8_BAR; PG8_MMA(1, 1, At, B1); PG8_BAR;
            }
        }
        if constexpr (ALIGN_EPI) { if (wr == 0) PG8_BAR; }
        if constexpr (!Epi::AFTER_DRAIN) { E(acc, cur, wr, wc, fr, fq); S.done(cur); }
        if (!has_next) break;
#pragma unroll
        for (int a = 0; a < 2; ++a)
#pragma unroll
            for (int b = 0; b < 2; ++b)
#pragma unroll
                for (int m = 0; m < 4; ++m)
#pragma unroll
                    for (int n = 0; n < 2; ++n) acc[a][b][m][n] = (f32x4){0.f, 0.f, 0.f, 0.f};
        cur = nxt; cA = nA; cB = nB; ++ui;
        if constexpr (ALIGN_EPI) { if (wr == 1) PG8_BAR; }
    }
    PG8_WAIT_V(0);
    if constexpr (!ALIGN_EPI) { if (wr == 0) PG8_BAR; }
    PG8_BAR;
    if constexpr (Epi::AFTER_DRAIN) { E.fused(acc, cur, wr, wc, fr, fq, lds, wid, lane); S.done(cur); }
#undef PG8_SA
#undef PG8_SB
#undef PG8_STAGE
#undef PG8_LDA
#undef PG8_LDB
#undef PG8_MMA
#undef PG8_WAIT_V
#undef PG8_WAIT_L
#undef PG8_BAR
#undef PG8_SCHED
}
}
constexpr int NWAVES = 8;
constexpr int BATCH = 8, SEQ = 4096, DM = 1024, T = BATCH * SEQ, DFF = 2816, NBN = T / 64;
constexpr float EPS = 1e-6f, LOG2E_ = 1.4426950408889634f;
constexpr float LAM_INIT = 0.35550906759096934f;
constexpr size_t MiB = 1u << 20;
constexpr size_t WS_CTL = 0, CTL_ZERO_BYTES = 1 * MiB;
constexpr size_t WS_W1T = 2 * MiB, WS_WG1T = 8 * MiB, WS_WO1T = 9 * MiB, WS_WIN0T = 11 * MiB, WS_WOUT0T = 22 * MiB, WS_WKVQT = 28 * MiB, WS_WO2T = 34 * MiB, WS_WIN1T = 36 * MiB, WS_WOUT1T = 47 * MiB;
constexpr size_t WS_COS = 53 * MiB, WS_SIN = 53 * MiB + 512 * 1024, WS_RSTD = 54 * MiB, WS_DEC = 55 * MiB;
constexpr size_t WS_XB = 64 * MiB;
constexpr size_t WS_BIG = 128 * MiB;
constexpr size_t WS_QKVG = WS_BIG;
constexpr size_t WS_QI = 320 * MiB, WS_KET = 352 * MiB, WS_PM = 384 * MiB, WS_VT = 400 * MiB;
constexpr size_t WS_OGATE = 320 * MiB;
constexpr size_t WS_U = WS_BIG;
constexpr size_t WS_ACT = 320 * MiB;
constexpr size_t WS_KR = 128 * MiB, WS_VR = 192 * MiB, WS_QR = 256 * MiB, WS_AO = 320 * MiB;
constexpr size_t WS_UH = 496 * MiB, WS_AH = 507 * MiB, WS_RSTDH = 54 * MiB + 256 * 1024;
constexpr size_t WS_PS = 56 * MiB;
constexpr size_t WS_END = 512 * MiB;
constexpr int CW_BAR = 4096;
constexpr int RING_BYTES = 131072, LDSCTL_OFF = 147456, MISC_OFF = LDSCTL_OFF + 320, LDS_BYTES = 155648;

#define GAS __attribute__((address_space(1)))
#define LAS __attribute__((address_space(3)))
typedef unsigned short bf16;
typedef unsigned v4u __attribute__((ext_vector_type(4)));
typedef unsigned v2u __attribute__((ext_vector_type(2)));
typedef float f32x4 __attribute__((ext_vector_type(4)));
typedef float f32x16 __attribute__((ext_vector_type(16)));
typedef short bf16x8 __attribute__((ext_vector_type(8)));
typedef short s16x4 __attribute__((ext_vector_type(4)));
typedef GAS unsigned gu32;
#define RLX_AGENT __ATOMIC_RELAXED, __HIP_MEMORY_SCOPE_AGENT
#define LDS_WAIT() asm volatile("s_waitcnt lgkmcnt(0)" ::: "memory")
__device__ __forceinline__ unsigned f2bf(float f) { unsigned u = __builtin_bit_cast(unsigned, f); return (u + 0x7fffu + ((u >> 16) & 1u)) >> 16; }
typedef float f32x2_t __attribute__((ext_vector_type(2))); typedef __bf16 bf16x2_t __attribute__((ext_vector_type(2)));
__device__ __forceinline__ unsigned cvtpk(float lo, float hi) { f32x2_t v = {lo, hi}; bf16x2_t b = __builtin_convertvector(v, bf16x2_t); return __builtin_bit_cast(unsigned, b); }
__device__ __forceinline__ unsigned pk2(float lo, float hi) { return cvtpk(lo, hi); }
__device__ __forceinline__ float bf2f(unsigned short x) { return __builtin_bit_cast(float, (unsigned)x << 16); }
__device__ __forceinline__ float bflo(unsigned w) { return __builtin_bit_cast(float, w << 16); }
__device__ __forceinline__ float bfhi(unsigned w) { return __builtin_bit_cast(float, w & 0xffff0000u); }
#define MFMA_BF16(a, b, c) __builtin_amdgcn_mfma_f32_32x32x16_bf16(a, b, c, 0, 0, 0)

#define XB_TMO      128
#define XB_XCNT(j)  (256  + 64 * (j))
#define XB_XSUB(j)  (1280 + 64 * (j))
#define XB_XGEN(j)  (2304 + 64 * (j))
#define XB_TOP      3328
#define XB_TOPGEN   3392
#define XCD_BAR_WORDS 3456
#define XB_SPIN_CAP (1u << 18)

__device__ __forceinline__ unsigned xb_ld(unsigned* p)              { return __hip_atomic_load(p, __ATOMIC_RELAXED, __HIP_MEMORY_SCOPE_AGENT); }
__device__ __forceinline__ unsigned xb_add(unsigned* p, unsigned v) { return __hip_atomic_fetch_add(p, v, __ATOMIC_RELAXED, __HIP_MEMORY_SCOPE_AGENT); }
__device__ __forceinline__ unsigned xb_xcc_id() { return (unsigned)__builtin_amdgcn_s_getreg((3 << 11) | 20) & 0xFu; }
#define XB_SPIN(cond, bar) do { unsigned _sp = 0; while (cond) { __builtin_amdgcn_s_sleep(1); \
    if ((++_sp & 255u) == 0u) { if (xb_ld(&(bar)[XB_TMO])) break; if (_sp > XB_SPIN_CAP) { atomicAdd(&(bar)[XB_TMO], 1u); break; } } } } while (0)

struct XcdBarrier {
    unsigned* bar; unsigned x;
    volatile LAS unsigned* st;
};

__device__ __forceinline__ XcdBarrier xcd_barrier_post(unsigned* bar, volatile LAS unsigned* st) {
    XcdBarrier b; b.bar = bar; b.x = xb_xcc_id(); b.st = st;
    if (threadIdx.x == 0) (void)xb_add(&bar[XB_XCNT(b.x)], 1u);
    return b;
}
__device__ __forceinline__ void xcd_barrier_complete(unsigned* bar, unsigned x, unsigned& nloc, unsigned& nx) {
    const unsigned G = gridDim.x * gridDim.y * gridDim.z;
    unsigned sum, cnt, mine, sp = 0u;
    for (;;) {
        sum = 0u; cnt = 0u; mine = 0u;
#pragma unroll
        for (unsigned j = 0; j < 16; ++j) { const unsigned c = xb_ld(&bar[XB_XCNT(j)]); sum += c; cnt += (c > 0u) ? 1u : 0u; mine = (j == x) ? c : mine; }
        if (sum == G) break;
        __builtin_amdgcn_s_sleep(1);
        if ((++sp & 255u) == 0u) { if (xb_ld(&bar[XB_TMO])) break; if (sp > XB_SPIN_CAP) { atomicAdd(&bar[XB_TMO], 1u); break; } }
    }
    nloc = mine > 0u ? mine : 1u; nx = cnt > 0u ? cnt : 1u;
}

__device__ __forceinline__ void xcd_barrier(const XcdBarrier& b) {
    asm volatile("s_waitcnt vmcnt(0)" ::: "memory");
    __syncthreads();
    if (threadIdx.x == 0) {
        unsigned* bar = b.bar; asm volatile("" : "+s"(bar));
        __builtin_amdgcn_s_waitcnt(0);
        unsigned nloc = b.st[0], nx = b.st[1];
        if (nloc == 0u) { xcd_barrier_complete(bar, b.x, nloc, nx); b.st[0] = nloc; b.st[1] = nx; }
        const unsigned old = xb_add(&bar[XB_XSUB(b.x)], 1u);
        const unsigned gen = old / nloc;
        if (old + 1u == (gen + 1u) * nloc) {
            __builtin_amdgcn_fence(__ATOMIC_RELEASE, "agent");
            asm volatile("s_waitcnt vmcnt(0)" ::: "memory");
            const unsigned og = xb_add(&bar[XB_TOP], 1u);
            const unsigned tg = og / nx;
            if (og + 1u == (tg + 1u) * nx) xb_add(&bar[XB_TOPGEN], 1u);
            else XB_SPIN(xb_ld(&bar[XB_TOPGEN]) == tg, bar);
            __builtin_amdgcn_fence(__ATOMIC_ACQUIRE, "agent");
            xb_add(&bar[XB_XGEN(b.x)], 1u);
            asm volatile("s_waitcnt vmcnt(0)" ::: "memory");
        } else {
            XB_SPIN(xb_ld(&bar[XB_XGEN(b.x)]) == gen, bar);
            __builtin_amdgcn_fence(__ATOMIC_ACQUIRE, "agent");
            asm volatile("s_waitcnt vmcnt(0)" ::: "memory");
        }
    }
    __syncthreads();
}


__device__ __forceinline__ float wave_sum(float v) {
#pragma unroll
    for (int o = 1; o < 64; o <<= 1) v += __shfl_xor(v, o);
    return v;
}

struct Args { const float* in[20]; float* out; unsigned char* ws; int ph_lo, ph_hi; };
enum { I_X = 0, I_ATTN_NORM, I_FFN_NORM, I_WQKVG, I_WGK1, I_WGK2, I_BGK, I_ONORM, I_GLA_WO, I_KVNORM, I_WKV, I_WQ, I_LAMBDA, I_SUBLN, I_DIFF_WO, I_WIN, I_CONVW, I_CONVB, I_WOUT, I_FINAL };

template <int MAP> __device__ __forceinline__ int map_row(int s) {
    if (MAP == 0) return s;
    if (MAP == 1) { const int half = s >= DFF ? 1 : 0, j = s - half * DFF; return (j >> 7) * 256 + half * 128 + (j & 127); }
    const int tile = s >> 8, cidx = (s >> 6) & 3, d = s & 63, bj = cidx >> 1, wcp = cidx & 1, n = d >> 5, dd = d & 31;
    return tile * 256 + 128 * bj + 32 * (2 * wcp + (dd >> 4)) + 16 * n + 4 * ((dd & 15) >> 2) + (dd & 3);
}
template <int MAP> __device__ __forceinline__ void transpose_item(const float* W, int ldw, int K, int N, const float* gain, float scale, bf16* WT, int row_off, LAS float* scr, int item, int lane) {
    const int nblk = N / 32, kb = item / nblk, nb = item % nblk, k0 = 64 * kb, n0 = 32 * nb;
#pragma unroll
    for (int i = 0; i < 8; ++i) { const int kk = 8 * i + (lane >> 3), n4 = (lane & 7) * 4; const float g = gain ? gain[k0 + kk] * scale : scale;
        const f32x4 w = *(const f32x4*)(W + (size_t)(k0 + kk) * ldw + n0 + n4);
        scr[kk * 33 + n4] = w[0] * g; scr[kk * 33 + n4 + 1] = w[1] * g; scr[kk * 33 + n4 + 2] = w[2] * g; scr[kk * 33 + n4 + 3] = w[3] * g; }
    LDS_WAIT(); asm volatile("" ::: "memory");
    const int c = lane & 7;
#pragma unroll
    for (int j = 0; j < 4; ++j) { const int n = (lane >> 3) + 8 * j; const LAS float* s = scr + (8 * c) * 33 + n;
        v4u o; o.x = pk2(s[0 * 33], s[1 * 33]); o.y = pk2(s[2 * 33], s[3 * 33]); o.z = pk2(s[4 * 33], s[5 * 33]); o.w = pk2(s[6 * 33], s[7 * 33]);
        *(v4u*)(WT + (size_t)(row_off + map_row<MAP>(n0 + n)) * K + k0 + 8 * c) = o; }
    LDS_WAIT(); asm volatile("" ::: "memory");
}
__device__ __forceinline__ void sincos_d(double x, double& s, double& c) {
    const double k = __builtin_rint(x * 0.15915494309189535);
    double r = __builtin_fma(-k, 6.283185307179586, x); r = __builtin_fma(-k, 2.4492935982947064e-16, r);
    const double y = r * 0.25, y2 = y * y;
    double sy = 1.0 - y2 * (1.0 / 272.0);
    sy = 1.0 - y2 * (1.0 / 210.0) * sy; sy = 1.0 - y2 * (1.0 / 156.0) * sy; sy = 1.0 - y2 * (1.0 / 110.0) * sy; sy = 1.0 - y2 * (1.0 / 72.0) * sy;
    sy = 1.0 - y2 * (1.0 / 42.0) * sy; sy = 1.0 - y2 * (1.0 / 20.0) * sy; sy = 1.0 - y2 * (1.0 / 6.0) * sy; sy = y * sy;
    double cy = 1.0 - y2 * (1.0 / 240.0);
    cy = 1.0 - y2 * (1.0 / 182.0) * cy; cy = 1.0 - y2 * (1.0 / 132.0) * cy; cy = 1.0 - y2 * (1.0 / 90.0) * cy; cy = 1.0 - y2 * (1.0 / 56.0) * cy;
    cy = 1.0 - y2 * (1.0 / 30.0) * cy; cy = 1.0 - y2 * (1.0 / 12.0) * cy; cy = 1.0 - y2 * 0.5 * cy;
    const double s2 = 2.0 * sy * cy, c2 = 1.0 - 2.0 * sy * sy;
    s = 2.0 * s2 * c2; c = 1.0 - 2.0 * s2 * s2;
}
__device__ __forceinline__ void row_to_bf16_ps(const float* xrow, bf16* orow, float* ps_row, int lane) {
    const f32x4* xr = (const f32x4*)xrow + lane;
    f32x4 v[4]; float s = 0.f;
#pragma unroll
    for (int j = 0; j < 4; ++j) { v[j] = xr[64 * j]; s += (v[j].x * v[j].x + v[j].y * v[j].y) + (v[j].z * v[j].z + v[j].w * v[j].w); }
    s = wave_sum(s);
    if (lane < 16) ps_row[lane] = lane == 0 ? s : 0.f;
    unsigned long long* o8 = (unsigned long long*)orow + lane;
#pragma unroll
    for (int j = 0; j < 4; ++j) o8[64 * j] = (unsigned long long)pk2(v[j].x, v[j].y) | ((unsigned long long)pk2(v[j].z, v[j].w) << 32);
}
constexpr int WI0 = (DM / 64) * (3072 / 32), WI1 = (DM / 64) * (DM / 32), WI2 = (DM / 64) * (2 * DFF / 32), WI3 = (DFF / 64) * (DM / 32);
constexpr int W_NITEMS = WI0 + WI1 + WI2 + WI3 + 3 * WI1 + WI1 + WI2 + WI3, W_EARLY = WI0 + WI1 + WI2;
__device__ __forceinline__ void p0_weights(const Args& A, LAS unsigned char* lds, int gw, int NGW, int lo, int hi, int wave, int lane) {
    unsigned char* ws = A.ws;
    LAS float* scr = (LAS float*)(lds + wave * 16384);
    constexpr int I0 = WI0, I1 = WI1, I2 = WI2, I3 = WI3;
    const float QS = 0.18033688011112042f;
    for (int it = lo + gw; it < hi; it += NGW) {
        int r = it;
        if (r < I0) { transpose_item<0>(A.in[I_WQKVG], 3072, DM, 3072, A.in[I_ATTN_NORM], 1.f, (bf16*)(ws + WS_W1T), 0, scr, r, lane); continue; } r -= I0;
        if (r < I1) { transpose_item<0>(A.in[I_GLA_WO], DM, DM, DM, nullptr, 1.f, (bf16*)(ws + WS_WO1T), 0, scr, r, lane); continue; } r -= I1;
        if (r < I2) { transpose_item<1>(A.in[I_WIN], 2 * DFF, DM, 2 * DFF, A.in[I_FFN_NORM], 1.f, (bf16*)(ws + WS_WIN0T), 0, scr, r, lane); continue; } r -= I2;
        if (r < I3) { transpose_item<0>(A.in[I_WOUT], DM, DFF, DM, nullptr, 1.f, (bf16*)(ws + WS_WOUT0T), 0, scr, r, lane); continue; } r -= I3;
        if (r < I1) { transpose_item<2>(A.in[I_WKV], 2048, DM, 1024, A.in[I_KVNORM], 1.f, (bf16*)(ws + WS_WKVQT), 0, scr, r, lane); continue; } r -= I1;
        if (r < I1) { transpose_item<0>(A.in[I_WKV] + 1024, 2048, DM, 1024, A.in[I_KVNORM], 1.f, (bf16*)(ws + WS_WKVQT), 1024, scr, r, lane); continue; } r -= I1;
        if (r < I1) { transpose_item<2>(A.in[I_WQ], DM, DM, 1024, A.in[I_ATTN_NORM] + DM, QS, (bf16*)(ws + WS_WKVQT), 2048, scr, r, lane); continue; } r -= I1;
        if (r < I1) { transpose_item<0>(A.in[I_DIFF_WO], DM, DM, DM, nullptr, 1.f, (bf16*)(ws + WS_WO2T), 0, scr, r, lane); continue; } r -= I1;
        if (r < I2) { transpose_item<1>(A.in[I_WIN] + (size_t)DM * 2 * DFF, 2 * DFF, DM, 2 * DFF, A.in[I_FFN_NORM] + DM, 1.f, (bf16*)(ws + WS_WIN1T), 0, scr, r, lane); continue; } r -= I2;
        transpose_item<0>(A.in[I_WOUT] + (size_t)DFF * DM, DM, DFF, DM, nullptr, 1.f, (bf16*)(ws + WS_WOUT1T), 0, scr, r, lane);
    }
}
__device__ __forceinline__ void p0_prologue(const Args& A, LAS unsigned char* lds, int vcu, int G, int wave, int lane, int tid) {
    unsigned char* ws = A.ws;
    const int gw = vcu * NWAVES + wave, NGW = G * NWAVES;
    p0_weights(A, lds, gw, NGW, 0, W_EARLY, wave, lane);
    const int gt = vcu * (NWAVES * 64) + tid, NGT = G * NWAVES * 64;
    for (int i = gt; i < 32 * DM; i += NGT) { const int j = i >> 10, k = i & 1023; ((bf16*)(ws + WS_WG1T))[i] = j < 16 ? (bf16)f2bf(A.in[I_WGK1][k * 16 + j] * A.in[I_ATTN_NORM][k]) : (bf16)0; }
    for (int i = gt; i < SEQ * 32; i += NGT) { const int pos = i >> 5, fi = i & 31; double inv = 1.0; for (int q = 0; q < fi; ++q) inv *= 0.7498942093324558;
        double s, c; sincos_d((double)pos * inv, s, c); ((float*)(ws + WS_COS))[i] = (float)c; ((float*)(ws + WS_SIN))[i] = (float)s; }
    for (int i = gt; i < 1024 * DM / 8; i += NGT) ((v4u*)(ws + WS_AH))[i] = (v4u){0u, 0u, 0u, 0u};
    for (int m = gw; m < T; m += 2 * NGW) {
        const int m2 = m + NGW; const bool h2 = m2 < T;
        const f32x4* xa = (const f32x4*)(A.in[I_X] + (size_t)m * DM) + lane; const f32x4* xb2 = (const f32x4*)(A.in[I_X] + (size_t)(h2 ? m2 : m) * DM) + lane;
        f32x4 va[4], vb[4]; float sa = 0.f, sb = 0.f;
#pragma unroll
        for (int j = 0; j < 4; ++j) { va[j] = xa[64 * j]; vb[j] = xb2[64 * j]; }
#pragma unroll
        for (int j = 0; j < 4; ++j) { sa += (va[j].x * va[j].x + va[j].y * va[j].y) + (va[j].z * va[j].z + va[j].w * va[j].w); sb += (vb[j].x * vb[j].x + vb[j].y * vb[j].y) + (vb[j].z * vb[j].z + vb[j].w * vb[j].w); }
        sa = wave_sum(sa); sb = wave_sum(sb);
        if (lane == 0) { ((float*)(ws + WS_RSTD))[m] = __builtin_amdgcn_rsqf(sa * (1.0f / DM) + EPS); if (h2) ((float*)(ws + WS_RSTD))[m2] = __builtin_amdgcn_rsqf(sb * (1.0f / DM) + EPS); }
        unsigned long long* oa = (unsigned long long*)((bf16*)(ws + WS_XB) + (size_t)m * DM) + lane; unsigned long long* ob = (unsigned long long*)((bf16*)(ws + WS_XB) + (size_t)m2 * DM) + lane;
#pragma unroll
        for (int j = 0; j < 4; ++j) { oa[64 * j] = (unsigned long long)pk2(va[j].x, va[j].y) | ((unsigned long long)pk2(va[j].z, va[j].w) << 32);
            if (h2) ob[64 * j] = (unsigned long long)pk2(vb[j].x, vb[j].y) | ((unsigned long long)pk2(vb[j].z, vb[j].w) << 32); }
    }
}

__device__ __forceinline__ void final_norm_phase(const bf16* HB, const float* PS, float* out, const float* w, int vcu, int G, int wave, int lane) {
    const int gw = vcu * NWAVES + wave, NGW = G * NWAVES;
    const f32x4* wp = (const f32x4*)w + 2 * lane; const f32x4 w00 = wp[0], w01 = wp[1], w10 = wp[128], w11 = wp[129];
    for (int m0 = gw; m0 < T; m0 += 4 * NGW) {
        v4u r0[4], r1[4]; float rs[4];
#pragma unroll
        for (int q = 0; q < 4; ++q) { const int m = m0 + q * NGW; const int mm = m < T ? m : m0; const v4u* hp = (const v4u*)(HB + (size_t)mm * DM) + lane; r0[q] = hp[0]; r1[q] = hp[64]; rs[q] = pg8::rstd_ps(PS, mm); }
#pragma unroll
        for (int q = 0; q < 4; ++q) { const int m = m0 + q * NGW; if (m < T) { f32x4* op = (f32x4*)(out + (size_t)m * DM) + 2 * lane; const float rstd = rs[q];
            f32x4 a, b; a[0] = bflo(r0[q].x); a[1] = bfhi(r0[q].x); a[2] = bflo(r0[q].y); a[3] = bfhi(r0[q].y); b[0] = bflo(r0[q].z); b[1] = bfhi(r0[q].z); b[2] = bflo(r0[q].w); b[3] = bfhi(r0[q].w);
            op[0] = a * rstd * w00; op[1] = b * rstd * w01;
            a[0] = bflo(r1[q].x); a[1] = bfhi(r1[q].x); a[2] = bflo(r1[q].y); a[3] = bfhi(r1[q].y); b[0] = bflo(r1[q].z); b[1] = bfhi(r1[q].z); b[2] = bflo(r1[q].w); b[3] = bfhi(r1[q].w);
            op[128] = a * rstd * w10; op[129] = b * rstd * w11; } }
    }
}
__device__ __forceinline__ void gla_gate_phase(const bf16* O, const bf16* QKVG, const float* onw, bf16* OG, int vcu, int G, int wave, int lane) {
    const int gw = vcu * NWAVES + wave, NGW = G * NWAVES;
    const f32x4* wp = (const f32x4*)(onw + 16 * (lane & 15)); const f32x4 wq[4] = {wp[0], wp[1], wp[2], wp[3]};
    for (int m0 = gw; m0 < T; m0 += 4 * NGW) {
        v4u o0[4], o1[4], g0[4], g1[4];
#pragma unroll
        for (int q = 0; q < 4; ++q) { const int m = m0 + q * NGW; const int mm = m < T ? m : m0; const v4u* op = (const v4u*)(O + (size_t)mm * DM + 16 * lane); const v4u* gp = (const v4u*)(QKVG + (size_t)mm * 3072 + 2048 + 16 * lane);
            o0[q] = op[0]; o1[q] = op[1]; g0[q] = gp[0]; g1[q] = gp[1]; }
#pragma unroll
        for (int q = 0; q < 4; ++q) { const int m = m0 + q * NGW; if (m < T) {
            float ov[16], gv[16];
#pragma unroll
            for (int i = 0; i < 4; ++i) { ov[2 * i] = bflo(o0[q][i]); ov[2 * i + 1] = bfhi(o0[q][i]); ov[8 + 2 * i] = bflo(o1[q][i]); ov[8 + 2 * i + 1] = bfhi(o1[q][i]);
                                          gv[2 * i] = bflo(g0[q][i]); gv[2 * i + 1] = bfhi(g0[q][i]); gv[8 + 2 * i] = bflo(g1[q][i]); gv[8 + 2 * i + 1] = bfhi(g1[q][i]); }
            float s = 0.f;
#pragma unroll
            for (int i = 0; i < 16; ++i) s += ov[i] * ov[i];
            s += __shfl_xor(s, 1); s += __shfl_xor(s, 2); s += __shfl_xor(s, 4); s += __shfl_xor(s, 8);
            const float rstd = __builtin_amdgcn_rsqf(s * (1.0f / 256.0f) + EPS);
            float r[16];
#pragma unroll
            for (int k = 0; k < 4; ++k)
#pragma unroll
                for (int i = 0; i < 4; ++i) { const float g = gv[4 * k + i]; r[4 * k + i] = ov[4 * k + i] * rstd * wq[k][i] * (g * __builtin_amdgcn_rcpf(1.0f + __builtin_amdgcn_exp2f(-LOG2E_ * g))); }
            v4u w0, w1;
#pragma unroll
            for (int i = 0; i < 4; ++i) { w0[i] = pk2(r[2 * i], r[2 * i + 1]); w1[i] = pk2(r[8 + 2 * i], r[8 + 2 * i + 1]); }
            v4u* dp = (v4u*)(OG + (size_t)m * DM + 16 * lane); dp[0] = w0; dp[1] = w1; } }
    }
}
constexpr float LOG2E = 1.4426950408889634f, LN2 = 0.6931471805599453f;
struct PreRegs { v4u qraw[8], kraw[8]; bf16x8 afr[2][8]; };
__device__ __forceinline__ void gla_pre_loads(PreRegs& R, const unsigned char* ws, int bn, int tid, int wave) {
    const bf16* XB = (const bf16*)(ws + WS_XB); const bf16* QKVG = (const bf16*)(ws + WS_QKVG);
    const int lane = tid & 63, row0 = bn * 64, cl = lane & 31, h = lane >> 5;
#pragma unroll
    for (int rb = 0; rb < 2; ++rb) { const bf16* ap = XB + (size_t)(row0 + 32 * rb + cl) * DM + 128 * wave + 8 * h;
#pragma unroll
        for (int s = 0; s < 8; ++s) R.afr[rb][s] = *(const bf16x8*)(ap + 16 * s); }
#pragma unroll
    for (int q = 0; q < 8; ++q) { const int idx = tid + 512 * q, t = idx >> 6, ch8 = idx & 63; const bf16* p = QKVG + (size_t)(row0 + t) * 3072 + ch8 * 8; R.qraw[q] = *(const v4u*)p; R.kraw[q] = *(const v4u*)(p + 512); }
}
__device__ __forceinline__ void gla_pre_unit(const Args& A, int bn, int nbn, PreRegs& R, const bf16x8 (&bfr)[8], LAS unsigned char* lds, int tid_in, int wave) {
    int tid = tid_in; asm volatile("" : "+v"(tid)); const int lane = tid & 63;
    unsigned char* ws = A.ws;
    const bf16* XB = (const bf16*)(ws + WS_XB); const bf16* WG1T = (const bf16*)(ws + WS_WG1T); const float* PS = (const float*)(ws + WS_PS);
    const bf16* QKVG = (const bf16*)(ws + WS_QKVG);
    bf16* QIG = (bf16*)(ws + WS_QI); bf16* KIG = (bf16*)(ws + WS_KET); bf16* PM = (bf16*)(ws + WS_PM); float* DEC = (float*)(ws + WS_DEC);
    const int row0 = bn * 64, cl = lane & 31, h = lane >> 5;
    LAS float* r_lds = (LAS float*)lds;
    LAS float* part = (LAS float*)(lds + 4608);
    LAS unsigned char* QIl = lds + 4608;
    LAS unsigned char* KIl = lds + 4608 + 69632;
    {
        __builtin_amdgcn_sched_barrier(0);
#pragma unroll
        for (int rb = 0; rb < 2; ++rb) {
            f32x16 acc = {};
#pragma unroll
            for (int s = 0; s < 8; ++s) acc = MFMA_BF16(R.afr[rb][s], bfr[s], acc);
            if (cl < 16) {
#pragma unroll
                for (int i = 0; i < 16; ++i) { const int row = 32 * rb + (i & 3) + 8 * (i >> 2) + 4 * h; part[(wave * 64 + row) * 16 + cl] = acc[i]; }
            }
        }
    }
    __syncthreads();
    float rsum[2];
#pragma unroll
    for (int q = 0; q < 2; ++q) { const int idx = tid + 512 * q, row = idx >> 4, j = idx & 15; float s = 0.f;
#pragma unroll
        for (int w = 0; w < 8; ++w) s += part[(w * 64 + row) * 16 + j];
        rsum[q] = s * ((const float*)(ws + WS_RSTD))[row0 + row]; }
    __syncthreads();
#pragma unroll
    for (int q = 0; q < 2; ++q) { const int idx = tid + 512 * q, row = idx >> 4, j = idx & 15; r_lds[row * 17 + j] = rsum[q]; }
#pragma unroll
    for (int q = 0; q < 8; ++q) { const int idx = tid + 512 * q, t = idx >> 6, ch8 = idx & 63, hd2 = ch8 >> 4, cc2 = (ch8 & 15) * 8; const int off = ((hd2 * 64 + t) * 136 + cc2) * 2;
        *(LAS v4u*)(QIl + off) = R.qraw[q]; *(LAS v4u*)(KIl + off) = R.kraw[q]; }
    __syncthreads();
    const int hd = wave >> 1, chh = wave & 1;
    float bw[2][8], bias2[2];
#pragma unroll
    for (int cb = 0; cb < 2; ++cb) { const int c = hd * 128 + 64 * chh + 32 * cb + cl; bias2[cb] = A.in[I_BGK][c];
#pragma unroll
        for (int s = 0; s < 8; ++s) bw[cb][s] = A.in[I_WGK2][(2 * s + h) * 512 + c]; }
    asm volatile("" : "+v"(bias2[0]), "+v"(bias2[1]));
#pragma unroll
    for (int cb = 0; cb < 2; ++cb) asm volatile("" : "+v"(bw[cb][0]), "+v"(bw[cb][1]), "+v"(bw[cb][2]), "+v"(bw[cb][3]), "+v"(bw[cb][4]), "+v"(bw[cb][5]), "+v"(bw[cb][6]), "+v"(bw[cb][7]));
    if (nbn >= 0) gla_pre_loads(R, ws, nbn, tid, wave);
#pragma unroll
    for (int cb = 0; cb < 2; ++cb) {
        const int cc = 64 * chh + 32 * cb + cl, c = hd * 128 + cc;
        const float bias = bias2[cb];
        float pre = 0.f;
#pragma unroll 1
        for (int rb = 0; rb < 2; ++rb) {
            f32x16 x = {};
#pragma unroll
            for (int s = 0; s < 8; ++s) { const float a = r_lds[(32 * rb + cl) * 17 + 2 * s + h]; const float b = bw[cb][s]; x = __builtin_amdgcn_mfma_f32_32x32x2f32(a, b, x, 0, 0, 0); }
#pragma unroll
            for (int i = 0; i < 16; ++i) { const float v = x[i] + bias; const float e = __builtin_amdgcn_exp2f(-fabsf(v) * LOG2E);
                x[i] = (fminf(v, 0.f) - __builtin_amdgcn_logf(1.0f + e) * LN2) * (0.0625f * LOG2E); }
#pragma unroll
            for (int g = 0; g < 4; ++g) {
                const float own = (x[4 * g] + x[4 * g + 1]) + (x[4 * g + 2] + x[4 * g + 3]); const float oth = __shfl_xor(own, 32);
                const float start = pre + (h ? oth : 0.f);
                x[4 * g] += start; x[4 * g + 1] += x[4 * g]; x[4 * g + 2] += x[4 * g + 1]; x[4 * g + 3] += x[4 * g + 2];
                pre += own + oth;
            }
#pragma unroll
            for (int i = 0; i < 16; ++i) { const int t = 32 * rb + (i & 3) + 8 * (i >> 2) + 4 * h; const int off = ((hd * 64 + t) * 136 + cc) * 2;
                const float qv = bf2f(*(const LAS bf16*)(QIl + off)), kv = bf2f(*(const LAS bf16*)(KIl + off)); const float bb = x[i];
                const float qi = qv * 0.08838834764831845f * __builtin_amdgcn_exp2f(bb), ki = kv * __builtin_amdgcn_exp2f(-bb);
                *(LAS bf16*)(QIl + off) = (bf16)(cvtpk(qi, 0.f) & 0xffffu); *(LAS bf16*)(KIl + off) = (bf16)(cvtpk(ki, 0.f) & 0xffffu); }
        }
        if (h == 0) DEC[bn * 512 + c] = __builtin_amdgcn_exp2f(pre);
    }
    __syncthreads();
#pragma unroll
    for (int q = 0; q < 8; ++q) { const int idx = tid + 512 * q, t = idx >> 6, ch8 = idx & 63, hd2 = ch8 >> 4, cc2 = (ch8 & 15) * 8;
        const v4u kv = *(const LAS v4u*)(KIl + ((hd2 * 64 + t) * 136 + cc2) * 2); *(v4u*)(KIG + (size_t)(row0 + t) * 512 + hd2 * 128 + cc2) = kv;
        const int c0 = (cc2 & ~15) + 4 * ((cc2 >> 3) & 1);
        const v2u qa = *(const LAS v2u*)(QIl + ((hd2 * 64 + t) * 136 + c0) * 2), qb = *(const LAS v2u*)(QIl + ((hd2 * 64 + t) * 136 + c0 + 8) * 2);
        v4u qv; qv.x = qa.x; qv.y = qa.y; qv.z = qb.x; qv.w = qb.y; *(v4u*)(QIG + (size_t)(row0 + t) * 512 + hd2 * 128 + cc2) = qv; }
    { const int rb = wave & 1; const int t = 32 * rb + cl;
#pragma unroll
        for (int cbp = 0; cbp < 2; ++cbp) {
            f32x16 acc = {};
#pragma unroll
            for (int s = 0; s < 8; ++s) { const bf16x8 a = *(const LAS bf16x8*)(KIl + ((hd * 64 + 32 * cbp + cl) * 136 + 16 * s + 8 * h) * 2), b = *(const LAS bf16x8*)(QIl + ((hd * 64 + 32 * rb + cl) * 136 + 16 * s + 8 * h) * 2); acc = MFMA_BF16(a, b, acc); }
#pragma unroll
            for (int g = 0; g < 4; ++g) { const int tp0 = 32 * cbp + 8 * g + 4 * h; float v[4];
#pragma unroll
                for (int ii = 0; ii < 4; ++ii) v[ii] = (tp0 + ii <= t) ? acc[4 * g + ii] : 0.f;
                v2u w; w.x = pk2(v[0], v[1]); w.y = pk2(v[2], v[3]); *(v2u*)(PM + ((size_t)(bn * 4 + hd) * 64 + t) * 64 + tp0) = w; }
        }
    }
    __syncthreads();
}

constexpr int SL_P = 0, SL_QI = 9216, SL_KI = 26624, SL_V = 47104, SL_DEC = 51200, SL_BYTES = 51712;
struct SeqRegs { v4u p, q0, q1, k0, k1, x; };
__device__ __forceinline__ void seq_fetch(SeqRegs& R, const unsigned char* ws, int bn, int hd, int es, int tid) {
    const bf16* QIG = (const bf16*)(ws + WS_QI); const bf16* KIG = (const bf16*)(ws + WS_KET); const bf16* PM = (const bf16*)(ws + WS_PM); const bf16* QKVG = (const bf16*)(ws + WS_QKVG); const float* DEC = (const float*)(ws + WS_DEC);
    const int row0 = bn * 64;
    R.p = *(const v4u*)(PM + ((size_t)(bn * 4 + hd) * 64 + (tid >> 3)) * 64 + (tid & 7) * 8);
    { const int t = tid >> 4, c16 = tid & 15; const size_t o0 = (size_t)(row0 + t) * 512 + hd * 128 + c16 * 8, o1 = o0 + (size_t)32 * 512;
      R.q0 = *(const v4u*)(QIG + o0); R.q1 = *(const v4u*)(QIG + o1); R.k0 = *(const v4u*)(KIG + o0); R.k1 = *(const v4u*)(KIG + o1); }
    if (tid < 256) R.x = *(const v4u*)(QKVG + (size_t)(row0 + (tid >> 2)) * 3072 + 1024 + hd * 256 + 32 * es + (tid & 3) * 8);
    else if (tid < 288) R.x = *(const v4u*)(DEC + bn * 512 + hd * 128 + (tid - 256) * 4);
}
__device__ __forceinline__ void seq_put(const SeqRegs& R, LAS unsigned char* slot, int tid) {
    *(LAS v4u*)(slot + SL_P + (tid >> 3) * 144 + (tid & 7) * 16) = R.p;
    { const int t = tid >> 4, c16 = tid & 15;
      *(LAS v4u*)(slot + SL_QI + t * 272 + c16 * 16) = R.q0; *(LAS v4u*)(slot + SL_QI + (t + 32) * 272 + c16 * 16) = R.q1;
      *(LAS v4u*)(slot + SL_KI + t * 320 + c16 * 16) = R.k0; *(LAS v4u*)(slot + SL_KI + (t + 32) * 320 + c16 * 16) = R.k1; }
    if (tid < 256) *(LAS v4u*)(slot + SL_V + (tid >> 2) * 64 + (tid & 3) * 16) = R.x;
    else if (tid < 288) *(LAS v4u*)(slot + SL_DEC + (tid - 256) * 16) = R.x;
}
#define LTR(p) __builtin_bit_cast(s16x4, __builtin_amdgcn_ds_read_tr16_b64_v4i16((LAS s16x4*)(p)))
__device__ __forceinline__ void seq_out(LAS unsigned char* slot, const LAS unsigned char* sfr, bf16* O, int row0, int ocol, int rb, int lane) {
    const int cl = lane & 31, h = lane >> 5;
    const int trb = (8 * h + ((lane & 15) >> 2)), trc = (16 * ((lane >> 4) & 1) + 4 * (lane & 3)) * 2;
    bf16x8 vt[4], pf[4], sa[4], qw[4];
#pragma unroll
    for (int s = 0; s < 4; ++s) { const s16x4 lo = LTR(slot + SL_V + (16 * s + trb) * 64 + trc), hi = LTR(slot + SL_V + (16 * s + 4 + trb) * 64 + trc); vt[s] = (bf16x8){lo[0], lo[1], lo[2], lo[3], hi[0], hi[1], hi[2], hi[3]}; }
#pragma unroll
    for (int s = 0; s < 4; ++s) pf[s] = *(const LAS bf16x8*)(slot + SL_P + (32 * rb + cl) * 144 + (16 * s + 8 * h) * 2);
#pragma unroll
    for (int i = 0; i < 4; ++i) { sa[i] = *(const LAS bf16x8*)(sfr + i * 1024 + lane * 16); qw[i] = *(const LAS bf16x8*)(slot + SL_QI + (32 * rb + cl) * 272 + (16 * i + 8 * h) * 2); }
    __builtin_amdgcn_sched_barrier(0);
    f32x16 acc = {};
#pragma unroll
    for (int s = 0; s < 4; ++s) acc = MFMA_BF16(vt[s], pf[s], acc);
    __builtin_amdgcn_sched_barrier(0);
#pragma unroll
    for (int i = 0; i < 4; ++i) { vt[i] = *(const LAS bf16x8*)(sfr + (4 + i) * 1024 + lane * 16); pf[i] = *(const LAS bf16x8*)(slot + SL_QI + (32 * rb + cl) * 272 + (16 * (4 + i) + 8 * h) * 2); }
    __builtin_amdgcn_sched_barrier(0);
#pragma unroll
    for (int i = 0; i < 4; ++i) acc = MFMA_BF16(sa[i], qw[i], acc);
#pragma unroll
    for (int i = 0; i < 4; ++i) acc = MFMA_BF16(vt[i], pf[i], acc);
#pragma unroll
    for (int g = 0; g < 4; ++g) { v2u w; w.x = cvtpk(acc[4 * g], acc[4 * g + 1]); w.y = cvtpk(acc[4 * g + 2], acc[4 * g + 3]);
        *(v2u*)(O + (size_t)(row0 + 32 * rb + cl) * DM + ocol + 8 * g + 4 * h) = w; }
}
__device__ __forceinline__ void seq_state(f32x16 (&S)[2], LAS unsigned char* slot, LAS unsigned char* sfw, int blk0, int lane) {
    const int h = lane >> 5;
    const int trb = (8 * h + ((lane & 15) >> 2)), trc = (16 * ((lane >> 4) & 1) + 4 * (lane & 3)) * 2;
    bf16x8 vt[4];
#pragma unroll
    for (int s = 0; s < 4; ++s) { const s16x4 lo = LTR(slot + SL_V + (16 * s + trb) * 64 + trc), hi = LTR(slot + SL_V + (16 * s + 4 + trb) * 64 + trc); vt[s] = (bf16x8){lo[0], lo[1], lo[2], lo[3], hi[0], hi[1], hi[2], hi[3]}; }
#pragma unroll
    for (int bi = 0; bi < 2; ++bi) { const int blk = blk0 + bi;
        bf16x8 ke[4];
#pragma unroll
        for (int s = 0; s < 4; ++s) { const s16x4 lo = LTR(slot + SL_KI + (16 * s + trb) * 320 + 64 * blk + trc), hi = LTR(slot + SL_KI + (16 * s + 4 + trb) * 320 + 64 * blk + trc);
            ke[s] = (bf16x8){lo[0], lo[1], lo[2], lo[3], hi[0], hi[1], hi[2], hi[3]}; }
#pragma unroll
        for (int s = 0; s < 4; ++s) S[bi] = MFMA_BF16(ke[s], vt[s], S[bi]);
#pragma unroll
        for (int g = 0; g < 4; ++g) { const f32x4 d4 = *(const LAS f32x4*)(slot + SL_DEC + (32 * blk + 8 * g + 4 * h) * 4);
#pragma unroll
            for (int ii = 0; ii < 4; ++ii) S[bi][4 * g + ii] *= d4[ii]; }
#pragma unroll
        for (int sp = 0; sp < 2; ++sp) { v4u sw; sw.x = cvtpk(S[bi][8 * sp], S[bi][8 * sp + 1]); sw.y = cvtpk(S[bi][8 * sp + 2], S[bi][8 * sp + 3]); sw.z = cvtpk(S[bi][8 * sp + 4], S[bi][8 * sp + 5]); sw.w = cvtpk(S[bi][8 * sp + 6], S[bi][8 * sp + 7]);
            *(LAS v4u*)(sfw + (2 * blk + sp) * 1024 + lane * 16) = sw; }
    }
}
constexpr int SEQ_SF = 2 * SL_BYTES;
__device__ __forceinline__ void seq_touch(unsigned& d0, unsigned& d1, const unsigned char* ws, int bn, int hd, int es, int t  ) {
    const bf16* QIG = (const bf16*)(ws + WS_QI); const bf16* KIG = (const bf16*)(ws + WS_KET); const bf16* PM = (const bf16*)(ws + WS_PM); const bf16* QKVG = (const bf16*)(ws + WS_QKVG); const float* DEC = (const float*)(ws + WS_DEC);
    const int row0 = bn * 64;
    const bf16* p0;
    if (t < 64) p0 = PM + (size_t)(bn * 4 + hd) * 4096 + t * 64;
    else if (t < 192) p0 = QIG + (size_t)(row0 + ((t - 64) >> 1)) * 512 + hd * 128 + ((t - 64) & 1) * 64;
    else p0 = QKVG + (size_t)(row0 + (t - 192)) * 3072 + 1024 + hd * 256 + 32 * es;
    d0 = *(const unsigned*)p0;
    if (t < 128) d1 = *(const unsigned*)(KIG + (size_t)(row0 + (t >> 1)) * 512 + hd * 128 + (t & 1) * 64);
    else if (t < 132) d1 = *(const unsigned*)(DEC + bn * 512 + hd * 128 + (t - 128) * 32);
}
struct SeqRegs4 { v4u p[2], q[4], k[4], x, d; };
__device__ __forceinline__ void seq_fetch4(SeqRegs4& R, const unsigned char* ws, int bn, int hd, int es, int lt) {
    const bf16* QIG = (const bf16*)(ws + WS_QI); const bf16* KIG = (const bf16*)(ws + WS_KET); const bf16* PM = (const bf16*)(ws + WS_PM); const bf16* QKVG = (const bf16*)(ws + WS_QKVG); const float* DEC = (const float*)(ws + WS_DEC);
    const int row0 = bn * 64;
#pragma unroll
    for (int j = 0; j < 2; ++j) { const int idx = lt + 256 * j; R.p[j] = *(const v4u*)(PM + ((size_t)(bn * 4 + hd) * 64 + (idx >> 3)) * 64 + (idx & 7) * 8); }
#pragma unroll
    for (int j = 0; j < 4; ++j) { const int idx = lt + 256 * j, t = idx >> 4, c16 = idx & 15; const size_t o = (size_t)(row0 + t) * 512 + hd * 128 + c16 * 8; R.q[j] = *(const v4u*)(QIG + o); R.k[j] = *(const v4u*)(KIG + o); }
    R.x = *(const v4u*)(QKVG + (size_t)(row0 + (lt >> 2)) * 3072 + 1024 + hd * 256 + 32 * es + (lt & 3) * 8);
    if (lt < 32) R.d = *(const v4u*)(DEC + bn * 512 + hd * 128 + lt * 4);
}
__device__ __forceinline__ void seq_put4(const SeqRegs4& R, LAS unsigned char* slot, int lt) {
#pragma unroll
    for (int j = 0; j < 2; ++j) { const int idx = lt + 256 * j; *(LAS v4u*)(slot + SL_P + (idx >> 3) * 144 + (idx & 7) * 16) = R.p[j]; }
#pragma unroll
    for (int j = 0; j < 4; ++j) { const int idx = lt + 256 * j, t = idx >> 4, c16 = idx & 15; *(LAS v4u*)(slot + SL_QI + t * 272 + c16 * 16) = R.q[j]; *(LAS v4u*)(slot + SL_KI + t * 320 + c16 * 16) = R.k[j]; }
    *(LAS v4u*)(slot + SL_V + (lt >> 2) * 64 + (lt & 3) * 16) = R.x;
    if (lt < 32) *(LAS v4u*)(slot + SL_DEC + lt * 16) = R.d;
}
__device__ __forceinline__ void gla_seq_unit(const Args& A, int u, LAS unsigned char* lds, int tid_in, int wave) {
    int tid = tid_in; asm volatile("" : "+v"(tid)); const int lane = tid & 63;
    unsigned char* ws = A.ws; bf16* O = (bf16*)(ws + WS_XB);
    const int b = u >> 5, hd = (u >> 3) & 3, es = u & 7;
    for (int i = tid; i < 8192 / 16; i += 512) *(LAS v4u*)(lds + SEQ_SF + i * 16) = (v4u){0u, 0u, 0u, 0u};
    if (wave >= 4) {
        const int lt = tid - 256;
        SeqRegs4 L0, L1, L2, L3;
        seq_fetch4(L0, ws, b * 64, hd, es, lt); seq_fetch4(L1, ws, b * 64 + 1, hd, es, lt); seq_fetch4(L2, ws, b * 64 + 2, hd, es, lt); seq_fetch4(L3, ws, b * 64 + 3, hd, es, lt);
        seq_put4(L0, lds, lt); seq_fetch4(L0, ws, b * 64 + 4, hd, es, lt);
        __syncthreads();
#define SEQ_LOAD(n, R) do { if ((n) + 1 < 64) { seq_put4(R, lds + (((n) + 1) & 1) * SL_BYTES, lt); if ((n) + 5 < 64) seq_fetch4(R, ws, b * 64 + (n) + 5, hd, es, lt); } __syncthreads(); } while (0)
#pragma unroll 1
        for (int n = 0; n < 64; n += 4) { SEQ_LOAD(n, L1); SEQ_LOAD(n + 1, L2); SEQ_LOAD(n + 2, L3); SEQ_LOAD(n + 3, L0); }
#undef SEQ_LOAD
    } else {
        f32x16 S[2]; S[0] = f32x16{}; S[1] = f32x16{};
        __syncthreads();
#pragma unroll 1
        for (int n = 0; n < 64; ++n) {
            if (wave < 2) seq_out(lds + (n & 1) * SL_BYTES, lds + SEQ_SF + (n & 1) * 8192, O, (b * 64 + n) * 64, hd * 256 + 32 * es, wave, lane);
            else seq_state(S, lds + (n & 1) * SL_BYTES, lds + SEQ_SF + ((n + 1) & 1) * 8192, 2 * (wave - 2), lane);
            __syncthreads();
        }
    }
}

constexpr int AT_KB = 18432, AT_VB = 20480, AT_K0 = 0, AT_V0 = 2 * AT_KB, AT_XO = 2 * AT_KB + 2 * AT_VB;
__device__ __forceinline__ float max3f(float a, float b, float c) { return fmaxf(fmaxf(a, b), c); }
#define VTR(p) __builtin_bit_cast(s16x4, __builtin_amdgcn_ds_read_tr16_b64_v4i16((LAS s16x4*)(p)))
#define MFMA_PV(a, b, c) MFMA_BF16(a, b, c)
#define EXP2F(x) __builtin_amdgcn_exp2f(x)
#define VFRAG(lo, hi) ((bf16x8){lo[0], lo[1], lo[2], lo[3], hi[0], hi[1], hi[2], hi[3]})
#define AT_EXP8(P, B, W) do { const float e0 = EXP2F(P[B]), e1 = EXP2F(P[B + 1]), e2 = EXP2F(P[B + 2]), e3 = EXP2F(P[B + 3]), e4 = EXP2F(P[B + 4]), e5 = EXP2F(P[B + 5]), e6 = EXP2F(P[B + 6]), e7 = EXP2F(P[B + 7]); \
        W.x = cvtpk(e0, e1); W.y = cvtpk(e2, e3); W.z = cvtpk(e4, e5); W.w = cvtpk(e6, e7); ra += (e0 + e1) + (e4 + e5); rb += (e2 + e3) + (e6 + e7); } while (0)
__device__ __forceinline__ void glds16_asm(const void* gsrc, unsigned lds_dst) { unsigned keep;
    asm volatile("s_mov_b32 %0, m0\n\ts_mov_b32 m0, %2\n\ts_nop 0\n\tglobal_load_lds_dwordx4 %1, off\n\ts_mov_b32 m0, %0" : "=&s"(keep) : "v"(gsrc), "s"(lds_dst) : "memory"); }
__device__ __forceinline__ void glds16_so(const void* sbase, unsigned voff, unsigned lds_dst) { unsigned keep;
    asm volatile("s_mov_b32 %0, m0\n\ts_mov_b32 m0, %3\n\ts_nop 0\n\tglobal_load_lds_dwordx4 %1, %2\n\ts_mov_b32 m0, %0" : "=&s"(keep) : "v"(voff), "s"(sbase), "s"(lds_dst) : "memory"); }
constexpr int A5_K0 = 0, A5_V0 = 3 * AT_KB;
__device__ __forceinline__ void attn5_tile(LAS unsigned char* vp, LAS unsigned char* kpn  , bool has_next, bf16x8 (&kf)[8], const bf16x8 (&qf)[4], f32x16 (&o)[4], float& m, float& l, f32x16& nmv  ,
                                           int key0, int qrow, int h, bool need_mask, bool first) {
    s16x4 la[4], ha[4], lb[4], hb[4];
#pragma unroll
    for (int eb = 0; eb < 4; ++eb) { la[eb] = VTR(vp + eb * 64); ha[eb] = VTR(vp + 8 * 320 + eb * 64); }
#pragma unroll
    for (int eb = 0; eb < 4; ++eb) { lb[eb] = VTR(vp + 16 * 320 + eb * 64); hb[eb] = VTR(vp + 16 * 320 + 8 * 320 + eb * 64); }
    __builtin_amdgcn_sched_barrier(0);
    f32x16 p0, p1;
    asm volatile("v_mfma_f32_32x32x16_bf16 %0, %2, %3, %4\n\tv_mfma_f32_32x32x16_bf16 %1, %5, %3, %4" : "=&v"(p0), "=&v"(p1) : "v"(kf[0]), "v"(qf[0]), "v"(nmv), "v"(kf[1]));
#pragma unroll
    for (int s = 1; s < 4; ++s) { p0 = MFMA_BF16(kf[2 * s], qf[s], p0); p1 = MFMA_BF16(kf[2 * s + 1], qf[s], p1); }
    if (need_mask) {
#pragma unroll
        for (int i = 0; i < 16; ++i) { const int key = key0 + (i & 3) + 8 * (i >> 2) + 4 * h; if (key > qrow) p0[i] = -INFINITY; if (key + 32 > qrow) p1[i] = -INFINITY; }
    }
    float ma = max3f(p0[0], p0[1], p1[0]), mb = max3f(p0[2], p0[3], p1[1]), mc = max3f(p0[4], p0[5], p1[2]), md = max3f(p0[6], p0[7], p1[3]);
    ma = max3f(ma, p0[8], p0[9]); mb = max3f(mb, p0[10], p0[11]); mc = max3f(mc, p0[12], p0[13]); md = max3f(md, p0[14], p0[15]);
    ma = max3f(ma, p1[4], p1[5]); mb = max3f(mb, p1[6], p1[7]); mc = max3f(mc, p1[8], p1[9]); md = max3f(md, p1[10], p1[11]);
    ma = max3f(ma, p1[12], p1[13]); mb = max3f(mb, p1[14], p1[15]);
    float mx = fmaxf(fmaxf(ma, mb), fmaxf(mc, md));
    { auto rr = __builtin_amdgcn_permlane32_swap(__builtin_bit_cast(unsigned, mx), __builtin_bit_cast(unsigned, mx), false, false); mx = fmaxf(__builtin_bit_cast(float, rr[0]), __builtin_bit_cast(float, rr[1])); }
    if (first || __any(mx > 8.0f)) {
        const float dl = first ? mx : fmaxf(mx, 0.f); m += dl;
#pragma unroll
        for (int i = 0; i < 16; ++i) { p0[i] -= dl; p1[i] -= dl; nmv[i] = -m; }
        if (!first) { const float al = __builtin_amdgcn_exp2f(-dl); l *= al;
#pragma unroll
            for (int eb = 0; eb < 4; ++eb) o[eb] *= al; }
    }
    float ra = 0.f, rb = 0.f; v4u w0, w1;
    AT_EXP8(p0, 0, w0);
    __builtin_amdgcn_sched_barrier(0);
    { const bf16x8 pf = __builtin_bit_cast(bf16x8, w0);
#pragma unroll
      for (int eb = 0; eb < 4; ++eb) o[eb] = MFMA_PV(VFRAG(la[eb], ha[eb]), pf, o[eb]); }
    AT_EXP8(p0, 8, w1);
    __builtin_amdgcn_sched_barrier(0);
#pragma unroll
    for (int eb = 0; eb < 4; ++eb) { la[eb] = VTR(vp + 32 * 320 + eb * 64); ha[eb] = VTR(vp + 32 * 320 + 8 * 320 + eb * 64); }
    __builtin_amdgcn_sched_barrier(0);
    { const bf16x8 pf = __builtin_bit_cast(bf16x8, w1);
#pragma unroll
      for (int eb = 0; eb < 4; ++eb) o[eb] = MFMA_PV(VFRAG(lb[eb], hb[eb]), pf, o[eb]); }
    AT_EXP8(p1, 0, w0);
    __builtin_amdgcn_sched_barrier(0);
#pragma unroll
    for (int eb = 0; eb < 4; ++eb) { lb[eb] = VTR(vp + 48 * 320 + eb * 64); hb[eb] = VTR(vp + 48 * 320 + 8 * 320 + eb * 64); }
    if (has_next) {
#pragma unroll
        for (int s = 0; s < 4; ++s) { kf[2 * s] = *(const LAS bf16x8*)(kpn + s * 32); kf[2 * s + 1] = *(const LAS bf16x8*)(kpn + 32 * 144 + s * 32); }
    }
    __builtin_amdgcn_sched_barrier(0);
    { const bf16x8 pf = __builtin_bit_cast(bf16x8, w0);
#pragma unroll
      for (int eb = 0; eb < 4; ++eb) o[eb] = MFMA_PV(VFRAG(la[eb], ha[eb]), pf, o[eb]); }
    AT_EXP8(p1, 8, w1);
    __builtin_amdgcn_sched_barrier(0);
    { const bf16x8 pf = __builtin_bit_cast(bf16x8, w1);
#pragma unroll
      for (int eb = 0; eb < 4; ++eb) o[eb] = MFMA_PV(VFRAG(lb[eb], hb[eb]), pf, o[eb]); }
    l += ra + rb;
}
__device__ __forceinline__ void attn8_step(LAS unsigned char* vp, LAS unsigned char* kpn2  , bool has_next, bool has_next2, bf16x8 (&kf)[8], const bf16x8 (&qf)[4], f32x16 (&o)[4], float& m, float& l,
                                           f32x16& p0, f32x16& p1, f32x16& n0, f32x16& n1, int key0, int qrow, int h, bool need_mask, bool first) {
    s16x4 la[4], ha[4], lb[4], hb[4];
#pragma unroll
    for (int eb = 0; eb < 4; ++eb) { la[eb] = VTR(vp + eb * 64); ha[eb] = VTR(vp + 8 * 320 + eb * 64); }
#pragma unroll
    for (int eb = 0; eb < 4; ++eb) { lb[eb] = VTR(vp + 16 * 320 + eb * 64); hb[eb] = VTR(vp + 16 * 320 + 8 * 320 + eb * 64); }
    __builtin_amdgcn_sched_barrier(0);
    { const float nm = -m;
#pragma unroll
        for (int i = 0; i < 16; ++i) { n0[i] = nm; n1[i] = nm; }
#pragma unroll
        for (int s = 0; s < 4; ++s) { n0 = MFMA_BF16(kf[2 * s], qf[s], n0); n1 = MFMA_BF16(kf[2 * s + 1], qf[s], n1); } }
    __builtin_amdgcn_sched_barrier(0);
    if (need_mask) {
#pragma unroll
        for (int i = 0; i < 16; ++i) { const int key = key0 + (i & 3) + 8 * (i >> 2) + 4 * h; if (key > qrow) p0[i] = -INFINITY; if (key + 32 > qrow) p1[i] = -INFINITY; }
    }
    float ma = max3f(p0[0], p0[1], p1[0]), mb = max3f(p0[2], p0[3], p1[1]), mc = max3f(p0[4], p0[5], p1[2]), md = max3f(p0[6], p0[7], p1[3]);
    ma = max3f(ma, p0[8], p0[9]); mb = max3f(mb, p0[10], p0[11]); mc = max3f(mc, p0[12], p0[13]); md = max3f(md, p0[14], p0[15]);
    ma = max3f(ma, p1[4], p1[5]); mb = max3f(mb, p1[6], p1[7]); mc = max3f(mc, p1[8], p1[9]); md = max3f(md, p1[10], p1[11]);
    ma = max3f(ma, p1[12], p1[13]); mb = max3f(mb, p1[14], p1[15]);
    float mx = fmaxf(fmaxf(ma, mb), fmaxf(mc, md));
    { auto rr = __builtin_amdgcn_permlane32_swap(__builtin_bit_cast(unsigned, mx), __builtin_bit_cast(unsigned, mx), false, false); mx = fmaxf(__builtin_bit_cast(float, rr[0]), __builtin_bit_cast(float, rr[1])); }
    if (first || __any(mx > 8.0f)) {
        const float dl = first ? mx : fmaxf(mx, 0.f); m += dl;
#pragma unroll
        for (int i = 0; i < 16; ++i) { p0[i] -= dl; p1[i] -= dl; }
#pragma unroll
        for (int i = 0; i < 16; ++i) { n0[i] -= dl; n1[i] -= dl; }
        if (!first) { const float al = __builtin_amdgcn_exp2f(-dl); l *= al;
#pragma unroll
            for (int eb = 0; eb < 4; ++eb) o[eb] *= al; }
    }
    float ra = 0.f, rb = 0.f; v4u w0, w1;
    AT_EXP8(p0, 0, w0);
    __builtin_amdgcn_sched_barrier(0);
    { const bf16x8 pf = __builtin_bit_cast(bf16x8, w0);
#pragma unroll
      for (int eb = 0; eb < 4; ++eb) o[eb] = MFMA_PV(VFRAG(la[eb], ha[eb]), pf, o[eb]); }
    AT_EXP8(p0, 8, w1);
    __builtin_amdgcn_sched_barrier(0);
#pragma unroll
    for (int eb = 0; eb < 4; ++eb) { la[eb] = VTR(vp + 32 * 320 + eb * 64); ha[eb] = VTR(vp + 32 * 320 + 8 * 320 + eb * 64); }
    __builtin_amdgcn_sched_barrier(0);
    { const bf16x8 pf = __builtin_bit_cast(bf16x8, w1);
#pragma unroll
      for (int eb = 0; eb < 4; ++eb) o[eb] = MFMA_PV(VFRAG(lb[eb], hb[eb]), pf, o[eb]); }
    AT_EXP8(p1, 0, w0);
    __builtin_amdgcn_sched_barrier(0);
#pragma unroll
    for (int eb = 0; eb < 4; ++eb) { lb[eb] = VTR(vp + 48 * 320 + eb * 64); hb[eb] = VTR(vp + 48 * 320 + 8 * 320 + eb * 64); }
    {
#pragma unroll
        for (int s = 0; s < 4; ++s) { kf[2 * s] = *(const LAS bf16x8*)(kpn2 + s * 32); kf[2 * s + 1] = *(const LAS bf16x8*)(kpn2 + 32 * 144 + s * 32); }
    }
    __builtin_amdgcn_sched_barrier(0);
    { const bf16x8 pf = __builtin_bit_cast(bf16x8, w0);
#pragma unroll
      for (int eb = 0; eb < 4; ++eb) o[eb] = MFMA_PV(VFRAG(la[eb], ha[eb]), pf, o[eb]); }
    AT_EXP8(p1, 8, w1);
    __builtin_amdgcn_sched_barrier(0);
    { const bf16x8 pf = __builtin_bit_cast(bf16x8, w1);
#pragma unroll
      for (int eb = 0; eb < 4; ++eb) o[eb] = MFMA_PV(VFRAG(lb[eb], hb[eb]), pf, o[eb]); }
    l += ra + rb;
}
__device__ __forceinline__ unsigned a8_koff(int cc, int i, int lane) { const int t = i + lane, r = (t * 57) >> 9, cq = t - 9 * r; return (unsigned)((cc * 4096 * 64 + (7 * i + r) * 64 + (cq > 7 ? 7 : cq) * 8) * 2); }
__device__ __forceinline__ unsigned a8_voff(int i, int lane) { const int t = 4 * i + lane, r = (t * 205) >> 12, cq = t - 20 * r; return (unsigned)(((3 * i + r) * 128 + (cq > 15 ? 15 : cq) * 8) * 2); }
__device__ __forceinline__ void a8_dma_k(const bf16* kt, unsigned ldsK, int wave, int lane) {
#pragma unroll
    for (int ii = 0; ii < 3; ++ii) { const int g = wave + 8 * ii; if (g < 18) { const int cc = g >= 9 ? 1 : 0, i = g - 9 * cc;
        glds16_so(kt, a8_koff(cc, i, lane), (unsigned)__builtin_amdgcn_readfirstlane((int)(ldsK + cc * 9216 + i * 1024))); } }
}
__device__ __forceinline__ void a8_dma_v(const bf16* vt, unsigned ldsV, int wave, int lane) {
#pragma unroll
    for (int ii = 2; ii < 5; ++ii) { const int g = wave + 8 * ii; if (g >= 18) { const int i = g < 38 ? g - 18 : g - 38;
        glds16_so(vt, a8_voff(i, lane), (unsigned)__builtin_amdgcn_readfirstlane((int)(ldsV + i * 1024))); } }
}
__device__ __forceinline__ void attn_unit(const Args& A, int b, int hh, int qb, float lam, LAS unsigned char* lds, int tid_in, int wave, int lane_in) {
    int tid = tid_in; asm volatile("" : "+v"(tid));
    const int lane = tid & 63; (void)lane_in;
    unsigned char* ws = A.ws;
    const bf16* KR = (const bf16*)(ws + WS_KR); const bf16* VR = (const bf16*)(ws + WS_VR); const bf16* QR = (const bf16*)(ws + WS_QR); bf16* AO = (bf16*)(ws + WS_AO);
    const int cl = lane & 31, h = lane >> 5, c = wave >> 2, qg = wave & 3;
    const int q0 = qb * 128, NT = 2 * (qb + 1), qrow = q0 + 32 * qg + cl, qmax = q0 + 32 * qg + 31, qmin = q0 + 32 * qg;
    bf16x8 qf[4];
    { const bf16* qp = QR + ((size_t)((b * 8 + hh) * 2 + c) * 4096 + qrow) * 64 + 8 * h;
#pragma unroll
        for (int s = 0; s < 4; ++s) qf[s] = *(const bf16x8*)(qp + 16 * s); }
    f32x16 o[4]; o[0] = f32x16{}; o[1] = f32x16{}; o[2] = f32x16{}; o[3] = f32x16{};
    float m = 0.f, l = 0.f;
    constexpr int A7_K0 = 0, A7_V0 = 4 * AT_KB;
    const bf16* const kbase = KR + (size_t)((b * 8 + hh) * 2) * 4096 * 64; const bf16* const vbase = VR + (size_t)(b * 8 + hh) * 4096 * 128;
    const unsigned lds0 = (unsigned)(uintptr_t)lds;
#define A7_DMA_K(t, slot) a8_dma_k(kbase + (size_t)(t) * 64 * 64, lds0 + A7_K0 + (slot) * AT_KB, wave, lane)
#define A7_DMA_V(t, slot) a8_dma_v(vbase + (size_t)(t) * 64 * 128, lds0 + A7_V0 + (slot) * AT_VB, wave, lane)
    LAS unsigned char* const vtr = lds + A7_V0 + (4 * h + ((lane & 15) >> 2)) * 320 + (16 * ((lane >> 4) & 1) + 4 * (lane & 3)) * 2;
    LAS unsigned char* const kfr = lds + A7_K0 + c * 9216 + cl * 144 + 16 * h;
    A7_DMA_K(0, 0); A7_DMA_V(0, 0); A7_DMA_K(1, 1); A7_DMA_V(1, 1);
    if (NT > 2) A7_DMA_K(2, 2);
    asm volatile("s_waitcnt vmcnt(0)" ::: "memory"); __syncthreads();
    asm volatile("" : "+v"(qf[0]), "+v"(qf[1]), "+v"(qf[2]), "+v"(qf[3]));
    bf16x8 kf[8];
#pragma unroll
    for (int s = 0; s < 4; ++s) { kf[2 * s] = *(const LAS bf16x8*)(kfr + s * 32); kf[2 * s + 1] = *(const LAS bf16x8*)(kfr + 32 * 144 + s * 32); }
    f32x16 nmv = {};
    int kv = 0, kv1 = 1, kv2 = 2, kk1 = 1, kk3 = 3;
#pragma unroll 1
    for (int j = 0; j < NT; ++j) {
        if (j + 3 < NT) A7_DMA_K(j + 3, kk3);
        if (j + 2 < NT) A7_DMA_V(j + 2, kv2);
        const bool act_ = (64 * j <= qmax);
        if (act_) attn5_tile(vtr + kv * AT_VB, kfr + kk1 * AT_KB, j + 1 < NT, kf, qf, o, m, l, nmv, 64 * j, qrow, h, 64 * j + 63 > qmin, j == 0);
        if (j + 3 < NT) asm volatile("s_waitcnt vmcnt(5) lgkmcnt(0)\n\ts_barrier" ::: "memory"); else asm volatile("s_waitcnt vmcnt(0) lgkmcnt(0)\n\ts_barrier" ::: "memory");
        kv = kv1; kv1 = kv2; kv2 = (kv2 == 2) ? 0 : kv2 + 1; kk1 = (kk1 + 1) & 3; kk3 = (kk3 + 1) & 3;
    }
    __syncthreads();
    int tid2 = tid; asm volatile("" : "+v"(tid2));
    const int bp32 = ((tid2 & 63) ^ 32) << 2;
    l += __builtin_bit_cast(float, __builtin_amdgcn_ds_bpermute(bp32, __builtin_bit_cast(int, l)));
    const float inv = __builtin_amdgcn_rcpf(l);
    {
    const int lane2 = tid2 & 63, cl = lane2 & 31, h = lane2 >> 5, wave2 = __builtin_amdgcn_readfirstlane(tid2 >> 6), c = wave2 >> 2, qg = wave2 & 3, qrow = q0 + 32 * qg + cl;
    LAS float* XO = (LAS float*)(lds) + qg * 4096;
    if (c == 1) {
        const float f = inv * lam;
#pragma unroll
        for (int eb = 0; eb < 4; ++eb)
#pragma unroll
            for (int i = 0; i < 16; ++i) { const int e = 32 * eb + (i & 3) + 8 * (i >> 2) + 4 * h; XO[e * 32 + cl] = o[eb][i] * f; }
    }
    __syncthreads();
    if (c == 0) {
        float ss = 0.f;
#pragma unroll
        for (int eb = 0; eb < 4; ++eb)
#pragma unroll
            for (int i = 0; i < 16; ++i) { const int e = 32 * eb + (i & 3) + 8 * (i >> 2) + 4 * h; const float v = o[eb][i] * inv - XO[e * 32 + cl]; o[eb][i] = v; ss += v * v; }
        ss += __builtin_bit_cast(float, __builtin_amdgcn_ds_bpermute(bp32, __builtin_bit_cast(int, ss)));
        const float rstd = (1.0f - LAM_INIT) * __builtin_amdgcn_rsqf(ss * (1.0f / 128.0f) + EPS);
        LAS unsigned char* ob = lds + qg * 16384 + cl * 272;
        f32x4 w4[4][4];
#pragma unroll
        for (int eb = 0; eb < 4; ++eb)
#pragma unroll
            for (int g = 0; g < 4; ++g) w4[eb][g] = *(const f32x4*)(A.in[I_SUBLN] + 32 * eb + 8 * g + 4 * h);
#pragma unroll
        for (int eb = 0; eb < 4; ++eb)
#pragma unroll
            for (int g = 0; g < 4; ++g) { const int e0 = 32 * eb + 8 * g + 4 * h;
                v2u w; w.x = cvtpk(o[eb][4 * g] * rstd * w4[eb][g][0], o[eb][4 * g + 1] * rstd * w4[eb][g][1]); w.y = cvtpk(o[eb][4 * g + 2] * rstd * w4[eb][g][2], o[eb][4 * g + 3] * rstd * w4[eb][g][3]);
                *(LAS v2u*)(ob + e0 * 2) = w; }
    }
    __syncthreads();
    { bf16* ob0 = AO + (size_t)(b * 4096 + q0) * DM + hh * 128;
      v4u t[4];
#pragma unroll
      for (int it = 0; it < 4; ++it) { const int row = 16 * wave2 + 4 * it + (lane2 >> 4); t[it] = *(const LAS v4u*)(lds + (row >> 5) * 16384 + (row & 31) * 272 + (lane2 & 15) * 16); }
#pragma unroll
      for (int it = 0; it < 4; ++it) { const int row = 16 * wave2 + 4 * it + (lane2 >> 4); *(v4u*)(ob0 + (size_t)row * DM + (lane2 & 15) * 8) = t[it]; } }
    }
    __syncthreads();
#undef A7_DMA_K
#undef A7_DMA_V
}

constexpr int NPH = 16;
__global__ void __launch_bounds__(NWAVES * 64, 2) yoco_fwd(Args args) {
    extern __shared__ __attribute__((aligned(16))) unsigned char lds_raw[];
    LAS unsigned char* lds = (LAS unsigned char*)lds_raw;
#define FRESH() int tid = threadIdx.x; asm volatile("" : "+v"(tid)); const int lane = tid & 63, wave = __builtin_amdgcn_readfirstlane(tid >> 6); (void)lane; (void)wave
    const int G = gridDim.x; const int bx = blockIdx.x; const int vcu = (G % 8 == 0) ? (bx % 8) * (G / 8) + bx / 8 : bx;
    unsigned char* ws = args.ws;
    for (int u = threadIdx.x; u < (LDS_BYTES - LDSCTL_OFF) / 4; u += NWAVES * 64) ((LAS unsigned*)(lds + LDSCTL_OFF))[u] = 0u;
    __syncthreads();
#if !MK_PER_PHASE
    XcdBarrier bar = xcd_barrier_post((unsigned*)(ws + WS_CTL) + CW_BAR, (volatile LAS unsigned*)(lds + MISC_OFF) + 8);
#define GRID_BAR() xcd_barrier(bar)
#else
#define GRID_BAR() do {} while (0)
#endif
    const int lo = args.ph_lo, hi = args.ph_hi;
#define IN(k) (lo <= (k) && (k) < hi)
#define SEAM(k) do { if (IN((k) + 1)) GRID_BAR(); } while (0)
    float* H = args.out;
    const float* PS = (const float*)(ws + WS_PS);
    if (IN(0)) { FRESH(); { p0_prologue(args, lds, vcu, G, wave, lane, tid); } SEAM(0); }
    if (IN(1)) { FRESH(); {
        pg8::Gemm g{(const bf16*)(ws + WS_XB), (const bf16*)(ws + WS_W1T), T, 3072, DM}; pg8::StaticOrder S; S.init(T, 3072, G, bx);
        pg8::EpiScaleBf16 E{(bf16*)(ws + WS_QKVG), 3072, (const float*)(ws + WS_RSTD), nullptr, 0};
        pg8::gemm_phase<pg8::EpiScaleBf16, pg8::StaticOrder, true, true>(lds, g, S, E); } SEAM(1);
    }
    if (IN(2)) { FRESH(); {
        if (bx & 1) __builtin_amdgcn_s_sleep(127);
        PreRegs R; bf16x8 bfr[8];
        { const bf16* bp = (const bf16*)(ws + WS_WG1T) + (size_t)(lane & 31) * DM + 128 * wave + 8 * (lane >> 5);
#pragma unroll
          for (int s = 0; s < 8; ++s) bfr[s] = *(const bf16x8*)(bp + 16 * s); }
        if (vcu < NBN) gla_pre_loads(R, ws, vcu, tid, wave);
        for (int bn = vcu; bn < NBN; bn += G) gla_pre_unit(args, bn, bn + G < NBN ? bn + G : -1, R, bfr, lds, tid, wave); } SEAM(2); }
    if (IN(3)) { FRESH(); { for (int u = vcu; u < 256; u += G) gla_seq_unit(args, u, lds, tid, wave); } SEAM(3); }
    if (IN(4)) { FRESH(); { gla_gate_phase((const bf16*)(ws + WS_XB), (const bf16*)(ws + WS_QKVG), args.in[I_ONORM], (bf16*)(ws + WS_OGATE), vcu, G, wave, lane); } SEAM(4); }
    if (IN(5)) { FRESH(); {
        pg8::Gemm g{(const bf16*)(ws + WS_OGATE), (const bf16*)(ws + WS_WO1T), T, DM, DM}; pg8::StaticOrder S; S.init(T, DM, G, bx);
        pg8::EpiResBf16 E{args.in[I_X], nullptr, (bf16*)(ws + WS_XB), DM, (float*)(ws + WS_PS), (bf16*)(ws + WS_AH)};
        pg8::gemm_phase<pg8::EpiResBf16, pg8::StaticOrder, true, true>(lds, g, S, E); } SEAM(5);
    }
#pragma unroll
    for (int layer = 0; layer < 2; ++layer) {
        const int pb = layer == 0 ? 6 : 12;
        const bf16* WIN = (const bf16*)(ws + (layer == 0 ? WS_WIN0T : WS_WIN1T)); const bf16* WOUT = (const bf16*)(ws + (layer == 0 ? WS_WOUT0T : WS_WOUT1T));
        const float* cw = args.in[I_CONVW] + (size_t)layer * 3 * 2 * DFF; const float* cb = args.in[I_CONVB] + (size_t)layer * 2 * DFF;
        if (IN(pb)) { FRESH(); {
            pg8::Gemm g{(const bf16*)(ws + WS_AH), WIN, 1024, 2 * DFF, DM}; pg8::StaticOrder S; S.init(1024, 2 * DFF, G, bx);
            pg8::EpiScaleBf16 E{(bf16*)(ws + WS_UH), 2 * DFF, nullptr, PS, 1};
            pg8::gemm_phase<pg8::EpiScaleBf16, pg8::StaticOrder, true, true>(lds, g, S, E);
            { const int nidle = G > 88 ? G - 88 : G, me = G > 88 ? bx - 88 : bx;
              if (me >= 0) { for (int r = me * (NWAVES * 64) + tid; r < T; r += nidle * NWAVES * 64) ((float*)(ws + WS_RSTD))[r] = pg8::rstd_ps(PS, r);
                  if (layer == 0) { asm volatile("s_waitcnt vmcnt(0)" ::: "memory"); __syncthreads(); p0_weights(args, lds, me * NWAVES + wave, nidle * NWAVES, W_EARLY, W_NITEMS, wave, lane); } } } } SEAM(pb);
        }
        if (IN(pb + 1)) { FRESH(); {
            pg8::Gemm g{(const bf16*)(ws + WS_XB), WIN, T, 2 * DFF, DM}; pg8::StaticOrder S; S.init(T, 2 * DFF, G, bx);
            pg8::EpiConvGate E{(bf16*)(ws + WS_ACT), (const bf16*)(ws + WS_UH), (const float*)(ws + WS_RSTD), cw, cb};
            pg8::gemm_phase<pg8::EpiConvGate, pg8::StaticOrder, true, true>(lds, g, S, E); } SEAM(pb + 1);
        }
        if (IN(pb + 2)) { FRESH(); {
            pg8::Gemm g{(const bf16*)(ws + WS_ACT), WOUT, T, DM, DFF}; pg8::StaticOrder S; S.init(T, DM, G, bx);
            pg8::EpiResBf16 E{nullptr, (const bf16*)(ws + WS_XB), (bf16*)(ws + WS_XB), DM, (float*)(ws + WS_PS), layer == 0 ? (bf16*)(ws + WS_AH) : (bf16*)nullptr};
            pg8::gemm_phase<pg8::EpiResBf16, pg8::StaticOrder, true, true>(lds, g, S, E); } SEAM(pb + 2);
        }
        if (layer == 0) {
            if (IN(9)) { FRESH(); {
                pg8::Gemm g{(const bf16*)(ws + WS_XB), (const bf16*)(ws + WS_WKVQT), T, 3072, DM}; pg8::StaticOrder S; S.init(T, 3072, G, bx);
                pg8::EpiRope E{(bf16*)(ws + WS_KR), (bf16*)(ws + WS_VR), (bf16*)(ws + WS_QR), PS, (const float*)(ws + WS_COS), (const float*)(ws + WS_SIN)};
                pg8::gemm_phase<pg8::EpiRope, pg8::StaticOrder, true, true>(lds, g, S, E); } SEAM(9);
            }
            if (IN(10)) { FRESH(); {
                const float* lp = args.in[I_LAMBDA];
                const float sa = wave_sum(lp[lane] * lp[64 + lane]), sb = wave_sum(lp[128 + lane] * lp[192 + lane]);
                const float lam = __builtin_bit_cast(float, __builtin_amdgcn_readfirstlane(__builtin_bit_cast(int, expf(sa) - expf(sb) + LAM_INIT)));
                const int xg = vcu >> 5, cu = vcu & 31, kq = cu & 15;
                if (G == 256) {
#pragma unroll 1
                    for (int i = 0; i < 8; ++i) { const int pr = xg * 8 + 2 * (i >> 1) + (cu >> 4); const int qb = (i & 1) ? 31 - kq : kq; attn_unit(args, pr >> 3, pr & 7, qb, lam, lds, tid, wave, lane); }
                } else {
#pragma unroll 1
                    for (int it = vcu; it < 1024; it += G) {
#pragma unroll 1
                        for (int i = 0; i < 2; ++i) { const int pr = it >> 4, k2 = it & 15; attn_unit(args, pr >> 3, pr & 7, i ? 31 - k2 : k2, lam, lds, tid, wave, lane); } }
                } }
                SEAM(10);
            }
            if (IN(11)) { FRESH(); {
                pg8::Gemm g{(const bf16*)(ws + WS_AO), (const bf16*)(ws + WS_WO2T), T, DM, DM}; pg8::StaticOrder S; S.init(T, DM, G, bx);
                pg8::EpiResBf16 E{nullptr, (const bf16*)(ws + WS_XB), (bf16*)(ws + WS_XB), DM, (float*)(ws + WS_PS), (bf16*)(ws + WS_AH)};
                pg8::gemm_phase<pg8::EpiResBf16, pg8::StaticOrder, true, true>(lds, g, S, E); } SEAM(11);
            }
        }
    }
    if (IN(15)) { FRESH(); { final_norm_phase((const bf16*)(ws + WS_XB), PS, H, args.in[I_FINAL], vcu, G, wave, lane); } }
#undef IN
#undef SEAM
}

extern "C" void kernel_launch(void* const* d_in, const int* in_sizes, int n_in, void* d_out, int out_size, void* d_ws, size_t ws_size, hipStream_t stream) {
    static int grid = 0;
    if (grid == 0) {
        if (n_in != 20 || out_size != T * DM || ws_size < WS_END) { fprintf(stderr, "kernel_launch: unexpected shapes (n_in %d out %d ws %zu)\n", n_in, out_size, ws_size); grid = -1; return; }
        int dev = 0, cus = 0;
        if (hipGetDevice(&dev) != hipSuccess || hipDeviceGetAttribute(&cus, hipDeviceAttributeMultiprocessorCount, dev) != hipSuccess) { grid = -1; return; }
        if (hipFuncSetAttribute((const void*)yoco_fwd, hipFuncAttributeMaxDynamicSharedMemorySize, LDS_BYTES) != hipSuccess) { grid = -1; return; }
        int per_cu = 0; (void)hipOccupancyMaxActiveBlocksPerMultiprocessor(&per_cu, (const void*)yoco_fwd, NWAVES * 64, LDS_BYTES); (void)hipGetLastError();
        grid = cus;
    }
    if (grid < 0) return;
    if (hipMemsetAsync((char*)d_ws + WS_CTL, 0, CTL_ZERO_BYTES, stream) != hipSuccess) return;
    Args a{};
    for (int i = 0; i < 20; ++i) a.in[i] = (const float*)d_in[i];
    a.out = (float*)d_out; a.ws = (unsigned char*)d_ws;
#if MK_PER_PHASE
    for (int ph = 0; ph < NPH; ++ph) { a.ph_lo = ph; a.ph_hi = ph + 1; hipLaunchKernelGGL(yoco_fwd, dim3(grid), dim3(NWAVES * 64), LDS_BYTES, stream, a); }
#else
    a.ph_lo = 0; a.ph_hi = NPH; hipLaunchKernelGGL(yoco_fwd, dim3(grid), dim3(NWAVES * 64), LDS_BYTES, stream, a);
#endif
}
```
